# Optimizing an MI355X kernel written in HIP

```python
import math
import jax, jax.numpy as jnp
from jax import lax
import numpy as np

D_MODEL = 1024
BATCH = 4
SEQ = 8192
DEPTH = 2

CHUNK = 64
N_MIXERS = 2
N_S5_LAYERS = (DEPTH + N_MIXERS - 1) // N_MIXERS
N_GM_LAYERS = DEPTH // N_MIXERS
S5_WIDTH = D_MODEL
S5_GROUP_CH = 16
S5_GROUPS = S5_WIDTH // S5_GROUP_CH
S5_STATE = 64
S5_DT_MIN = 1e-3
S5_DT_MAX = 1e-1
GM_HALF = 2 * D_MODEL
GM_GROUPS = 8
GM_SPAN = 128
MEM_LEN = 256
XA_HEADS = 4
XA_HEAD_DIM = D_MODEL // XA_HEADS
MOE_GROUPS = 4
MOE_PER_GROUP = 8
MOE_EXPERTS = MOE_GROUPS * MOE_PER_GROUP
MOE_TOPK = 2
MOE_HIDDEN = D_MODEL // 2
MOE_BLOCK = 128
RMS_EPS = 1e-6

kernel_name = "hybrid_s5_gmlp_memxattn_hmoe"


def rms_norm(x, g):
    xf = x.astype(jnp.float32)
    y = xf * lax.rsqrt(jnp.mean(xf * xf, axis=-1, keepdims=True) + RMS_EPS)
    return (y * g.astype(jnp.float32)).astype(x.dtype)


def _complex_linear_combine(e1, e2):
    a1r, a1i, b1r, b1i = e1
    a2r, a2i, b2r, b2i = e2
    return (a2r * a1r - a2i * a1i,
            a2r * a1i + a2i * a1r,
            a2r * b1r - a2i * b1i + b2r,
            a2r * b1i + a2i * b1r + b2i)


def s5_mixer(h, w_in, lam_re, lam_im, log_dt, b_re, b_im, c_re, c_im, d_skip, w_out):
    f32 = jnp.float32
    bsz, seq, _ = h.shape
    n_chunks = seq // CHUNK
    u = (h @ w_in).astype(f32)
    lr = lam_re.astype(f32)
    li = lam_im.astype(f32)
    dt = jnp.exp(log_dt.astype(f32))[:, None]
    mag = jnp.exp(lr * dt)
    ab_re = mag * jnp.cos(li * dt)
    ab_im = mag * jnp.sin(li * dt)
    den = lr * lr + li * li
    coef_re = ((ab_re - 1.0) * lr + ab_im * li) / den
    coef_im = (ab_im * lr - (ab_re - 1.0) * li) / den
    br = b_re.astype(f32)
    bi = b_im.astype(f32)
    bb_re = coef_re[..., None] * br - coef_im[..., None] * bi
    bb_im = coef_re[..., None] * bi + coef_im[..., None] * br
    cr = c_re.astype(f32)
    ci = c_im.astype(f32)
    uc = u.reshape(bsz, n_chunks, CHUNK, S5_GROUPS, S5_GROUP_CH).transpose(1, 0, 2, 3, 4)

    def chunk_step(carry, u_blk):
        h_re, h_im = carry
        bu_re = jnp.einsum('btgn,gpn->btgp', u_blk, bb_re)
        bu_im = jnp.einsum('btgn,gpn->btgp', u_blk, bb_im)
        a_re = jnp.broadcast_to(ab_re, bu_re.shape)
        a_im = jnp.broadcast_to(ab_im, bu_re.shape)
        pa_re, pa_im, s_re, s_im = lax.associative_scan(
            _complex_linear_combine, (a_re, a_im, bu_re, bu_im), axis=1)
        x_re = s_re + pa_re * h_re[:, None] - pa_im * h_im[:, None]
        x_im = s_im + pa_re * h_im[:, None] + pa_im * h_re[:, None]
        y = (jnp.einsum('btgp,gnp->btgn', x_re, cr)
             - jnp.einsum('btgp,gnp->btgn', x_im, ci))
        return (x_re[:, -1], x_im[:, -1]), y

    init = (jnp.zeros((bsz, S5_GROUPS, S5_STATE), f32),
            jnp.zeros((bsz, S5_GROUPS, S5_STATE), f32))
    _, ys = lax.scan(chunk_step, init, uc)
    y = ys.transpose(1, 0, 2, 3, 4).reshape(bsz, seq, S5_WIDTH) + d_skip.astype(f32) * u
    z = jax.nn.gelu(y).astype(h.dtype) @ w_out
    return z[..., :D_MODEL] * jax.nn.sigmoid(z[..., D_MODEL:])


def gmlp_mixer(h, w_in, v_norm, w_s, b_s, w_out):
    bsz, seq, _ = h.shape
    z = jax.nn.gelu(h @ w_in)
    u = z[..., :GM_HALF]
    v = rms_norm(z[..., GM_HALF:], v_norm)
    pos_chunk = jnp.arange(GM_SPAN) // CHUNK
    mask = pos_chunk[:, None] >= pos_chunk[None, :]
    ws = jnp.where(mask[None], w_s, jnp.zeros_like(w_s))
    vb = v.reshape(bsz, seq // GM_SPAN, GM_SPAN, GM_GROUPS, GM_HALF // GM_GROUPS)
    mixed = jnp.einsum('gij,bnjgc->bnigc', ws, vb) + b_s.T[:, :, None]
    return (u * mixed.reshape(bsz, seq, GM_HALF)) @ w_out


def memory_cross_attention(h, mem_n, w_q, w_kv, w_o):
    bsz, seq, _ = h.shape
    m = mem_n.shape[1]
    q = (h @ w_q).reshape(bsz, seq, XA_HEADS, XA_HEAD_DIM)
    kv = mem_n @ w_kv
    k = kv[..., :D_MODEL].reshape(bsz, m, XA_HEADS, XA_HEAD_DIM)
    v = kv[..., D_MODEL:].reshape(bsz, m, XA_HEADS, XA_HEAD_DIM)
    s = jnp.einsum('bshd,bmhd->bhsm', q, k).astype(jnp.float32) * (XA_HEAD_DIM ** -0.5)
    p = jax.nn.softmax(s, axis=-1).astype(h.dtype)
    o = jnp.einsum('bhsm,bmhd->bshd', p, v).reshape(bsz, seq, D_MODEL)
    return o @ w_o


def hierarchical_moe(h, w_group, b_group, w_expert, b_expert, w_gate, w_up, w_down):
    f32 = jnp.float32
    bsz, seq, d = h.shape
    n_tok = bsz * seq
    ht = h.reshape(n_tok, d)
    p_group = jax.nn.softmax((ht @ w_group).astype(f32) + b_group.astype(f32), axis=-1)
    g = jnp.argmax(p_group, axis=-1)
    w_g = jnp.take_along_axis(p_group, g[:, None], axis=1)[:, 0]
    e_logits = ((ht @ w_expert).astype(f32) + b_expert.astype(f32)).reshape(
        n_tok, MOE_GROUPS, MOE_PER_GROUP)
    within = jnp.take_along_axis(e_logits, g[:, None, None], axis=1)[:, 0, :]
    vals, idx = lax.top_k(within, MOE_TOPK)
    w_e = jax.nn.softmax(vals, axis=-1)
    eid = (g[:, None] * MOE_PER_GROUP + idx).reshape(-1).astype(jnp.int32)
    wts = (w_g[:, None] * w_e).reshape(-1)
    tok = jnp.repeat(jnp.arange(n_tok, dtype=jnp.int32), MOE_TOPK)
    n_assign = n_tok * MOE_TOPK
    n_pad = n_assign + MOE_EXPERTS * MOE_BLOCK
    n_blocks = n_pad // MOE_BLOCK
    order = jnp.argsort(eid)
    e_sorted = eid[order]
    counts = jnp.bincount(eid, length=MOE_EXPERTS).astype(jnp.int32)
    padded = ((counts + MOE_BLOCK - 1) // MOE_BLOCK) * MOE_BLOCK
    start = jnp.cumsum(counts) - counts
    pad_end = jnp.cumsum(padded)
    pad_start = pad_end - padded
    dest = pad_start[e_sorted] + jnp.arange(n_assign, dtype=jnp.int32) - start[e_sorted]
    buf_tok = jnp.full((n_pad,), n_tok, jnp.int32).at[dest].set(tok[order])
    buf_w = jnp.zeros((n_pad,), f32).at[dest].set(wts[order])
    block_expert = jnp.minimum(
        jnp.searchsorted(pad_end, jnp.arange(n_blocks, dtype=jnp.int32) * MOE_BLOCK, side='right'),
        MOE_EXPERTS - 1).astype(jnp.int32)
    h_ext = jnp.concatenate([ht, jnp.zeros((1, d), ht.dtype)], axis=0)
    xb = h_ext[buf_tok].reshape(n_blocks, MOE_BLOCK, d)

    def expert_block(args):
        xblk, e = args
        a = xblk @ w_gate[e]
        b = xblk @ w_up[e]
        return (jax.nn.silu(a) * b) @ w_down[e]

    yb = lax.map(expert_block, (xb, block_expert)).reshape(n_pad, d)
    out = jnp.zeros((n_tok + 1, d), ht.dtype).at[buf_tok].add(yb * buf_w[:, None].astype(ht.dtype))
    return out[:n_tok].reshape(bsz, seq, d)


def setup_inputs(seed: int = 0) -> dict:
    key = jax.random.key(seed)
    ks = iter(jax.random.split(key, 48))
    f32 = jnp.float32

    def nrm(shape, scale):
        return jax.random.normal(next(ks), shape, f32) * scale

    def gain(shape):
        return 1.0 + nrm(shape, 0.01)

    NA, NB, L, D = N_S5_LAYERS, N_GM_LAYERS, DEPTH, D_MODEL
    lam_im = jnp.broadcast_to(jnp.pi * jnp.arange(S5_STATE, dtype=f32), (NA, S5_GROUPS, S5_STATE))
    return {
        "x": nrm((BATCH, SEQ, D), 1.0),
        "mem": nrm((BATCH, MEM_LEN, D), 1.0),
        "s5_norm": gain((NA, D)),
        "s5_w_in": nrm((NA, D, S5_WIDTH), D ** -0.5),
        "s5_lambda_re": -0.5 + nrm((NA, S5_GROUPS, S5_STATE), 0.01),
        "s5_lambda_im": lam_im + nrm((NA, S5_GROUPS, S5_STATE), 0.01),
        "s5_log_dt": jax.random.uniform(next(ks), (NA, S5_GROUPS), f32,
                                        minval=math.log(S5_DT_MIN), maxval=math.log(S5_DT_MAX)),
        "s5_b_re": nrm((NA, S5_GROUPS, S5_STATE, S5_GROUP_CH), (2 * S5_GROUP_CH) ** -0.5),
        "s5_b_im": nrm((NA, S5_GROUPS, S5_STATE, S5_GROUP_CH), (2 * S5_GROUP_CH) ** -0.5),
        "s5_c_re": nrm((NA, S5_GROUPS, S5_GROUP_CH, S5_STATE), (2 * S5_STATE) ** -0.5),
        "s5_c_im": nrm((NA, S5_GROUPS, S5_GROUP_CH, S5_STATE), (2 * S5_STATE) ** -0.5),
        "s5_d": nrm((NA, S5_WIDTH), 1.0),
        "s5_w_out": nrm((NA, S5_WIDTH, 2 * D), S5_WIDTH ** -0.5),
        "gm_norm": gain((NB, D)),
        "gm_w_in": nrm((NB, D, 2 * GM_HALF), D ** -0.5),
        "gm_v_norm": gain((NB, GM_HALF)),
        "gm_w_s": nrm((NB, GM_GROUPS, GM_SPAN, GM_SPAN), GM_SPAN ** -0.5),
        "gm_b_s": gain((NB, GM_GROUPS, GM_SPAN)),
        "gm_w_out": nrm((NB, GM_HALF, D), GM_HALF ** -0.5),
        "mem_norm": gain((D,)),
        "xa_norm": gain((L, D)),
        "xa_w_q": nrm((L, D, D), D ** -0.5),
        "xa_w_kv": nrm((L, D, 2 * D), D ** -0.5),
        "xa_w_o": nrm((L, D, D), D ** -0.5),
        "moe_norm": gain((L, D)),
        "moe_w_group": nrm((L, D, MOE_GROUPS), D ** -0.5),
        "moe_b_group": nrm((L, MOE_GROUPS), 0.01),
        "moe_w_expert": nrm((L, D, MOE_EXPERTS), D ** -0.5),
        "moe_b_expert": nrm((L, MOE_EXPERTS), 0.01),
        "moe_w_gate": nrm((L, MOE_EXPERTS, D, MOE_HIDDEN), D ** -0.5),
        "moe_w_up": nrm((L, MOE_EXPERTS, D, MOE_HIDDEN), D ** -0.5),
        "moe_w_down": nrm((L, MOE_EXPERTS, MOE_HIDDEN, D), MOE_HIDDEN ** -0.5),
        "final_norm": gain((D,)),
    }


def reference(x, mem, s5_norm, s5_w_in, s5_lambda_re, s5_lambda_im, s5_log_dt, s5_b_re, s5_b_im,
              s5_c_re, s5_c_im, s5_d, s5_w_out, gm_norm, gm_w_in, gm_v_norm, gm_w_s, gm_b_s,
              gm_w_out, mem_norm, xa_norm, xa_w_q, xa_w_kv, xa_w_o, moe_norm, moe_w_group,
              moe_b_group, moe_w_expert, moe_b_expert, moe_w_gate, moe_w_up, moe_w_down,
              final_norm):
    mem_n = rms_norm(mem, mem_norm)
    for i in range(DEPTH):
        j = i // N_MIXERS
        if i % N_MIXERS == 0:
            x = x + s5_mixer(rms_norm(x, s5_norm[j]), s5_w_in[j], s5_lambda_re[j], s5_lambda_im[j],
                             s5_log_dt[j], s5_b_re[j], s5_b_im[j], s5_c_re[j], s5_c_im[j],
                             s5_d[j], s5_w_out[j])
        else:
            x = x + gmlp_mixer(rms_norm(x, gm_norm[j]), gm_w_in[j], gm_v_norm[j], gm_w_s[j],
                               gm_b_s[j], gm_w_out[j])
        x = x + memory_cross_attention(rms_norm(x, xa_norm[i]), mem_n, xa_w_q[i], xa_w_kv[i], xa_w_o[i])
        x = x + hierarchical_moe(rms_norm(x, moe_norm[i]), moe_w_group[i], moe_b_group[i],
                                 moe_w_expert[i], moe_b_expert[i], moe_w_gate[i], moe_w_up[i],
                                 moe_w_down[i])
    return rms_norm(x, final_norm)
```

```cpp
#include <hip/hip_runtime.h>
#include <cstdio>
#include <cstdint>

#define LAS __attribute__((address_space(3)))
typedef unsigned short bf16_t;
typedef short bf16x8 __attribute__((ext_vector_type(8)));
typedef float f32x4 __attribute__((ext_vector_type(4)));
typedef float f32x2 __attribute__((ext_vector_type(2)));
typedef unsigned u32x4 __attribute__((ext_vector_type(4)));
typedef unsigned u32x2 __attribute__((ext_vector_type(2)));

constexpr int T_TOK = 32768, DM = 1024, NBATCH = 4, SEQ = 8192, MEMR = 1024;
constexpr float RMS_EPS = 1e-6f;
constexpr int NWAVES = 8, NTHR = 512;

constexpr size_t MiB = 1u << 20;
constexpr size_t WS_CTL = 0, CTL_BYTES = 1 * MiB;
constexpr size_t WS_W_S5IN = 1 * MiB, WS_W_S5OUT = 3 * MiB, WS_W_GMIN = 7 * MiB, WS_W_GMOUT = 15 * MiB, WS_W_XA = 19 * MiB  ;
constexpr size_t WS_W_RT = 35 * MiB;
constexpr size_t WS_W_MOE = 36 * MiB;
constexpr size_t MOE_L_STRIDE = 96 * MiB, MOE_D_OFF = 64 * MiB;
constexpr size_t WS_MEMBF = 228 * MiB, WS_KV = 230 * MiB;
constexpr size_t WS_SMALL = 238 * MiB;
constexpr size_t SM_RINVMEM = 0, SM_RINVA = 64 * 1024, SM_RINVB = 256 * 1024, SM_WTS = 512 * 1024, SM_AB16 = 1024 * 1024;
constexpr size_t WS_PART = 240 * MiB, WS_LIST = 244 * MiB, WS_X = 248 * MiB, WS_SCR = 313 * MiB, WS_END = 569 * MiB;
constexpr size_t SC_U = 0, SC_H2 = 64 * MiB, SC_Y = 128 * MiB, SC_S5A = 192 * MiB, SC_S5M = 204 * MiB;
constexpr size_t SC_Q = 0, SC_O = 64 * MiB, SC_P = 128 * MiB;
constexpr size_t SC_HB = 0, SC_YS = 72 * MiB;
constexpr size_t SC_Z = 0;
constexpr int CW_BAR = 4096, CW_CNT = 16384  , CW_DBG = 20480;

constexpr int LDS_BYTES = 155648;
constexpr int LDS_EXTRA = 131072;
constexpr int LX_MISC = LDS_BYTES - 256;
constexpr int LX_TAB = LDS_EXTRA;

__device__ __forceinline__ unsigned cvt_pk_bf16(float lo, float hi) { unsigned r; asm volatile("v_cvt_pk_bf16_f32 %0, %1, %2" : "=v"(r) : "v"(lo), "v"(hi)); return r; }
__device__ __forceinline__ unsigned f2bf(float f) { unsigned u = __builtin_bit_cast(unsigned, f); return (u + 0x7fffu + ((u >> 16) & 1u)) >> 16; }
__device__ __forceinline__ float bf2f(unsigned h) { return __builtin_bit_cast(float, h << 16); }
__device__ __forceinline__ float bflo(unsigned w) { return __builtin_bit_cast(float, w << 16); }
__device__ __forceinline__ float bfhi(unsigned w) { return __builtin_bit_cast(float, w & 0xffff0000u); }
__device__ __forceinline__ float wave_sum(float v) {
#pragma unroll
    for (int o = 1; o < 64; o <<= 1) v += __shfl_xor(v, o);
    return v;
}
__device__ __forceinline__ float fast_rcp(float x) { return __builtin_amdgcn_rcpf(x); }
__device__ __forceinline__ float fast_exp2(float x) { return __builtin_amdgcn_exp2f(x); }
__device__ __forceinline__ float sigmoid_f(float g) { return fast_rcp(1.0f + fast_exp2(-1.4426950408889634f * g)); }
__device__ __forceinline__ float gelu_tanh(float x) {
    const float t = x * (1.0f + 0.044715f * x * x);
    return x * fast_rcp(1.0f + fast_exp2(-2.302208198f * t));
}

#define XB_TMO      128
#define XB_XCNT(j)  (256  + 64 * (j))
#define XB_XSUB(j)  (1280 + 64 * (j))
#define XB_XGEN(j)  (2304 + 64 * (j))
#define XB_TOP      3328
#define XB_TOPGEN   3392
#define XCD_BAR_WORDS 3456
#define XB_SPIN_CAP (1u << 18)
__device__ __forceinline__ unsigned xb_ld(unsigned* p)              { return __hip_atomic_load(p, __ATOMIC_RELAXED, __HIP_MEMORY_SCOPE_AGENT); }
__device__ __forceinline__ unsigned xb_add(unsigned* p, unsigned v) { return __hip_atomic_fetch_add(p, v, __ATOMIC_RELAXED, __HIP_MEMORY_SCOPE_AGENT); }
__device__ __forceinline__ unsigned xb_xcc_id() { return (unsigned)__builtin_amdgcn_s_getreg((3 << 11) | 20) & 0xFu; }
#define XB_SPIN(cond, bar) do { unsigned _sp = 0; while (cond) { __builtin_amdgcn_s_sleep(1); \
    if ((++_sp & 255u) == 0u) { if (xb_ld(&(bar)[XB_TMO])) break; if (_sp > XB_SPIN_CAP) { atomicAdd(&(bar)[XB_TMO], 1u); break; } } } } while (0)
struct XcdBarrier { unsigned* bar; unsigned x; volatile LAS unsigned* st; };
__device__ __forceinline__ XcdBarrier xcd_barrier_post(unsigned* bar, volatile LAS unsigned* st) {
    XcdBarrier b; b.bar = bar; b.x = xb_xcc_id(); b.st = st;
    if (threadIdx.x == 0) (void)xb_add(&bar[XB_XCNT(b.x)], 1u);
    return b;
}
__device__ __forceinline__ void xcd_barrier_complete(unsigned* bar, unsigned x, unsigned& nloc, unsigned& nx) {
    const unsigned G = gridDim.x * gridDim.y * gridDim.z;
    unsigned sum, cnt, mine, sp = 0u;
    for (;;) {
        sum = 0u; cnt = 0u; mine = 0u;
#pragma unroll
        for (unsigned j = 0; j < 16; ++j) { const unsigned c = xb_ld(&bar[XB_XCNT(j)]); sum += c; cnt += (c > 0u) ? 1u : 0u; mine = (j == x) ? c : mine; }
        if (sum == G) break;
        __builtin_amdgcn_s_sleep(1);
        if ((++sp & 255u) == 0u) { if (xb_ld(&bar[XB_TMO])) break; if (sp > XB_SPIN_CAP) { atomicAdd(&bar[XB_TMO], 1u); break; } }
    }
    nloc = mine > 0u ? mine : 1u; nx = cnt > 0u ? cnt : 1u;
}
__device__ __forceinline__ void xcd_barrier(const XcdBarrier& b) {
    asm volatile("s_waitcnt vmcnt(0)" ::: "memory");
    __syncthreads();
    if (threadIdx.x == 0) {
        unsigned* bar = b.bar;
        __builtin_amdgcn_s_waitcnt(0);
        unsigned nloc = b.st[0], nx = b.st[1];
        if (nloc == 0u) { xcd_barrier_complete(bar, b.x, nloc, nx); b.st[0] = nloc; b.st[1] = nx; }
        const unsigned old = xb_add(&bar[XB_XSUB(b.x)], 1u);
        const unsigned gen = old / nloc;
        if (old + 1u == (gen + 1u) * nloc) {
            __builtin_amdgcn_fence(__ATOMIC_RELEASE, "agent");
            asm volatile("s_waitcnt vmcnt(0)" ::: "memory");
            const unsigned og = xb_add(&bar[XB_TOP], 1u);
            const unsigned tg = og / nx;
            if (og + 1u == (tg + 1u) * nx) xb_add(&bar[XB_TOPGEN], 1u);
            else XB_SPIN(xb_ld(&bar[XB_TOPGEN]) == tg, bar);
            __builtin_amdgcn_fence(__ATOMIC_ACQUIRE, "agent");
            xb_add(&bar[XB_XGEN(b.x)], 1u);
            asm volatile("s_waitcnt vmcnt(0)" ::: "memory");
        } else {
            XB_SPIN(xb_ld(&bar[XB_XGEN(b.x)]) == gen, bar);
            __builtin_amdgcn_fence(__ATOMIC_ACQUIRE, "agent");
            asm volatile("s_waitcnt vmcnt(0)" ::: "memory");
        }
    }
    __syncthreads();
}

namespace g8 {
constexpr int BM = 256, BK = 64, HALF = 128, HTB = HALF * BK * 2, STAGE_BYTES = 8 * HTB, NXCD = 8, WGM = 8;
__host__ __device__ __forceinline__ int lds_byte(int r, int c) { const int st = (r >> 4) * 2 + (c >> 5), rr = r & 15, cc = c & 31, ob = rr * 64 + cc * 2; return st * 1024 + (ob ^ (((ob >> 9) & 1) << 5)); }
__host__ __device__ __forceinline__ void stage_rc(int b, int& R, int& C) { const int st = b / 1024, sb = b % 1024, swz = sb ^ (((sb >> 9) & 1) << 5); R = (st >> 1) * 16 + swz / 64; C = (st & 1) * 32 + (swz % 64) / 2; }
__host__ __device__ __forceinline__ int perm32(int rho) { const int n = rho >> 4, i = rho & 15; return 8 * (i >> 2) + 4 * n + (i & 3); }

struct Unit {
    unsigned A;
    unsigned A2;
    unsigned B;
    int pm, pn;
    int slot;
    int aux;
};
struct Cfg { int lda, ldb, kstepA, kstepB, nt, asplit; };

__device__ __forceinline__ bool static_order(int i, int G, int c, int nM, int nN, int& pm, int& pn) {
    const int nwg = nM * nN; const int L = i * G + c; if (L >= nwg) return false;
    int wgid = L; { const int q = nwg / NXCD, r = nwg % NXCD, xcd = wgid % NXCD, off = wgid / NXCD; wgid = (xcd < r ? xcd * (q + 1) : r * (q + 1) + (xcd - r) * q) + off; }
    const int nig = WGM * nN, gid = wgid / nig, fm = gid * WGM, gsz = (nM - fm) < WGM ? (nM - fm) : WGM;
    pm = fm + ((wgid % nig) % gsz); pn = (wgid % nig) / gsz; return true;
}
template <int NM, int NN, unsigned TSA, unsigned TSB>
struct StdSched {
    unsigned A, B; int G, c;
    __device__ __forceinline__ bool next(int i, Unit& u) const {
        int pm, pn; if (!static_order(i, G, c, NM, NN, pm, pn)) return false;
        u.A = A + (unsigned)pm * TSA; u.A2 = u.A; u.B = B + (unsigned)pn * TSB; u.pm = pm; u.pn = pn; u.slot = i; u.aux = 0; return true;
    }
};

template <class Epi, class Sched, int MODE, int LDA, int LDB, int KSA, int KSB, int NT, int ASPLIT>
__device__ __forceinline__ void gemm_phase(LAS unsigned char* lds, const char* wsb, const Sched& S, const Epi& E, const LAS int* tok_lds) {
    constexpr Cfg cfg{LDA, LDB, KSA, KSB, NT, ASPLIT};
    int tid_ = threadIdx.x; asm volatile("" : "+v"(tid_));
    const int tid = tid_, wid = __builtin_amdgcn_readfirstlane(tid >> 6), lane = tid & 63, wr = wid >> 2, wc = wid & 3, fr = lane & 15, fq = lane >> 4;
    constexpr int nt = NT;
    constexpr bool GATHER = (MODE & 1) != 0, TOKA = (MODE & 2) != 0;
    int RA[2], CA[2]; unsigned voffA[2], voffB[2];
#pragma unroll
    for (int i = 0; i < 2; ++i) { int R, C; stage_rc(tid * 16 + i * 8192, R, C); const int Rb = Epi::PERM ? ((R & ~31) + perm32(R & 31)) : R;
        RA[i] = R; CA[i] = C;
        const unsigned acol = TOKA ? (unsigned)((C >> 4) * 2048 + (C & 15) * 2) : (unsigned)(C * 2);
        voffA[i] = (unsigned)R * (unsigned)cfg.lda + acol; voffB[i] = (unsigned)Rb * (unsigned)cfg.ldb + (unsigned)(C * 2); }
    constexpr unsigned kstepA = (unsigned)KSA, kstepB = (unsigned)KSB;
    constexpr unsigned hstepA = (unsigned)HALF * (unsigned)LDA, hstepB = (unsigned)HALF * (unsigned)LDB;
    const unsigned ldsw = (unsigned)wid * 1024u;
    const int aoff = lds_byte(wr * 64 + fr, fq * 8), boff = lds_byte(wc * 32 + fr, fq * 8);
    unsigned gc00 = 0, gc01 = 0, gc10 = 0, gc11 = 0, gn00 = 0, gn01 = 0, gn10 = 0, gn11 = 0;
#define G8_SA(b, h) (((b) * 2 + (h)) * HTB)
#define G8_SB(b, h) ((4 + (b) * 2 + (h)) * HTB)
#define G8_GLDS(off32, ldsoff) __builtin_amdgcn_global_load_lds((const unsigned*)(wsb + (size_t)(unsigned)(off32)), (LAS unsigned*)(lds + (ldsoff)), 16, 0, 0)
#define G8_STAGE_B(bufoff, ub) do { G8_GLDS((ub) + voffB[0], (bufoff) + ldsw); G8_GLDS((ub) + voffB[1], (bufoff) + ldsw + 8192); } while (0)
#define G8_STAGE_A(bufoff, ua, h, o0, o1) do { if (GATHER) { G8_GLDS((ua) + (o0), (bufoff) + ldsw); G8_GLDS((ua) + (o1), (bufoff) + ldsw + 8192); } \
        else { G8_GLDS((ua) + (unsigned)(h) * hstepA + voffA[0], (bufoff) + ldsw); G8_GLDS((ua) + (unsigned)(h) * hstepA + voffA[1], (bufoff) + ldsw + 8192); } } while (0)
#define G8_LDA(dst, b, h) do { _Pragma("unroll") for (int m = 0; m < 4; ++m) _Pragma("unroll") for (int k = 0; k < 2; ++k) dst[m][k] = *(const LAS bf16x8*)(lds + G8_SA(b, h) + aoff + m * 2048 + k * 1024); } while (0)
#define G8_LDB(dst, b, h) do { _Pragma("unroll") for (int n = 0; n < 2; ++n) _Pragma("unroll") for (int k = 0; k < 2; ++k) dst[n][k] = *(const LAS bf16x8*)(lds + G8_SB(b, h) + boff + n * 2048 + k * 1024); } while (0)
#define G8_MMA(ai, bj, At, Bt) do { __builtin_amdgcn_s_setprio(1); _Pragma("unroll") for (int m = 0; m < 4; ++m) _Pragma("unroll") for (int n = 0; n < 2; ++n) _Pragma("unroll") for (int k = 0; k < 2; ++k) \
        acc[ai][bj][m][n] = __builtin_amdgcn_mfma_f32_16x16x32_bf16(Bt[n][k], At[m][k], acc[ai][bj][m][n], 0, 0, 0); __builtin_amdgcn_s_setprio(0); } while (0)
#define G8_WAIT_V(n) asm volatile("s_waitcnt vmcnt(" #n ")" ::: "memory")
#define G8_WAIT_L(n) asm volatile("s_waitcnt lgkmcnt(" #n ")" ::: "memory")
#define G8_BAR __builtin_amdgcn_s_barrier()
#define G8_SCHED __builtin_amdgcn_sched_barrier(0)
#define G8_APTR(u, kt) ((TOKA && (kt) >= cfg.asplit) ? (u).A2 + (unsigned)((kt) - cfg.asplit) * kstepA : (u).A + (unsigned)(kt) * kstepA)
#define G8_GOFF(u, d00, d01, d10, d11) do { if (GATHER) { const LAS int* _t = tok_lds + (u).slot * 256; \
        d00 = (unsigned)_t[RA[0]] * (unsigned)cfg.lda + (unsigned)(CA[0] * 2); d01 = (unsigned)_t[RA[1]] * (unsigned)cfg.lda + (unsigned)(CA[1] * 2); \
        d10 = (unsigned)_t[128 + RA[0]] * (unsigned)cfg.lda + (unsigned)(CA[0] * 2); d11 = (unsigned)_t[128 + RA[1]] * (unsigned)cfg.lda + (unsigned)(CA[1] * 2); } } while (0)
    Unit cur, nxt; int ui = 0;
    if (!S.next(0, cur)) return;
    f32x4 acc[2][2][4][2];
#pragma unroll
    for (int a = 0; a < 2; ++a)
#pragma unroll
        for (int b = 0; b < 2; ++b)
#pragma unroll
            for (int m = 0; m < 4; ++m)
#pragma unroll
                for (int n = 0; n < 2; ++n) acc[a][b][m][n] = (f32x4){0.f, 0.f, 0.f, 0.f};
    bf16x8 At[4][2], B0[2][2], B1[2][2];
    G8_GOFF(cur, gc00, gc01, gc10, gc11);
    {
        const unsigned cA0 = G8_APTR(cur, 0), cA1 = G8_APTR(cur, 1), cB = cur.B;
        G8_STAGE_B(G8_SB(0, 0), cB); G8_STAGE_B(G8_SB(0, 1), cB + hstepB); G8_STAGE_A(G8_SA(0, 0), cA0, 0, gc00, gc01); G8_STAGE_A(G8_SA(0, 1), cA0, 1, gc10, gc11);
        if (wr == 1) G8_BAR;
        G8_WAIT_V(2); G8_BAR;
        G8_STAGE_B(G8_SB(1, 0), cB + kstepB); G8_STAGE_A(G8_SA(1, 0), cA1, 0, gc00, gc01); G8_STAGE_B(G8_SB(1, 1), cB + hstepB + kstepB);
        G8_WAIT_V(6); G8_BAR;
    }
    for (;;) {
        const bool has_next = S.next(ui + 1, nxt);
        if (!has_next) nxt = cur;
#pragma unroll 1
        for (int t = 0; t < nt; t += 2) {
            const bool last = (t == nt - 2);
            const unsigned a1 = G8_APTR(cur, t + 1);
            const unsigned a2 = last ? G8_APTR(nxt, 0) : G8_APTR(cur, t + 2), b2 = last ? nxt.B : cur.B + (unsigned)(t + 2) * kstepB;
            const unsigned a3 = last ? G8_APTR(nxt, 1) : G8_APTR(cur, t + 3), b3 = b2 + kstepB;
            if (GATHER && last) { if (has_next) { G8_GOFF(nxt, gn00, gn01, gn10, gn11); } else { gn00 = gc00; gn01 = gc01; gn10 = gc10; gn11 = gc11; } }
            const unsigned s00 = last ? gn00 : gc00, s01 = last ? gn01 : gc01, s10 = last ? gn10 : gc10, s11 = last ? gn11 : gc11;
            G8_LDB(B0, 0, 0); G8_LDB(B1, 0, 1); G8_SCHED; G8_LDA(At, 0, 0); G8_STAGE_A(G8_SA(1, 1), a1, 1, gc10, gc11);
            G8_WAIT_V(8); G8_WAIT_L(0); G8_BAR; G8_MMA(0, 0, At, B0); G8_MMA(0, 1, At, B1); G8_BAR; G8_SCHED;
            G8_LDA(At, 0, 1); G8_STAGE_B(G8_SB(0, 0), b2); G8_STAGE_B(G8_SB(0, 1), b2 + hstepB); G8_STAGE_A(G8_SA(0, 0), a2, 0, s00, s01);
            G8_WAIT_V(8); G8_WAIT_L(0); G8_BAR; G8_MMA(1, 0, At, B0); G8_MMA(1, 1, At, B1); G8_BAR; G8_SCHED;
            G8_LDB(B0, 1, 0); G8_LDB(B1, 1, 1); G8_SCHED; G8_LDA(At, 1, 0); G8_STAGE_A(G8_SA(0, 1), a2, 1, s10, s11);
            G8_WAIT_V(8); G8_WAIT_L(0); G8_BAR; G8_MMA(0, 0, At, B0); G8_MMA(0, 1, At, B1); G8_BAR; G8_SCHED;
            G8_LDA(At, 1, 1); G8_STAGE_B(G8_SB(1, 0), b3); G8_STAGE_B(G8_SB(1, 1), b3 + hstepB); G8_STAGE_A(G8_SA(1, 0), a3, 0, s00, s01);
            G8_WAIT_V(8); G8_WAIT_L(0); G8_BAR; G8_MMA(1, 0, At, B0); G8_MMA(1, 1, At, B1); G8_BAR; G8_SCHED;
        }
        if (wr == 0) G8_BAR;
        if constexpr (!Epi::AFTER_DRAIN) { int efr = fr, efq = fq; asm volatile("" : "+v"(efr), "+v"(efq));
            E(acc, cur, wr, wc, efr, efq); }
        if (!has_next) break;
#pragma unroll
        for (int a = 0; a < 2; ++a)
#pragma unroll
            for (int b = 0; b < 2; ++b)
#pragma unroll
                for (int m = 0; m < 4; ++m)
#pragma unroll
                    for (int n = 0; n < 2; ++n) acc[a][b][m][n] = (f32x4){0.f, 0.f, 0.f, 0.f};
        cur = nxt; ++ui; gc00 = gn00; gc01 = gn01; gc10 = gn10; gc11 = gn11;
        if (wr == 1) G8_BAR;
    }
    G8_WAIT_V(0);
    G8_BAR;
    if constexpr (Epi::AFTER_DRAIN) { E.fused(acc, cur, wr, wc, fr, fq, lds, wid, lane); }
#undef G8_SA
#undef G8_SB
#undef G8_GLDS
#undef G8_STAGE_A
#undef G8_STAGE_B
#undef G8_LDA
#undef G8_LDB
#undef G8_MMA
#undef G8_WAIT_V
#undef G8_WAIT_L
#undef G8_BAR
#undef G8_SCHED
#undef G8_APTR
#undef G8_GOFF
}
}
namespace g8 {
typedef const f32x4 (&AccRef)[2][2][4][2];

struct EpiRowScale {
    static constexpr bool PERM = true, AFTER_DRAIN = false;
    bf16_t* O; int ldc; const LAS float* rs_lds;
    __device__ __forceinline__ void operator()(AccRef acc, const Unit& u, int wr, int wc, int fr, int fq) const {
        const int r0 = wr * 64 + fr; const int col0 = u.pn * BM + wc * 32 + 8 * fq;
#pragma unroll
        for (int ai = 0; ai < 2; ++ai)
#pragma unroll
            for (int m = 0; m < 4; ++m) { const int r = r0 + ai * HALF + m * 16; const float s = rs_lds[u.slot * 256 + r];
                bf16_t* rowp = O + (size_t)(u.pm * BM + r) * ldc + col0;
#pragma unroll
                for (int bj = 0; bj < 2; ++bj) { const f32x4 v0 = acc[ai][bj][m][0] * s, v1 = acc[ai][bj][m][1] * s;
                    u32x4 w; w.x = cvt_pk_bf16(v0[0], v0[1]); w.y = cvt_pk_bf16(v0[2], v0[3]); w.z = cvt_pk_bf16(v1[0], v1[1]); w.w = cvt_pk_bf16(v1[2], v1[3]);
                    *(u32x4*)(rowp + bj * HALF) = w; } }
    }
};
struct EpiGmIn {
    static constexpr bool PERM = true, AFTER_DRAIN = false;
    bf16_t* O; int ldc; const LAS float* rs_lds; float* part;
    __device__ __forceinline__ void operator()(AccRef acc, const Unit& u, int wr, int wc, int fr, int fq) const {
        const int r0 = wr * 64 + fr; const int col0 = u.pn * BM + wc * 32 + 8 * fq;
#pragma unroll
        for (int ai = 0; ai < 2; ++ai)
#pragma unroll
            for (int m = 0; m < 4; ++m) { const int r = r0 + ai * HALF + m * 16; const float s = rs_lds[u.slot * 256 + r];
                bf16_t* rowp = O + (size_t)(u.pm * BM + r) * ldc + col0; float q = 0.f;
#pragma unroll
                for (int bj = 0; bj < 2; ++bj) { f32x4 v0 = acc[ai][bj][m][0] * s, v1 = acc[ai][bj][m][1] * s;
#pragma unroll
                    for (int j = 0; j < 4; ++j) { v0[j] = gelu_tanh(v0[j]); v1[j] = gelu_tanh(v1[j]); }
                    u32x4 w; w.x = cvt_pk_bf16(v0[0], v0[1]); w.y = cvt_pk_bf16(v0[2], v0[3]); w.z = cvt_pk_bf16(v1[0], v1[1]); w.w = cvt_pk_bf16(v1[2], v1[3]);
                    *(u32x4*)(rowp + bj * HALF) = w;
                    q += bflo(w.x) * bflo(w.x) + bfhi(w.x) * bfhi(w.x) + bflo(w.y) * bflo(w.y) + bfhi(w.y) * bfhi(w.y) + bflo(w.z) * bflo(w.z) + bfhi(w.z) * bfhi(w.z) + bflo(w.w) * bflo(w.w) + bfhi(w.w) * bfhi(w.w); }
                if (u.pn >= 8) { q += __shfl_xor(q, 16); q += __shfl_xor(q, 32);
                    if (fq == 0) part[(size_t)(u.pm * BM + r) * 32 + (u.pn - 8) * 4 + wc] = q; } }
    }
};
struct EpiKV {
    static constexpr bool PERM = true, AFTER_DRAIN = false;
    bf16_t* O0; const float* rinv_mem;
    __device__ __forceinline__ void operator()(AccRef acc, const Unit& u, int wr, int wc, int fr, int fq) const {
        const int r0 = wr * 64 + fr; const int col0 = u.pn * BM + wc * 32 + 8 * fq; const int kind = u.aux & 1; bf16_t* Ob = O0 + (size_t)(u.aux & 3) * 1048576;
        f32x4 cs[2][2];
#pragma unroll
        for (int bj = 0; bj < 2; ++bj)
#pragma unroll
            for (int n = 0; n < 2; ++n) cs[bj][n] = kind ? *(const f32x4*)(rinv_mem + col0 + bj * HALF + 4 * n) : (f32x4){1.f, 1.f, 1.f, 1.f};
#pragma unroll
        for (int ai = 0; ai < 2; ++ai)
#pragma unroll
            for (int m = 0; m < 4; ++m) { const int row = u.pm * BM + r0 + ai * HALF + m * 16; const float s = kind ? 1.f : rinv_mem[row];
                bf16_t* rowp = Ob + (size_t)row * 1024 + col0;
#pragma unroll
                for (int bj = 0; bj < 2; ++bj) { const f32x4 v0 = acc[ai][bj][m][0] * s * cs[bj][0], v1 = acc[ai][bj][m][1] * s * cs[bj][1];
                    u32x4 w; w.x = cvt_pk_bf16(v0[0], v0[1]); w.y = cvt_pk_bf16(v0[2], v0[3]); w.z = cvt_pk_bf16(v1[0], v1[1]); w.w = cvt_pk_bf16(v1[2], v1[3]);
                    *(u32x4*)(rowp + bj * HALF) = w; } }
    }
};
struct EpiGluRes {
    static constexpr bool PERM = true, AFTER_DRAIN = false;
    bf16_t* X; float* part;
    __device__ __forceinline__ void operator()(AccRef acc, const Unit& u, int wr, int wc, int fr, int fq) const {
        const int r0 = wr * 64 + fr; const int col0 = u.pn * HALF + wc * 32 + 8 * fq;
#pragma unroll
        for (int ai = 0; ai < 2; ++ai)
#pragma unroll
            for (int m = 0; m < 4; ++m) { const int row = u.pm * BM + r0 + ai * HALF + m * 16;
                bf16_t* xp = X + (size_t)row * 1024 + col0; const u32x4 xo = *(const u32x4*)xp;
                f32x4 v0 = acc[ai][0][m][0], v1 = acc[ai][0][m][1]; const f32x4 g0 = acc[ai][1][m][0], g1 = acc[ai][1][m][1];
#pragma unroll
                for (int j = 0; j < 4; ++j) { v0[j] *= sigmoid_f(g0[j]); v1[j] *= sigmoid_f(g1[j]); }
                u32x4 w; w.x = cvt_pk_bf16(v0[0] + bflo(xo.x), v0[1] + bfhi(xo.x)); w.y = cvt_pk_bf16(v0[2] + bflo(xo.y), v0[3] + bfhi(xo.y));
                w.z = cvt_pk_bf16(v1[0] + bflo(xo.z), v1[1] + bfhi(xo.z)); w.w = cvt_pk_bf16(v1[2] + bflo(xo.w), v1[3] + bfhi(xo.w));
                *(u32x4*)xp = w;
                float q = bflo(w.x) * bflo(w.x) + bfhi(w.x) * bfhi(w.x) + bflo(w.y) * bflo(w.y) + bfhi(w.y) * bfhi(w.y) + bflo(w.z) * bflo(w.z) + bfhi(w.z) * bfhi(w.z) + bflo(w.w) * bflo(w.w) + bfhi(w.w) * bfhi(w.w);
                q += __shfl_xor(q, 16); q += __shfl_xor(q, 32);
                if (fq == 0) part[(size_t)row * 32 + u.pn * 4 + wc] = q; }
    }
};
template <bool PART> struct EpiRes {
    static constexpr bool PERM = true, AFTER_DRAIN = false;
    bf16_t* X; float* part;
    __device__ __forceinline__ void operator()(AccRef acc, const Unit& u, int wr, int wc, int fr, int fq) const {
        const int r0 = wr * 64 + fr; const int col0 = u.pn * BM + wc * 32 + 8 * fq;
#pragma unroll
        for (int ai = 0; ai < 2; ++ai)
#pragma unroll
            for (int m = 0; m < 4; ++m) { const int row = u.pm * BM + r0 + ai * HALF + m * 16; float q = 0.f;
#pragma unroll
                for (int bj = 0; bj < 2; ++bj) { bf16_t* xp = X + (size_t)row * 1024 + col0 + bj * HALF; const u32x4 xo = *(const u32x4*)xp;
                    const f32x4 v0 = acc[ai][bj][m][0], v1 = acc[ai][bj][m][1];
                    u32x4 w; w.x = cvt_pk_bf16(v0[0] + bflo(xo.x), v0[1] + bfhi(xo.x)); w.y = cvt_pk_bf16(v0[2] + bflo(xo.y), v0[3] + bfhi(xo.y));
                    w.z = cvt_pk_bf16(v1[0] + bflo(xo.z), v1[1] + bfhi(xo.z)); w.w = cvt_pk_bf16(v1[2] + bflo(xo.w), v1[3] + bfhi(xo.w));
                    *(u32x4*)xp = w;
                    if (PART) q += bflo(w.x) * bflo(w.x) + bfhi(w.x) * bfhi(w.x) + bflo(w.y) * bflo(w.y) + bfhi(w.y) * bfhi(w.y) + bflo(w.z) * bflo(w.z) + bfhi(w.z) * bfhi(w.z) + bflo(w.w) * bflo(w.w) + bfhi(w.w) * bfhi(w.w); }
                if (PART) { q += __shfl_xor(q, 16); q += __shfl_xor(q, 32); if (fq == 0) part[(size_t)row * 32 + u.pn * 4 + wc] = q; } }
    }
};
struct EpiS5B {
    static constexpr bool PERM = true, AFTER_DRAIN = false;
    bf16_t* Y;
    __device__ __forceinline__ void operator()(AccRef acc, const Unit& u, int wr, int wc, int fr, int fq) const {
        const int r0 = wr * 64 + fr; const int g = u.aux;
#pragma unroll
        for (int ai = 0; ai < 2; ++ai)
#pragma unroll
            for (int m = 0; m < 4; ++m) { const int blk = u.pm * BM + r0 + ai * HALF + m * 16;
#pragma unroll
                for (int bj = 0; bj < 2; ++bj) { const int c = bj * HALF + wc * 32 + 8 * fq; const int tl = c >> 4, ch = c & 15;
                    f32x4 v0 = acc[ai][bj][m][0], v1 = acc[ai][bj][m][1];
#pragma unroll
                    for (int j = 0; j < 4; ++j) { v0[j] = gelu_tanh(v0[j]); v1[j] = gelu_tanh(v1[j]); }
                    u32x4 w; w.x = cvt_pk_bf16(v0[0], v0[1]); w.y = cvt_pk_bf16(v0[2], v0[3]); w.z = cvt_pk_bf16(v1[0], v1[1]); w.w = cvt_pk_bf16(v1[2], v1[3]);
                    *(u32x4*)(Y + ((size_t)blk * 16 + tl) * 1024 + g * 16 + ch) = w; } }
    }
};
struct EpiSoftmax {
    static constexpr bool PERM = true, AFTER_DRAIN = true;
    bf16_t* P;
    __device__ __forceinline__ void operator()(AccRef, const Unit&, int, int, int, int) const {}
    __device__ __forceinline__ void fused(f32x4 (&acc)[2][2][4][2], const Unit& u, int wr, int wc, int fr, int fq, LAS unsigned char* lds, int wid, int lane) const {
        LAS float* RM = (LAS float*)lds;
        LAS float* RS = (LAS float*)(lds + 4096);
        const int r0 = wr * 64 + fr;
        float mx[2][4];
#pragma unroll
        for (int ai = 0; ai < 2; ++ai)
#pragma unroll
            for (int m = 0; m < 4; ++m) { float v = -3.0e38f;
#pragma unroll
                for (int bj = 0; bj < 2; ++bj)
#pragma unroll
                    for (int n = 0; n < 2; ++n) { const f32x4 x = acc[ai][bj][m][n]; v = fmaxf(v, fmaxf(fmaxf(x[0], x[1]), fmaxf(x[2], x[3]))); }
                v = fmaxf(v, __shfl_xor(v, 16)); v = fmaxf(v, __shfl_xor(v, 32));
                if (fq == 0) RM[(r0 + ai * HALF + m * 16) * 4 + wc] = v; }
        __syncthreads();
#pragma unroll
        for (int ai = 0; ai < 2; ++ai)
#pragma unroll
            for (int m = 0; m < 4; ++m) { const f32x4 t = *(const LAS f32x4*)(RM + (r0 + ai * HALF + m * 16) * 4); mx[ai][m] = fmaxf(fmaxf(t[0], t[1]), fmaxf(t[2], t[3])); }
#pragma unroll
        for (int ai = 0; ai < 2; ++ai)
#pragma unroll
            for (int m = 0; m < 4; ++m) { float s = 0.f; const float mm = mx[ai][m] * 1.4426950408889634f;
#pragma unroll
                for (int bj = 0; bj < 2; ++bj)
#pragma unroll
                    for (int n = 0; n < 2; ++n) { f32x4 x = acc[ai][bj][m][n];
#pragma unroll
                        for (int j = 0; j < 4; ++j) { x[j] = fast_exp2(x[j] * 1.4426950408889634f - mm); s += x[j]; }
                        acc[ai][bj][m][n] = x; }
                s += __shfl_xor(s, 16); s += __shfl_xor(s, 32);
                if (fq == 0) RS[(r0 + ai * HALF + m * 16) * 4 + wc] = s; }
        __syncthreads();
#pragma unroll
        for (int ai = 0; ai < 2; ++ai)
#pragma unroll
            for (int m = 0; m < 4; ++m) { const int r = r0 + ai * HALF + m * 16; const f32x4 t = *(const LAS f32x4*)(RS + r * 4); const float inv = 1.0f / ((t[0] + t[1]) + (t[2] + t[3]));
#pragma unroll
                for (int bj = 0; bj < 2; ++bj) { const f32x4 v0 = acc[ai][bj][m][0] * inv, v1 = acc[ai][bj][m][1] * inv;
                    u32x4 w; w.x = cvt_pk_bf16(v0[0], v0[1]); w.y = cvt_pk_bf16(v0[2], v0[3]); w.z = cvt_pk_bf16(v1[0], v1[1]); w.w = cvt_pk_bf16(v1[2], v1[3]);
                    *(u32x4*)(P + (size_t)r * 256 + bj * HALF + wc * 32 + 8 * fq) = w; } }
        (void)u; (void)wid; (void)lane;
    }
};
struct EpiStore {
    static constexpr bool PERM = true, AFTER_DRAIN = false;
    bf16_t* O; int ldc;
    __device__ __forceinline__ void operator()(AccRef acc, const Unit& u, int wr, int wc, int fr, int fq) const {
        const int r0 = wr * 64 + fr; const int col0 = u.pn * BM + wc * 32 + 8 * fq;
#pragma unroll
        for (int ai = 0; ai < 2; ++ai)
#pragma unroll
            for (int m = 0; m < 4; ++m) { bf16_t* rowp = O + (size_t)(u.pm * BM + r0 + ai * HALF + m * 16) * ldc + col0;
#pragma unroll
                for (int bj = 0; bj < 2; ++bj) { const f32x4 v0 = acc[ai][bj][m][0], v1 = acc[ai][bj][m][1];
                    u32x4 w; w.x = cvt_pk_bf16(v0[0], v0[1]); w.y = cvt_pk_bf16(v0[2], v0[3]); w.z = cvt_pk_bf16(v1[0], v1[1]); w.w = cvt_pk_bf16(v1[2], v1[3]);
                    *(u32x4*)(rowp + bj * HALF) = w; } }
    }
};
struct EpiMoeUp {
    static constexpr bool PERM = true, AFTER_DRAIN = false;
    bf16_t* H; const LAS float* rs_lds; const LAS float* wt_lds;
    __device__ __forceinline__ void operator()(AccRef acc, const Unit& u, int wr, int wc, int fr, int fq) const {
        const int r0 = wr * 64 + fr; const int col0 = u.pn * HALF + wc * 32 + 8 * fq;
#pragma unroll
        for (int ai = 0; ai < 2; ++ai)
#pragma unroll
            for (int m = 0; m < 4; ++m) { const int r = r0 + ai * HALF + m * 16; const float s = rs_lds[u.slot * 256 + r], wt = wt_lds[u.slot * 256 + r];
                f32x4 a0 = acc[ai][0][m][0] * s, a1 = acc[ai][0][m][1] * s; const f32x4 b0 = acc[ai][1][m][0] * s, b1 = acc[ai][1][m][1] * s;
#pragma unroll
                for (int j = 0; j < 4; ++j) { a0[j] = wt * a0[j] * sigmoid_f(a0[j]) * b0[j]; a1[j] = wt * a1[j] * sigmoid_f(a1[j]) * b1[j]; }
                u32x4 w; w.x = cvt_pk_bf16(a0[0], a0[1]); w.y = cvt_pk_bf16(a0[2], a0[3]); w.z = cvt_pk_bf16(a1[0], a1[1]); w.w = cvt_pk_bf16(a1[2], a1[3]);
                *(u32x4*)(H + (size_t)(u.pm + r) * 512 + col0) = w; }
    }
};
struct EpiMoeDown {
    static constexpr bool PERM = true, AFTER_DRAIN = false;
    bf16_t* YS; const LAS int* tokk_lds;
    __device__ __forceinline__ void operator()(AccRef acc, const Unit& u, int wr, int wc, int fr, int fq) const {
        const int r0 = wr * 64 + fr; const int col0 = u.pn * BM + wc * 32 + 8 * fq;
#pragma unroll
        for (int ai = 0; ai < 2; ++ai)
#pragma unroll
            for (int m = 0; m < 4; ++m) { const int r = r0 + ai * HALF + m * 16; const int tk = tokk_lds[u.slot * 256 + r];
                if (tk >= 0) { bf16_t* rowp = YS + (size_t)tk * 1024 + col0;
#pragma unroll
                    for (int bj = 0; bj < 2; ++bj) { const f32x4 v0 = acc[ai][bj][m][0], v1 = acc[ai][bj][m][1];
                        u32x4 w; w.x = cvt_pk_bf16(v0[0], v0[1]); w.y = cvt_pk_bf16(v0[2], v0[3]); w.z = cvt_pk_bf16(v1[0], v1[1]); w.w = cvt_pk_bf16(v1[2], v1[3]);
                        *(u32x4*)(rowp + bj * HALF) = w; } } }
    }
};
}
struct Args { const float* in[33]; float* out; unsigned char* ws; };
__device__ __forceinline__ const float* ARG(int k) { const __attribute__((address_space(4))) volatile unsigned long long* p = (const __attribute__((address_space(4))) volatile unsigned long long*)__builtin_amdgcn_kernarg_segment_ptr(); return (const float*)p[k]; }
struct ArgsV { unsigned char* ws; };
enum { I_X = 0, I_MEM, I_S5_NORM, I_S5_WIN, I_S5_LRE, I_S5_LIM, I_S5_LOGDT, I_S5_BRE, I_S5_BIM, I_S5_CRE, I_S5_CIM, I_S5_D, I_S5_WOUT,
       I_GM_NORM, I_GM_WIN, I_GM_VNORM, I_GM_WS, I_GM_BS, I_GM_WOUT, I_MEM_NORM, I_XA_NORM, I_XA_WQ, I_XA_WKV, I_XA_WO,
       I_MOE_NORM, I_MOE_WG, I_MOE_BG, I_MOE_WE, I_MOE_BE, I_MOE_WGATE, I_MOE_WUP, I_MOE_WDOWN, I_FINAL_NORM };

__device__ __forceinline__ void transpose_item(const float* W, int ldw, int k0, int n0, const float* ksc, float cs, bf16_t* WT, int ldt, int drow0, LAS float* scr, int lane) {
#pragma unroll 8
    for (int i = 0; i < 32; ++i) { const int kk = 2 * i + (lane >> 5); const float sc = ksc ? ksc[k0 + kk] * cs : cs;
        scr[kk * 33 + (lane & 31)] = W[(size_t)(k0 + kk) * ldw + n0 + (lane & 31)] * sc; }
    asm volatile("s_waitcnt lgkmcnt(0)" ::: "memory");
    const int c = lane & 7;
#pragma unroll
    for (int j = 0; j < 4; ++j) { const int n = (lane >> 3) + 8 * j; const LAS float* s = scr + (8 * c) * 33 + n;
        u32x4 o; o.x = cvt_pk_bf16(s[0 * 33], s[1 * 33]); o.y = cvt_pk_bf16(s[2 * 33], s[3 * 33]); o.z = cvt_pk_bf16(s[4 * 33], s[5 * 33]); o.w = cvt_pk_bf16(s[6 * 33], s[7 * 33]);
        *(u32x4*)(WT + (size_t)(drow0 + n) * ldt + k0 + 8 * c) = o; }
    asm volatile("s_waitcnt lgkmcnt(0)" ::: "memory");
}
__device__ __forceinline__ int glu_row(int j0, int part) { return (j0 >> 7) * 256 + part * 128 + (j0 & 127); }

__device__ __forceinline__ void p0_weights(const ArgsV& a, LAS unsigned char* lds, int gw, int NGW, int wave, int lane) {
    LAS float* scr = (LAS float*)(lds + wave * 16384);
    unsigned char* ws = a.ws;
    constexpr int N_DENSE = 8704, N_MOE = 49152, TOTAL = N_DENSE + N_MOE;
    for (int L = gw; L < TOTAL; L += NGW) {
        if (L < 512) { const int kb = L / 32, nb = L % 32;
            transpose_item(ARG(I_S5_WIN), 1024, kb * 64, nb * 32, ARG(I_S5_NORM), 1.f, (bf16_t*)(ws + WS_W_S5IN), 1024, nb * 32, scr, lane);
        } else if (L < 1536) { const int r = L - 512, kb = r / 64, nb = r % 64, n0 = nb * 32;
            transpose_item(ARG(I_S5_WOUT), 2048, kb * 64, n0, nullptr, 1.f, (bf16_t*)(ws + WS_W_S5OUT), 1024, glu_row(n0 & 1023, n0 >> 10), scr, lane);
        } else if (L < 3584) { const int r = L - 1536, kb = r / 128, nb = r % 128;
            transpose_item(ARG(I_GM_WIN), 4096, kb * 64, nb * 32, ARG(I_GM_NORM), 1.f, (bf16_t*)(ws + WS_W_GMIN), 1024, nb * 32, scr, lane);
        } else if (L < 4608) { const int r = L - 3584, kb = r / 32, nb = r % 32;
            transpose_item(ARG(I_GM_WOUT), 1024, kb * 64, nb * 32, nullptr, 1.f, (bf16_t*)(ws + WS_W_GMOUT), 2048, nb * 32, scr, lane);
        } else if (L < 5632) { const int r = L - 4608, l = r / 512, it = r % 512, kb = it / 32, nb = it % 32;
            transpose_item(ARG(I_XA_WQ) + (size_t)l * 1048576, 1024, kb * 64, nb * 32, ARG(I_XA_NORM) + l * 1024, 0.0625f, (bf16_t*)(ws + WS_W_XA + l * 8 * MiB), 1024, nb * 32, scr, lane);
        } else if (L < 7680) { const int r = L - 5632, l = r / 1024, it = r % 1024, kb = it / 64, nb = it % 64, n0 = nb * 32;
            transpose_item(ARG(I_XA_WKV) + (size_t)l * 2097152, 2048, kb * 64, n0, ARG(I_MEM_NORM), 1.f, (bf16_t*)(ws + WS_W_XA + l * 8 * MiB + (n0 < 1024 ? 2 : 4) * MiB), 1024, n0 & 1023, scr, lane);
        } else if (L < N_DENSE) { const int r = L - 7680, l = r / 512, it = r % 512, kb = it / 32, nb = it % 32;
            transpose_item(ARG(I_XA_WO) + (size_t)l * 1048576, 1024, kb * 64, nb * 32, nullptr, 1.f, (bf16_t*)(ws + WS_W_XA + l * 8 * MiB + 6 * MiB), 1024, nb * 32, scr, lane);
        } else { const int r = L - N_DENSE; const int kind = r / 16384, q = r % 16384, mat = q / 256, it = q % 256, l = mat / 32, e = mat % 32;
            if (kind < 2) { const int kb = it / 16, nb = it % 16, n0 = nb * 32;
                transpose_item(ARG(kind == 0 ? I_MOE_WGATE : I_MOE_WUP) + (size_t)mat * 524288, 512, kb * 64, n0, ARG(I_MOE_NORM) + l * 1024, 1.f,
                               (bf16_t*)(ws + WS_W_MOE + l * MOE_L_STRIDE) + (size_t)e * 1048576, 1024, glu_row(n0, kind), scr, lane);
            } else { const int kb = it / 32, nb = it % 32;
                transpose_item(ARG(I_MOE_WDOWN) + (size_t)mat * 524288, 1024, kb * 64, nb * 32, nullptr, 1.f,
                               (bf16_t*)(ws + WS_W_MOE + l * MOE_L_STRIDE + MOE_D_OFF) + (size_t)e * 524288, 512, nb * 32, scr, lane);
            }
        }
    }
}
__device__ __forceinline__ float row_to_bf16(const float* xrow, bf16_t* orow, int lane) {
    const f32x4* xr = (const f32x4*)xrow + lane; float s = 0.f; u32x2* o8 = (u32x2*)orow + lane;
#pragma unroll
    for (int j = 0; j < 4; ++j) { const f32x4 v = xr[64 * j]; u32x2 w; w.x = cvt_pk_bf16(v[0], v[1]); w.y = cvt_pk_bf16(v[2], v[3]); o8[64 * j] = w;
        s += bflo(w.x) * bflo(w.x) + bfhi(w.x) * bfhi(w.x) + bflo(w.y) * bflo(w.y) + bfhi(w.y) * bfhi(w.y); }
    return 1.0f / sqrtf(wave_sum(s) * (1.0f / 1024.0f) + RMS_EPS);
}
__device__ __forceinline__ void p0_rows(const ArgsV& a, int gw, int NGW, int lane) {
    unsigned char* ws = a.ws; bf16_t* X = (bf16_t*)(ws + WS_X); float* rinvA = (float*)(ws + WS_SMALL + SM_RINVA);
    for (int m = gw; m < T_TOK; m += NGW) { const float r = row_to_bf16(ARG(I_X) + (size_t)m * 1024, X + (size_t)m * 1024, lane); if (lane == 0) rinvA[m] = r; }
    if (gw == 0) { u32x4* z = (u32x4*)(X + (size_t)T_TOK * 1024); z[lane] = (u32x4){0u, 0u, 0u, 0u}; z[lane + 64] = (u32x4){0u, 0u, 0u, 0u}; }
    bf16_t* MB = (bf16_t*)(ws + WS_MEMBF); float* rinvM = (float*)(ws + WS_SMALL + SM_RINVMEM);
    for (int m = gw; m < MEMR; m += NGW) { const float r = row_to_bf16(ARG(I_MEM) + (size_t)m * 1024, MB + (size_t)m * 1024, lane); if (lane == 0) rinvM[m] = r; }
    bf16_t* RT = (bf16_t*)(ws + WS_W_RT);
    for (int i = gw * 64 + lane; i < 2 * 48 * 1024; i += NGW * 64) { const int l = i / (48 * 1024), r = i % (48 * 1024), n = r / 1024, k = r % 1024;
        float v = 0.f;
        if (n < 4) v = ARG(I_MOE_WG)[(size_t)l * 4096 + k * 4 + n]; else if (n < 36) v = ARG(I_MOE_WE)[(size_t)l * 32768 + k * 32 + (n - 4)];
        v *= ARG(I_MOE_NORM)[l * 1024 + k];
        const unsigned hi = f2bf(v); const unsigned lo = f2bf(v - bf2f(hi));
        RT[(size_t)l * 98304 + n * 1024 + k] = (bf16_t)hi; RT[(size_t)l * 98304 + (48 + n) * 1024 + k] = (bf16_t)lo; }
}
__device__ __forceinline__ void p0_s5_tables(const ArgsV& a, LAS unsigned char* lds, int job, int tid) {
    const int g = job >> 2, qd = job & 3;
    LAS float* ABR = (LAS float*)lds;
    LAS float* ABI = ABR + 17 * 64;
    LAS float* CR = ABI + 17 * 64;
    LAS float* CI = CR + 1024;
    LAS float* BR = CI + 1024;
    LAS float* BI = BR + 1024;
    __syncthreads();
    if (tid < 64) { const int p = tid; const float lr = ARG(I_S5_LRE)[g * 64 + p], li = ARG(I_S5_LIM)[g * 64 + p], dt = expf(ARG(I_S5_LOGDT)[g]);
        for (int lag = 0; lag <= 16; ++lag) { const float mag = expf(lr * dt * (float)lag); float sn, cs; sincosf(li * dt * (float)lag, &sn, &cs); ABR[lag * 64 + p] = mag * cs; ABI[lag * 64 + p] = mag * sn; }
        const float ar = ABR[64 + p], ai = ABI[64 + p], den = lr * lr + li * li;
        const float cre = ((ar - 1.0f) * lr + ai * li) / den, cim = (ai * lr - (ar - 1.0f) * li) / den;
        for (int n = 0; n < 16; ++n) { const float br = ARG(I_S5_BRE)[(size_t)(g * 64 + p) * 16 + n], bi = ARG(I_S5_BIM)[(size_t)(g * 64 + p) * 16 + n];
            BR[p * 16 + n] = cre * br - cim * bi; BI[p * 16 + n] = cre * bi + cim * br; } }
    for (int i = tid; i < 1024; i += NTHR) { CR[i] = ARG(I_S5_CRE)[(size_t)g * 1024 + i]; CI[i] = ARG(I_S5_CIM)[(size_t)g * 1024 + i]; }
    __syncthreads();
    bf16_t* AF = (bf16_t*)(a.ws + WS_SCR + SC_S5A) + (size_t)g * 256 * 384;
    for (int e = tid; e < 64 * 384; e += NTHR) { const int r = qd * 64 + e / 384, k = e % 384, tl = r >> 4, n = r & 15; float v = 0.f;
        if (k < 256) { const int s = k >> 4, np = k & 15;
            if (s <= tl) { const int lag = tl - s; float acc = 0.f;
                for (int p = 0; p < 64; ++p) { const float ar = ABR[lag * 64 + p], ai = ABI[lag * 64 + p], br = BR[p * 16 + np], bi = BI[p * 16 + np];
                    const float wr_ = ar * br - ai * bi, wi_ = ar * bi + ai * br; acc += CR[n * 64 + p] * wr_ - CI[n * 64 + p] * wi_; }
                v = acc; if (s == tl && np == n) v += ARG(I_S5_D)[g * 16 + n]; }
        } else { const int ci = k - 256, p = ci & 63; const float ar = ABR[(tl + 1) * 64 + p], ai = ABI[(tl + 1) * 64 + p], cr = CR[n * 64 + p], cim = CI[n * 64 + p];
            v = (ci < 64) ? (cr * ar - cim * ai) : -(cr * ai + cim * ar); }
        AF[(size_t)r * 384 + k] = (bf16_t)f2bf(v); }
    bf16_t* MS = (bf16_t*)(a.ws + WS_SCR + SC_S5M) + (size_t)g * 128 * 256;
    for (int e = tid; e < 32 * 256; e += NTHR) { const int pp = qd * 32 + e / 256, k = e % 256, s = k >> 4, np = k & 15, p = pp & 63;
        const float ar = ABR[(15 - s) * 64 + p], ai = ABI[(15 - s) * 64 + p], br = BR[p * 16 + np], bi = BI[p * 16 + np];
        const float v = (pp < 64) ? (ar * br - ai * bi) : (ar * bi + ai * br);
        MS[(size_t)pp * 256 + k] = (bf16_t)f2bf(v); }
    if (qd == 0 && tid < 64) { float* AB = (float*)(a.ws + WS_SMALL + SM_AB16) + (size_t)(g * 64 + tid) * 2; AB[0] = ABR[16 * 64 + tid]; AB[1] = ABI[16 * 64 + tid]; }
}

template <class Sched>
__device__ __forceinline__ void fill_rs(const Sched& S, LAS float* rs_lds, const float* direct, const float* part, int nslots, int tid) {
    g8::Unit u;
    for (int i = 0; i < 8 && S.next(i, u); ++i) {
        if (tid < 256) { const int row = u.pm * 256 + tid; float v;
            if (direct) v = direct[row];
            else { float s = 0.f; const f32x4* p = (const f32x4*)(part + (size_t)row * 32); for (int j = 0; j < nslots / 4; ++j) { const f32x4 t = p[j]; s += (t[0] + t[1]) + (t[2] + t[3]); } v = 1.0f / sqrtf(s * (1.0f / 1024.0f) + RMS_EPS); }
            rs_lds[i * 256 + tid] = v; }
    }
    __syncthreads();
}

struct S5Sched {
    int b, g;
    __device__ __forceinline__ bool next(int i, g8::Unit& u) const { if (i >= 2) return false;
        const int bt = b * 2 + i;
        const unsigned off = (unsigned)bt * (256u * 32768u) + (unsigned)g * 32u;
        u.A = (unsigned)(WS_SCR + SC_U) + off; u.A2 = (unsigned)(WS_SCR + SC_H2) + off; u.B = (unsigned)(WS_SCR + SC_S5A) + (unsigned)g * (256u * 768u); u.pm = bt; u.pn = 0; u.slot = i; u.aux = g; return true; }
};
__device__ __forceinline__ void s5_scan_pair(const ArgsV& a, LAS unsigned char* lds, int b, int g, int tid, int wave, int lane) {
    unsigned char* ws = a.ws;
    const bf16_t* U = (const bf16_t*)(ws + WS_SCR + SC_U); bf16_t* H2 = (bf16_t*)(ws + WS_SCR + SC_H2);
    const bf16_t* MS = (const bf16_t*)(ws + WS_SCR + SC_S5M) + (size_t)g * 128 * 256;
    LAS bf16_t* ML = (LAS bf16_t*)lds; LAS float* SL = (LAS float*)(lds + 67584);
    __syncthreads();
    for (int i = tid; i < 128 * 32; i += NTHR) { const int r = i >> 5, c = i & 31; *(LAS u32x4*)(ML + r * 264 + c * 8) = *(const u32x4*)(MS + r * 256 + c * 8); }
    __syncthreads();
    float hr = 0.f, hi = 0.f, a16r = 0.f, a16i = 0.f;
    if (tid < 64) { const float* AB = (const float*)(ws + WS_SMALL + SM_AB16) + (size_t)(g * 64 + tid) * 2; a16r = AB[0]; a16i = AB[1]; }
    const int fr = lane & 15, fq = lane >> 4;
    for (int qt = 0; qt < 4; ++qt) {
        { const int blk0 = b * 512 + (qt * 8 + wave) * 16;
          f32x4 acc[8];
#pragma unroll
          for (int mt = 0; mt < 8; ++mt) acc[mt] = (f32x4){0.f, 0.f, 0.f, 0.f};
#pragma unroll 2
          for (int ks = 0; ks < 8; ++ks) {
              const bf16x8 yb = *(const bf16x8*)(U + ((size_t)(blk0 + fr) * 16 + 2 * ks + (lane >> 5)) * 1024 + g * 16 + 8 * (fq & 1));
#pragma unroll
              for (int mt = 0; mt < 8; ++mt) { const bf16x8 xa = *(const LAS bf16x8*)(ML + (mt * 16 + fr) * 264 + ks * 32 + fq * 8);
                  acc[mt] = __builtin_amdgcn_mfma_f32_16x16x32_bf16(xa, yb, acc[mt], 0, 0, 0); } }
#pragma unroll
          for (int mt = 0; mt < 8; ++mt) *(LAS f32x4*)(SL + (wave * 16 + fr) * 128 + mt * 16 + fq * 4) = acc[mt];
        }
        __syncthreads();
        if (tid < 64) { const int p = tid;
            for (int j = 0; j < 128; ++j) { const int blk = b * 512 + qt * 128 + j;
                bf16_t* hrow = H2 + (size_t)blk * 16 * 1024 + g * 16;
                hrow[(size_t)(p >> 4) * 1024 + (p & 15)] = (bf16_t)f2bf(hr); hrow[(size_t)(4 + (p >> 4)) * 1024 + (p & 15)] = (bf16_t)f2bf(hi);
                const float sr = SL[j * 128 + p], si = SL[j * 128 + 64 + p];
                const float nr = a16r * hr - a16i * hi + sr, ni = a16r * hi + a16i * hr + si; hr = nr; hi = ni; } }
        __syncthreads();
    }
    asm volatile("s_waitcnt vmcnt(0)" ::: "memory");
    __syncthreads();
    S5Sched S{b, g};
    g8::EpiS5B E{(bf16_t*)(ws + WS_SCR + SC_Y)};
    g8::gemm_phase<g8::EpiS5B, S5Sched, 2, 32768, 768, 8192, 128, 6, 4>(lds, (const char*)ws, S, E, nullptr);
}

struct OneSched { g8::Unit u0; __device__ __forceinline__ bool next(int i, g8::Unit& u) const { if (i) return false; u = u0; return true; } };
__device__ __forceinline__ void attn_phase(const ArgsV& a, LAS unsigned char* lds, int layer, int G, int c) {
    unsigned char* ws = a.ws;
    bf16_t* O = (bf16_t*)(ws + WS_SCR + SC_O);
    const unsigned Kb = (unsigned)WS_KV + (unsigned)layer * (unsigned)(4 * MiB), Vt = Kb + (unsigned)(2 * MiB);
    const unsigned Poff = (unsigned)(WS_SCR + SC_P) + (unsigned)blockIdx.x * 131072u;
    for (int it = c; it < 512; it += G) {
        const int rt = it >> 2, h = it & 3, b = rt >> 5;
        { OneSched S; S.u0.A = (unsigned)(WS_SCR + SC_Q) + (unsigned)rt * (256u * 2048u) + (unsigned)h * 512u; S.u0.A2 = S.u0.A; S.u0.B = Kb + (unsigned)b * (256u * 2048u) + (unsigned)h * 512u; S.u0.pm = 0; S.u0.pn = 0; S.u0.slot = 0; S.u0.aux = 0;
          g8::EpiSoftmax E{(bf16_t*)(ws + Poff)};
          g8::gemm_phase<g8::EpiSoftmax, OneSched, 0, 2048, 2048, 128, 128, 4, 4>(lds, (const char*)ws, S, E, nullptr); }
        asm volatile("s_waitcnt vmcnt(0)" ::: "memory");
        __syncthreads();
        { OneSched S; S.u0.A = Poff; S.u0.A2 = S.u0.A; S.u0.B = Vt + (unsigned)h * (256u * 2048u) + (unsigned)b * 512u; S.u0.pm = rt; S.u0.pn = h; S.u0.slot = 0; S.u0.aux = 0;
          g8::EpiStore E{O, 1024};
          g8::gemm_phase<g8::EpiStore, OneSched, 0, 512, 2048, 128, 128, 4, 4>(lds, (const char*)ws, S, E, nullptr); }
        asm volatile("s_waitcnt vmcnt(0)" ::: "memory");
        __syncthreads();
    }
}

__device__ __forceinline__ void router_phase(const ArgsV& a, LAS unsigned char* lds, int layer, int G, int tid, int wave, int lane) {
    unsigned char* ws = a.ws;
    const bf16_t* X = (const bf16_t*)(ws + WS_X); const bf16_t* RT = (const bf16_t*)(ws + WS_W_RT) + (size_t)layer * 98304;
    float* rinvB = (float*)(ws + WS_SMALL + SM_RINVB); float* wts = (float*)(ws + WS_SMALL + SM_WTS);
    unsigned* cnt = (unsigned*)(ws + WS_CTL) + CW_CNT + layer * 64; int* list = (int*)(ws + WS_LIST);
    LAS float* LG = (LAS float*)lds;
    LAS int* HIST = (LAS int*)(lds + 32768);
    LAS int* ASG = (LAS int*)(lds + 33024);
    const int fr = lane & 15, fq = lane >> 4;
    for (int it = blockIdx.x; it < T_TOK / 128; it += G) {
        __syncthreads();
        if (tid < 64) HIST[tid] = 0;
        const int tok0 = it * 128 + wave * 16;
        f32x4 acc[6];
#pragma unroll
        for (int j = 0; j < 6; ++j) acc[j] = (f32x4){0.f, 0.f, 0.f, 0.f};
        float ss = 0.f;
        const bf16_t* xrow = X + (size_t)(tok0 + fr) * 1024 + fq * 8;
#pragma unroll 2
        for (int ks = 0; ks < 32; ++ks) {
            const bf16x8 xa = *(const bf16x8*)(xrow + ks * 32);
            { const u32x4 w = __builtin_bit_cast(u32x4, xa); ss += bflo(w.x) * bflo(w.x) + bfhi(w.x) * bfhi(w.x) + bflo(w.y) * bflo(w.y) + bfhi(w.y) * bfhi(w.y) + bflo(w.z) * bflo(w.z) + bfhi(w.z) * bfhi(w.z) + bflo(w.w) * bflo(w.w) + bfhi(w.w) * bfhi(w.w); }
#pragma unroll
            for (int j = 0; j < 6; ++j) { const bf16x8 wb = *(const bf16x8*)(RT + (size_t)(j * 16 + fr) * 1024 + ks * 32 + fq * 8);
                acc[j] = __builtin_amdgcn_mfma_f32_16x16x32_bf16(xa, wb, acc[j], 0, 0, 0); } }
        ss += __shfl_xor(ss, 16); ss += __shfl_xor(ss, 32);
        const float rinv = 1.0f / sqrtf(ss * (1.0f / 1024.0f) + RMS_EPS);
        if (fq == 0) rinvB[tok0 + fr] = rinv;
#pragma unroll
        for (int reg = 0; reg < 4; ++reg) { const float rv = __shfl(rinv, fq * 4 + reg);
#pragma unroll
            for (int j = 0; j < 3; ++j) { const int n = j * 16 + fr; if (n < 40) LG[(wave * 16 + fq * 4 + reg) * 40 + n] = (acc[j][reg] + acc[j + 3][reg]) * rv; } }
        __syncthreads();
        if (tid < 128) { const int t = tid; const LAS float* lg = LG + t * 40;
            float gl[4]; int gsel = 0; float gm = -3.0e38f;
#pragma unroll
            for (int j = 0; j < 4; ++j) { gl[j] = lg[j] + ARG(I_MOE_BG)[layer * 4 + j]; if (gl[j] > gm) { gm = gl[j]; gsel = j; } }
            float gs = 0.f;
#pragma unroll
            for (int j = 0; j < 4; ++j) gs += expf(gl[j] - gm);
            const float wg = 1.0f / gs;
            float v0 = -3.0e38f, v1 = -3.0e38f; int i0 = 0, i1 = 0;
            for (int j = 0; j < 8; ++j) { const float v = lg[4 + gsel * 8 + j] + ARG(I_MOE_BE)[layer * 32 + gsel * 8 + j];
                if (v > v0) { v1 = v0; i1 = i0; v0 = v; i0 = j; } else if (v > v1) { v1 = v; i1 = j; } }
            const float e1 = expf(v1 - v0), den = 1.0f / (1.0f + e1);
            const int tok = it * 128 + t; const int ea = gsel * 8 + i0, eb = gsel * 8 + i1;
            wts[(size_t)tok * 2] = wg * den; wts[(size_t)tok * 2 + 1] = wg * e1 * den;
            ASG[t * 4] = ea; ASG[t * 4 + 1] = atomicAdd((int*)&HIST[ea], 1); ASG[t * 4 + 2] = eb; ASG[t * 4 + 3] = atomicAdd((int*)&HIST[eb], 1); }
        __syncthreads();
        if (tid < 32) { const int n = HIST[tid]; HIST[32 + tid] = n ? (int)atomicAdd(&cnt[tid], (unsigned)n) : 0; }
        __syncthreads();
        if (tid < 128) { const int tok = it * 128 + tid; const int ea = ASG[tid * 4], eb = ASG[tid * 4 + 2];
            list[(size_t)ea * 32768 + HIST[32 + ea] + ASG[tid * 4 + 1]] = tok * 2; list[(size_t)eb * 32768 + HIST[32 + eb] + ASG[tid * 4 + 3]] = tok * 2 + 1; }
    }
}

struct MoeSched {
    unsigned A, Bw, bstride  , btile  ; const LAS int* TP; int G, c; unsigned arow  ;
    __device__ __forceinline__ bool next(int i, g8::Unit& u) const {
        const int uidx = i * G + (c & 7) * (G >> 3) + (c >> 3); const int ntile = TP[32];
        if (uidx >= ntile * 4) return false;
        const int rtile = uidx >> 2, pn = uidx & 3; int e = 0;
        for (int j = 1; j < 32; ++j) e += (TP[j] <= rtile) ? 1 : 0;
        u.A = A + (unsigned)rtile * 256u * arow; u.A2 = u.A; u.B = Bw + (unsigned)e * bstride + (unsigned)pn * btile;
        u.pm = rtile * 256; u.pn = pn; u.slot = i; u.aux = e | ((rtile - TP[e]) << 8); return true; }
};
__device__ __forceinline__ void moe_tables(const ArgsV& a, LAS unsigned char* lds, int layer, const MoeSched& S, int tid) {
    unsigned char* ws = a.ws; const unsigned* cnt = (const unsigned*)(ws + WS_CTL) + CW_CNT + layer * 64; const int* list = (const int*)(ws + WS_LIST);
    const float* rinvB = (const float*)(ws + WS_SMALL + SM_RINVB); const float* wts = (const float*)(ws + WS_SMALL + SM_WTS);
    LAS int* TP = (LAS int*)(lds + LX_TAB); LAS int* TOK = TP + 64; LAS float* RS = (LAS float*)(TOK + 5 * 256); LAS float* WT = RS + 5 * 256; LAS int* TOKK = (LAS int*)(WT + 5 * 256);
    __syncthreads();
    if (tid == 0) { int s = 0; for (int e = 0; e < 32; ++e) { TP[e] = s; s += ((int)cnt[e] + 255) >> 8; } TP[32] = s; }
    __syncthreads();
    g8::Unit u;
    for (int i = 0; i < 5 && S.next(i, u); ++i) {
        if (tid < 256) { const int e = u.aux & 255, rt = u.aux >> 8; const int pos = rt * 256 + tid; const int n = (int)cnt[e];
            int tok = T_TOK, tk = -1; float rs = 0.f, wt = 0.f;
            if (pos < n) { tk = list[(size_t)e * 32768 + pos]; tok = tk >> 1; rs = rinvB[tok]; wt = wts[tk]; }
            TOK[i * 256 + tid] = tok; RS[i * 256 + tid] = rs; WT[i * 256 + tid] = wt; TOKK[i * 256 + tid] = tk; }
    }
    __syncthreads();
}
__device__ __forceinline__ void combine_phase(const ArgsV& a, int gw, int NGW, int lane, bool last) {
    unsigned char* ws = a.ws; bf16_t* X = (bf16_t*)(ws + WS_X); const bf16_t* YS = (const bf16_t*)(ws + WS_SCR + SC_YS); float* rinvA = (float*)(ws + WS_SMALL + SM_RINVA);
    for (int m = gw; m < T_TOK; m += NGW) {
        u32x4* xp = (u32x4*)(X + (size_t)m * 1024) + lane; const u32x4* y0 = (const u32x4*)(YS + (size_t)m * 2048) + lane; const u32x4* y1 = y0 + 128;
        float v[2][8]; float s = 0.f;
#pragma unroll
        for (int j = 0; j < 2; ++j) { const u32x4 xv = xp[64 * j], p = y0[64 * j], q = y1[64 * j];
            v[j][0] = bflo(xv.x) + bflo(p.x) + bflo(q.x); v[j][1] = bfhi(xv.x) + bfhi(p.x) + bfhi(q.x); v[j][2] = bflo(xv.y) + bflo(p.y) + bflo(q.y); v[j][3] = bfhi(xv.y) + bfhi(p.y) + bfhi(q.y);
            v[j][4] = bflo(xv.z) + bflo(p.z) + bflo(q.z); v[j][5] = bfhi(xv.z) + bfhi(p.z) + bfhi(q.z); v[j][6] = bflo(xv.w) + bflo(p.w) + bflo(q.w); v[j][7] = bfhi(xv.w) + bfhi(p.w) + bfhi(q.w); }
        if (!last) {
#pragma unroll
            for (int j = 0; j < 2; ++j) { u32x4 w; w.x = cvt_pk_bf16(v[j][0], v[j][1]); w.y = cvt_pk_bf16(v[j][2], v[j][3]); w.z = cvt_pk_bf16(v[j][4], v[j][5]); w.w = cvt_pk_bf16(v[j][6], v[j][7]); xp[64 * j] = w;
                s += bflo(w.x) * bflo(w.x) + bfhi(w.x) * bfhi(w.x) + bflo(w.y) * bflo(w.y) + bfhi(w.y) * bfhi(w.y) + bflo(w.z) * bflo(w.z) + bfhi(w.z) * bfhi(w.z) + bflo(w.w) * bflo(w.w) + bfhi(w.w) * bfhi(w.w); }
            const float r = 1.0f / sqrtf(wave_sum(s) * (1.0f / 1024.0f) + RMS_EPS); if (lane == 0) rinvA[m] = r;
        } else {
#pragma unroll
            for (int j = 0; j < 2; ++j)
#pragma unroll
                for (int k = 0; k < 8; ++k) s += v[j][k] * v[j][k];
            const float r = 1.0f / sqrtf(wave_sum(s) * (1.0f / 1024.0f) + RMS_EPS);
#pragma unroll
            for (int j = 0; j < 2; ++j) { const f32x4* gp = (const f32x4*)(ARG(I_FINAL_NORM) + (64 * j + lane) * 8); const f32x4 g0 = gp[0], g1 = gp[1];
                f32x4* op = (f32x4*)(((float*)ARG(33)) + (size_t)m * 1024 + (64 * j + lane) * 8);
                op[0] = (f32x4){v[j][0] * r * g0[0], v[j][1] * r * g0[1], v[j][2] * r * g0[2], v[j][3] * r * g0[3]};
                op[1] = (f32x4){v[j][4] * r * g1[0], v[j][5] * r * g1[1], v[j][6] * r * g1[2], v[j][7] * r * g1[3]}; }
        }
    }
}

__device__ __forceinline__ void spatial_phase(const ArgsV& a, LAS unsigned char* lds, int G, int tid, int wave, int lane) {
    unsigned char* ws = a.ws; bf16_t* Z = (bf16_t*)(ws + WS_SCR + SC_Z); const float* part = (const float*)(ws + WS_PART);
    LAS float* RV = (LAS float*)lds;
    LAS bf16_t* WL = (LAS bf16_t*)(lds + 512);
    LAS bf16_t* ZL = (LAS bf16_t*)(lds + 512 + 34816);
    const int fr = lane & 15, fq = lane >> 4;
    for (int it = blockIdx.x; it < 2048; it += G) {
        const int span = it >> 3, gg = it & 7; const size_t row0 = (size_t)span * 128;
        __syncthreads();
        if (tid < 128) { float s = 0.f; const f32x4* p = (const f32x4*)(part + (row0 + tid) * 32);
#pragma unroll
            for (int j = 0; j < 8; ++j) { const f32x4 t = p[j]; s += (t[0] + t[1]) + (t[2] + t[3]); }
            RV[tid] = 1.0f / sqrtf(s * (1.0f / 2048.0f) + RMS_EPS); }
        for (int i = tid; i < 128 * 32; i += NTHR) { const int j = i >> 5, c8 = i & 31; const u32x4 v = *(const u32x4*)(Z + (row0 + j) * 4096 + 2048 + gg * 256 + c8 * 8);
            LAS unsigned* d = (LAS unsigned*)(ZL + j * 258 + c8 * 8); d[0] = v.x; d[1] = v.y; d[2] = v.z; d[3] = v.w; }
        __syncthreads();
        for (int i = tid; i < 128 * 32; i += NTHR) { const int r = i >> 5, c4 = (i & 31) * 4; const f32x4 w = *(const f32x4*)(ARG(I_GM_WS) + ((size_t)gg * 128 + r) * 128 + c4);
            const bool msk = (r < 64) && (c4 >= 64);
            u32x2 o; o.x = msk ? 0u : cvt_pk_bf16(w[0] * RV[c4], w[1] * RV[c4 + 1]); o.y = msk ? 0u : cvt_pk_bf16(w[2] * RV[c4 + 2], w[3] * RV[c4 + 3]);
            *(LAS u32x2*)(WL + r * 136 + c4) = o; }
        __syncthreads();
        f32x4 acc[8][2];
#pragma unroll
        for (int mt = 0; mt < 8; ++mt) { acc[mt][0] = (f32x4){0.f, 0.f, 0.f, 0.f}; acc[mt][1] = (f32x4){0.f, 0.f, 0.f, 0.f}; }
#pragma unroll
        for (int ks = 0; ks < 4; ++ks) {
            bf16x8 za[2];
#pragma unroll
            for (int nt2 = 0; nt2 < 2; ++nt2) { const int c = wave * 32 + nt2 * 16 + fr; const LAS bf16_t* zp = ZL + (ks * 32 + fq * 8) * 258 + c;
                bf16x8 t;
#pragma unroll
                for (int jj = 0; jj < 8; ++jj) t[jj] = (short)zp[jj * 258];
                za[nt2] = t; }
#pragma unroll
            for (int mt = 0; mt < 8; ++mt) { const bf16x8 wb = *(const LAS bf16x8*)(WL + (mt * 16 + fr) * 136 + ks * 32 + fq * 8);
                acc[mt][0] = __builtin_amdgcn_mfma_f32_16x16x32_bf16(za[0], wb, acc[mt][0], 0, 0, 0);
                acc[mt][1] = __builtin_amdgcn_mfma_f32_16x16x32_bf16(za[1], wb, acc[mt][1], 0, 0, 0); } }
#pragma unroll
        for (int nt2 = 0; nt2 < 2; ++nt2) { const int c = gg * 256 + wave * 32 + nt2 * 16 + fq * 4; const f32x4 vn = *(const f32x4*)(ARG(I_GM_VNORM) + c);
#pragma unroll
            for (int mt = 0; mt < 8; ++mt) { const int i = mt * 16 + fr; const float bs = ARG(I_GM_BS)[gg * 128 + i];
                u32x2* up = (u32x2*)(Z + (row0 + i) * 4096 + c); const u32x2 uv = *up; const f32x4 m = acc[mt][nt2];
                u32x2 o; o.x = cvt_pk_bf16(bflo(uv.x) * (vn[0] * m[0] + bs), bfhi(uv.x) * (vn[1] * m[1] + bs)); o.y = cvt_pk_bf16(bflo(uv.y) * (vn[2] * m[2] + bs), bfhi(uv.y) * (vn[3] * m[3] + bs));
                *up = o; } }
    }
}
struct KvSched {
    int G, c;
    __device__ __forceinline__ bool next(int i, g8::Unit& u) const {
        const int idx = i * G + c; if (idx >= 64) return false;
        const int gm = idx >> 4, pm = (idx >> 2) & 3, pn = idx & 3, l = gm >> 1, kind = gm & 1;
        const unsigned W = (unsigned)WS_W_XA + (unsigned)l * (unsigned)(8 * MiB) + (unsigned)((kind ? 4 : 2) * MiB), MB = (unsigned)WS_MEMBF;
        const unsigned Ab = kind ? W : MB, Bb = kind ? MB : W;
        u.A = Ab + (unsigned)pm * (256u * 2048u); u.A2 = u.A; u.B = Bb + (unsigned)pn * (256u * 2048u); u.pm = pm; u.pn = pn; u.slot = i; u.aux = gm; return true; }
};

#ifndef ONLY
#define ONLY -1
#endif
#define PH(n) (ONLY < 0 || ONLY == (n))
#define PHASE_CTX \
    ArgsV a; a.ws = (unsigned char*)ARG(34); unsigned char* ws = a.ws; const char* wsb = (const char*)ws; (void)wsb; \
    int tid_ = threadIdx.x; asm volatile("" : "+v"(tid_)); const int tid = tid_, lane = tid & 63, wave = __builtin_amdgcn_readfirstlane(tid >> 6); \
    const int G = gridDim.x, c = blockIdx.x, gw = c * NWAVES + wave, NGW = G * NWAVES; (void)gw; (void)NGW; (void)lane; \
    LAS float* RSL = (LAS float*)(lds + LX_TAB); bf16_t* X = (bf16_t*)(ws + WS_X); float* part = (float*)(ws + WS_PART); const float* rinvA = (const float*)(ws + WS_SMALL + SM_RINVA); \
    (void)RSL; (void)X; (void)part; (void)rinvA;
#define GRID_BAR() do { XcdBarrier bar_; bar_.bar = (unsigned*)((unsigned char*)ARG(34) + WS_CTL) + CW_BAR; bar_.x = xb_xcc_id(); bar_.st = (volatile LAS unsigned*)(lds + LX_MISC) + 8; xcd_barrier(bar_); } while (0)
typedef g8::StdSched<128, 4, 256u * 2048u, 256u * 2048u> SchedN1024;

__global__ void __launch_bounds__(NTHR, 2) fwd_megakernel(Args a_unused) {
    extern __shared__ __attribute__((aligned(16))) unsigned char lds_raw[];
    LAS unsigned char* lds = (LAS unsigned char*)lds_raw;
    { volatile LAS unsigned* MISC = (volatile LAS unsigned*)(lds + LX_MISC);
      if (threadIdx.x < 64) MISC[threadIdx.x] = 0u;
      __syncthreads();
      (void)xcd_barrier_post((unsigned*)((unsigned char*)ARG(34) + WS_CTL) + CW_BAR, MISC + 8); }

    if (PH(0)) { PHASE_CTX
      for (int job = c; job < 256; job += G) p0_s5_tables(a, lds, job, tid);
      __syncthreads();
      p0_weights(a, lds, gw, NGW, wave, lane);
      p0_rows(a, gw, NGW, lane); }
    GRID_BAR();

    if (PH(1)) { PHASE_CTX
      SchedN1024 S{(unsigned)WS_X, (unsigned)WS_W_S5IN, G, c};
      fill_rs(S, RSL, rinvA, nullptr, 0, tid);
      g8::EpiRowScale E{(bf16_t*)(ws + WS_SCR + SC_U), 1024, RSL};
      g8::gemm_phase<g8::EpiRowScale, SchedN1024, 0, 2048, 2048, 128, 128, 16, 16>(lds, wsb, S, E, nullptr); }
    if (PH(2)) { PHASE_CTX
      KvSched S{G, c};
      g8::EpiKV E{(bf16_t*)(ws + WS_KV), (const float*)(ws + WS_SMALL + SM_RINVMEM)};
      g8::gemm_phase<g8::EpiKV, KvSched, 0, 2048, 2048, 128, 128, 16, 16>(lds, wsb, S, E, nullptr); }
    GRID_BAR();

    if (PH(3)) { PHASE_CTX
      for (int pr = c; pr < 256; pr += G) s5_scan_pair(a, lds, pr >> 6, pr & 63, tid, wave, lane); }
    GRID_BAR();

    if (PH(4)) { PHASE_CTX
      typedef g8::StdSched<128, 8, 256u * 2048u, 256u * 2048u> Sc; Sc S{(unsigned)(WS_SCR + SC_Y), (unsigned)WS_W_S5OUT, G, c};
      g8::EpiGluRes E{X, part};
      g8::gemm_phase<g8::EpiGluRes, Sc, 0, 2048, 2048, 128, 128, 16, 16>(lds, wsb, S, E, nullptr); }
    GRID_BAR();

#pragma unroll 1
    for (int layer = 0; layer < 2; ++layer) {
        if (layer == 1) {
            if (PH(5)) { PHASE_CTX
              typedef g8::StdSched<128, 16, 256u * 2048u, 256u * 2048u> Sc; Sc S{(unsigned)WS_X, (unsigned)WS_W_GMIN, G, c};
              fill_rs(S, RSL, rinvA, nullptr, 0, tid);
              g8::EpiGmIn E{(bf16_t*)(ws + WS_SCR + SC_Z), 4096, RSL, part};
              g8::gemm_phase<g8::EpiGmIn, Sc, 0, 2048, 2048, 128, 128, 16, 16>(lds, wsb, S, E, nullptr); }
            GRID_BAR();
            if (PH(6)) { PHASE_CTX
              spatial_phase(a, lds, G, tid, wave, lane); }
            GRID_BAR();
            if (PH(7)) { PHASE_CTX
              typedef g8::StdSched<128, 4, 256u * 8192u, 256u * 4096u> Sc; Sc S{(unsigned)(WS_SCR + SC_Z), (unsigned)WS_W_GMOUT, G, c};
              g8::EpiRes<true> E{X, part};
              g8::gemm_phase<g8::EpiRes<true>, Sc, 0, 8192, 4096, 128, 128, 32, 32>(lds, wsb, S, E, nullptr); }
            GRID_BAR();
        }
        if (PH(8)) { PHASE_CTX
          SchedN1024 S{(unsigned)WS_X, (unsigned)WS_W_XA + (unsigned)layer * (unsigned)(8 * MiB), G, c};
          fill_rs(S, RSL, nullptr, part, layer == 0 ? 32 : 16, tid);
          g8::EpiRowScale E{(bf16_t*)(ws + WS_SCR + SC_Q), 1024, RSL};
          g8::gemm_phase<g8::EpiRowScale, SchedN1024, 0, 2048, 2048, 128, 128, 16, 16>(lds, wsb, S, E, nullptr); }
        GRID_BAR();
        if (PH(9)) { PHASE_CTX
          attn_phase(a, lds, layer, G, c); }
        GRID_BAR();
        if (PH(10)) { PHASE_CTX
          SchedN1024 S{(unsigned)(WS_SCR + SC_O), (unsigned)WS_W_XA + (unsigned)layer * (unsigned)(8 * MiB) + (unsigned)(6 * MiB), G, c};
          g8::EpiRes<false> E{X, part};
          g8::gemm_phase<g8::EpiRes<false>, SchedN1024, 0, 2048, 2048, 128, 128, 16, 16>(lds, wsb, S, E, nullptr); }
        GRID_BAR();
        if (PH(11)) { PHASE_CTX
          router_phase(a, lds, layer, G, tid, wave, lane); }
        GRID_BAR();
        if (PH(12)) { PHASE_CTX
          LAS int* TP = (LAS int*)(lds + LX_TAB); LAS int* TOK = TP + 64; LAS float* RS = (LAS float*)(TOK + 5 * 256); LAS float* WT = RS + 5 * 256;
          MoeSched S{(unsigned)WS_X, (unsigned)WS_W_MOE + (unsigned)layer * (unsigned)MOE_L_STRIDE, (unsigned)(2 * MiB), 512u * 1024u, TP, G, c, 0u};
          moe_tables(a, lds, layer, S, tid);
          g8::EpiMoeUp E{(bf16_t*)(ws + WS_SCR + SC_HB), RS, WT};
          g8::gemm_phase<g8::EpiMoeUp, MoeSched, 1, 2048, 2048, 128, 128, 16, 16>(lds, wsb, S, E, TOK); }
        GRID_BAR();
        if (PH(13)) { PHASE_CTX
          LAS int* TP = (LAS int*)(lds + LX_TAB); LAS int* TOK = TP + 64; LAS int* TOKK = TOK + 3 * 5 * 256;
          MoeSched S{(unsigned)(WS_SCR + SC_HB), (unsigned)WS_W_MOE + (unsigned)layer * (unsigned)MOE_L_STRIDE + (unsigned)MOE_D_OFF, (unsigned)(1 * MiB), 256u * 1024u, TP, G, c, 1024u};
          moe_tables(a, lds, layer, S, tid);
          g8::EpiMoeDown E{(bf16_t*)(ws + WS_SCR + SC_YS), TOKK};
          g8::gemm_phase<g8::EpiMoeDown, MoeSched, 0, 1024, 1024, 128, 128, 8, 8>(lds, wsb, S, E, nullptr); }
        GRID_BAR();
        if (PH(14)) { PHASE_CTX
          combine_phase(a, gw, NGW, lane, layer == 1); }
        if (layer == 0) GRID_BAR();
    }
    { unsigned* ctl = (unsigned*)((unsigned char*)ARG(34) + WS_CTL);
      if (xb_ld(ctl + CW_BAR + XB_TMO) != 0u && blockIdx.x == 0 && threadIdx.x == 0) ((float*)ARG(33))[0] = __builtin_nanf(""); }
}

extern "C" void kernel_launch(void* const* d_in, const int* in_sizes, int n_in, void* d_out, int out_size, void* d_ws, size_t ws_size, hipStream_t stream) {
    static int grid = 0;
    if (grid == 0) {
        if (n_in != 33 || in_sizes[0] != T_TOK * DM || out_size != T_TOK * DM || ws_size < WS_END) {
            fprintf(stderr, "kernel_launch: unexpected problem (n_in %d, in0 %d, out %d, ws %zu < %zu)\n", n_in, n_in > 0 ? in_sizes[0] : -1, out_size, ws_size, (size_t)WS_END); grid = -1; return; }
        int dev = 0, cus = 0, per_cu = 0;
        if (hipGetDevice(&dev) != hipSuccess || hipDeviceGetAttribute(&cus, hipDeviceAttributeMultiprocessorCount, dev) != hipSuccess) { grid = -1; return; }
        if (hipFuncSetAttribute((const void*)fwd_megakernel, hipFuncAttributeMaxDynamicSharedMemorySize, LDS_BYTES) != hipSuccess) { fprintf(stderr, "kernel_launch: hipFuncSetAttribute failed\n"); grid = -1; return; }
        if (hipOccupancyMaxActiveBlocksPerMultiprocessor(&per_cu, (const void*)fwd_megakernel, NTHR, LDS_BYTES) != hipSuccess || per_cu < 1) { fprintf(stderr, "kernel_launch: occupancy query says %d blocks per CU\n", per_cu); (void)hipGetLastError(); grid = -1; return; }
        grid = cus;
        if (grid != 256) { fprintf(stderr, "kernel_launch: built for 256 CUs, device has %d\n", cus); grid = -1; return; }
    }
    if (grid < 0) return;
    if (hipMemsetAsync((char*)d_ws + WS_CTL, 0, CTL_BYTES, stream) != hipSuccess) { fprintf(stderr, "kernel_launch: memset failed\n"); return; }
    Args a{};
    for (int i = 0; i < 33; ++i) a.in[i] = (const float*)d_in[i];
    a.out = (float*)d_out; a.ws = (unsigned char*)d_ws;
    void* args[] = {&a};
    const hipError_t e = hipLaunchCooperativeKernel((const void*)fwd_megakernel, dim3(grid), dim3(NTHR), args, LDS_BYTES, stream);
    if (e != hipSuccess) fprintf(stderr, "kernel_launch: cooperative launch failed: %s\n", hipGetErrorString(e));
}
```

```cpp
#include <hip/hip_runtime.h>
#include <cstdio>
#include <cstdint>

#define LAS __attribute__((address_space(3)))
typedef unsigned short bf16_t;
typedef short bf16x8 __attribute__((ext_vector_type(8)));
typedef float f32x4 __attribute__((ext_vector_type(4)));
typedef float f32x2 __attribute__((ext_vector_type(2)));
typedef unsigned u32x4 __attribute__((ext_vector_type(4)));
typedef unsigned u32x2 __attribute__((ext_vector_type(2)));
typedef int i32x4 __attribute__((ext_vector_type(4)));

constexpr int T_TOK = 32768, DM = 1024, NBATCH = 4, SEQ = 8192, MEMR = 1024;
constexpr float RMS_EPS = 1e-6f;
constexpr int NWAVES = 8, NTHR = 512;

constexpr size_t MiB = 1u << 20;
constexpr size_t WS_CTL = 0, CTL_BYTES = 1 * MiB;
constexpr size_t WS_W_S5IN = 1 * MiB, WS_W_S5OUT = 3 * MiB, WS_W_GMIN = 7 * MiB, WS_W_GMOUT = 15 * MiB, WS_W_XA = 19 * MiB  ;
constexpr size_t WS_W_RT = 35 * MiB;
constexpr size_t WS_W_MOE = 36 * MiB;
constexpr size_t MOE_L_STRIDE = 96 * MiB, MOE_D_OFF = 64 * MiB;
constexpr size_t WS_MEMBF = 228 * MiB, WS_KV = 230 * MiB;
constexpr size_t WS_SMALL = 238 * MiB;
constexpr size_t SM_RINVMEM = 0, SM_RINVA = 64 * 1024, SM_RINVB = 256 * 1024, SM_WTS = 512 * 1024, SM_AB16 = 1024 * 1024, SM_MOESW = 1536 * 1024  , SM_GMSW = 1024 * 1024 + 32768  , SM_WSB = 1024 * 1024 + 65536  ;
constexpr size_t WS_PART = 240 * MiB, WS_LIST = 244 * MiB, WS_X = 248 * MiB, WS_SCR = 313 * MiB, WS_W_GMOUT_P = 569 * MiB  , WS_W_GMQ = 574 * MiB  , WS_END = 578 * MiB;
constexpr size_t SC_U = 0, SC_H2 = 64 * MiB, SC_Y = 128 * MiB, SC_S5A = 192 * MiB, SC_S5M = 204 * MiB;
constexpr size_t SC_P0 = 0, SC_G0 = 208 * MiB;
constexpr size_t WS_G1 = WS_W_MOE, WS_P1 = WS_W_MOE + 32 * MiB;
constexpr size_t SC_XQ = 0  , SC_HB = 32 * MiB, SC_YS = 104 * MiB;
constexpr size_t SC_Z = 0;
constexpr int CW_BAR = 4096, CW_CNT = 16384  , CW_DBG = 20480, CW_DONE = 65536  ;

constexpr int LDS_BYTES = 155648;
constexpr int LDS_EXTRA = 131072;
constexpr int LX_MISC = LDS_BYTES - 256;
constexpr int LX_TAB = LDS_EXTRA;

#define GAS __attribute__((address_space(1)))
__device__ __forceinline__ u32x4 gld128(const void* p) { return *(const GAS u32x4*)p; }
__device__ __forceinline__ void gst128(void* p, u32x4 v) { *(GAS u32x4*)p = v; }
__device__ __forceinline__ f32x4 gldf4(const void* p) { return *(const GAS f32x4*)p; }
__device__ __forceinline__ float gldf(const float* p) { return *(const GAS float*)p; }
__device__ __forceinline__ void gstf(float* p, float v) { *(GAS float*)p = v; }
__device__ __forceinline__ unsigned cvt_pk_bf16(float lo, float hi) { unsigned r; asm volatile("v_cvt_pk_bf16_f32 %0, %1, %2" : "=v"(r) : "v"(lo), "v"(hi)); return r; }
__device__ __forceinline__ unsigned f2bf(float f) { unsigned u = __builtin_bit_cast(unsigned, f); return (u + 0x7fffu + ((u >> 16) & 1u)) >> 16; }
__device__ __forceinline__ float bf2f(unsigned h) { return __builtin_bit_cast(float, h << 16); }
__device__ __forceinline__ float bflo(unsigned w) { return __builtin_bit_cast(float, w << 16); }
__device__ __forceinline__ float bfhi(unsigned w) { return __builtin_bit_cast(float, w & 0xffff0000u); }
__device__ __forceinline__ float wave_sum(float v) {
#pragma unroll
    for (int o = 1; o < 64; o <<= 1) v += __shfl_xor(v, o);
    return v;
}
__device__ __forceinline__ int lane_id() { int l; asm volatile("v_mbcnt_lo_u32_b32 %0, -1, 0\n\tv_mbcnt_hi_u32_b32 %0, -1, %0" : "=v"(l)); return l; }
__device__ __forceinline__ float fast_rcp(float x) { return __builtin_amdgcn_rcpf(x); }
__device__ __forceinline__ float fast_exp2(float x) { return __builtin_amdgcn_exp2f(x); }
__device__ __forceinline__ float sigmoid_f(float g) { return fast_rcp(1.0f + fast_exp2(-1.4426950408889634f * g)); }
__device__ __forceinline__ float gelu_tanh(float x) {
    const float t = x * (1.0f + 0.044715f * x * x);
    return x * fast_rcp(1.0f + fast_exp2(-2.302208198f * t));
}

#define XB_TMO      128
#define XB_XCNT(j)  (256  + 64 * (j))
#define XB_XSUB(j)  (1280 + 64 * (j))
#define XB_XGEN(j)  (2304 + 64 * (j))
#define XB_TOP      3328
#define XB_TOPGEN   3392
#define XCD_BAR_WORDS 3456
#define XB_SPIN_CAP (1u << 18)
__device__ __forceinline__ unsigned xb_ld(unsigned* p)              { return __hip_atomic_load(p, __ATOMIC_RELAXED, __HIP_MEMORY_SCOPE_AGENT); }
__device__ __forceinline__ unsigned xb_add(unsigned* p, unsigned v) { return __hip_atomic_fetch_add(p, v, __ATOMIC_RELAXED, __HIP_MEMORY_SCOPE_AGENT); }
__device__ __forceinline__ unsigned xb_xcc_id() { return (unsigned)__builtin_amdgcn_s_getreg((3 << 11) | 20) & 0xFu; }
#define XB_SPIN(cond, bar) do { unsigned _sp = 0; while (cond) { __builtin_amdgcn_s_sleep(1); \
    if ((++_sp & 255u) == 0u) { if (xb_ld(&(bar)[XB_TMO])) break; if (_sp > XB_SPIN_CAP) { atomicAdd(&(bar)[XB_TMO], 1u); break; } } } } while (0)
struct XcdBarrier { unsigned* bar; unsigned x; volatile LAS unsigned* st; };
__device__ __forceinline__ unsigned xcd_barrier_post(unsigned* bar, unsigned x, bool leader) {
    unsigned rank = 0u;
    if (leader) rank = xb_add(&bar[XB_XCNT(x)], 1u);
    return rank;
}
__device__ __forceinline__ void xcd_barrier_complete(unsigned* bar, unsigned x, unsigned& nloc, unsigned& nx, unsigned& regular) {
    const unsigned G = gridDim.x * gridDim.y * gridDim.z;
    unsigned sum, cnt, mine, bad, sp = 0u;
    for (;;) {
        sum = 0u; cnt = 0u; mine = 0u; bad = 0u;
#pragma unroll
        for (unsigned j = 0; j < 16; ++j) { const unsigned c = xb_ld(&bar[XB_XCNT(j)]); sum += c; cnt += (c > 0u) ? 1u : 0u; mine = (j == x) ? c : mine; bad += (c != 0u && c * 8u != G) ? 1u : 0u; }
        if (sum == G) break;
        __builtin_amdgcn_s_sleep(1);
        if ((++sp & 255u) == 0u) { if (xb_ld(&bar[XB_TMO])) break; if (sp > XB_SPIN_CAP) { atomicAdd(&bar[XB_TMO], 1u); break; } }
    }
    nloc = mine > 0u ? mine : 1u; nx = cnt > 0u ? cnt : 1u; regular = (sum == G && cnt == 8u && bad == 0u) ? 1u : 2u;
}
__device__ __forceinline__ void xcd_barrier(const XcdBarrier& b, bool leader) {
    asm volatile("s_waitcnt vmcnt(0)" ::: "memory");
    __syncthreads();
    if (leader) {
        unsigned* bar = b.bar;
        __builtin_amdgcn_s_waitcnt(0);
        unsigned nloc = b.st[0], nx = b.st[1];
        if (nloc == 0u) { unsigned reg; xcd_barrier_complete(bar, b.x, nloc, nx, reg); b.st[0] = nloc; b.st[1] = nx; b.st[2] = reg; }
        const unsigned old = xb_add(&bar[XB_XSUB(b.x)], 1u);
        const unsigned gen = old / nloc;
        if (old + 1u == (gen + 1u) * nloc) {
            __builtin_amdgcn_fence(__ATOMIC_RELEASE, "agent");
            asm volatile("s_waitcnt vmcnt(0)" ::: "memory");
            const unsigned og = xb_add(&bar[XB_TOP], 1u);
            const unsigned tg = og / nx;
            if (og + 1u == (tg + 1u) * nx) xb_add(&bar[XB_TOPGEN], 1u);
            else XB_SPIN(xb_ld(&bar[XB_TOPGEN]) == tg, bar);
            __builtin_amdgcn_fence(__ATOMIC_ACQUIRE, "agent");
            xb_add(&bar[XB_XGEN(b.x)], 1u);
            asm volatile("s_waitcnt vmcnt(0)" ::: "memory");
        } else {
            XB_SPIN(xb_ld(&bar[XB_XGEN(b.x)]) == gen, bar);
            __builtin_amdgcn_fence(__ATOMIC_ACQUIRE, "agent");
            asm volatile("s_waitcnt vmcnt(0)" ::: "memory");
        }
    }
    __syncthreads();
}

#define XL_SUB(j) (4096 + 64 * (j))
#define XL_GEN(j) (5120 + 64 * (j))
__device__ __forceinline__ void xcc_local_barrier(unsigned* bar, unsigned x, unsigned nloc, bool leader) {
    asm volatile("s_waitcnt vmcnt(0)" ::: "memory");
    __syncthreads();
    if (leader) {
        __builtin_amdgcn_s_waitcnt(0);
        const unsigned old = xb_add(&bar[XL_SUB(x)], 1u);
        const unsigned gen = old / nloc;
        if (old + 1u == (gen + 1u) * nloc) xb_add(&bar[XL_GEN(x)], 1u);
        else XB_SPIN(xb_ld(&bar[XL_GEN(x)]) == gen, bar);
        __builtin_amdgcn_fence(__ATOMIC_ACQUIRE, "agent");
        asm volatile("s_waitcnt vmcnt(0)" ::: "memory");
    }
    __syncthreads();
}

namespace g8 {
constexpr int BM = 256, BK = 64, HALF = 128, HTB = HALF * BK * 2, STAGE_BYTES = 8 * HTB, NXCD = 8, WGM = 8;
__host__ __device__ __forceinline__ int lds_byte(int r, int c) { const int st = (r >> 4) * 2 + (c >> 5), rr = r & 15, cc = c & 31, ob = rr * 64 + cc * 2; return st * 1024 + (ob ^ (((ob >> 9) & 1) << 5)); }
__host__ __device__ __forceinline__ void stage_rc(int b, int& R, int& C) { const int st = b / 1024, sb = b % 1024, swz = sb ^ (((sb >> 9) & 1) << 5); R = (st >> 1) * 16 + swz / 64; C = (st & 1) * 32 + (swz % 64) / 2; }
__host__ __device__ __forceinline__ int perm32(int rho) { const int n = rho >> 4, i = rho & 15; return 8 * (i >> 2) + 4 * n + (i & 3); }

struct Unit {
    unsigned A;
    unsigned A2;
    unsigned B;
    int pm, pn;
    int slot;
    int aux;
};
struct Cfg { int lda, ldb, kstepA, kstepB, nt, asplit; };

__device__ __forceinline__ bool static_order(int i, int G, int c, int nM, int nN, int& pm, int& pn) {
    const int nwg = nM * nN; const int L = i * G + c; if (L >= nwg) return false;
    int wgid = L; { const int q = nwg / NXCD, r = nwg % NXCD, xcd = wgid % NXCD, off = wgid / NXCD; wgid = (xcd < r ? xcd * (q + 1) : r * (q + 1) + (xcd - r) * q) + off; }
    const int nig = WGM * nN, gid = wgid / nig, fm = gid * WGM, gsz = (nM - fm) < WGM ? (nM - fm) : WGM;
    pm = fm + ((wgid % nig) % gsz); pn = (wgid % nig) / gsz; return true;
}
template <int NM, int NN, unsigned TSA, unsigned TSB>
struct StdSched {
    unsigned A, B; int G, c;
    __device__ __forceinline__ bool next(int i, Unit& u) const {
        int pm, pn; if (!static_order(i, G, c, NM, NN, pm, pn)) return false;
        u.A = A + (unsigned)pm * TSA; u.A2 = u.A; u.B = B + (unsigned)pn * TSB; u.pm = pm; u.pn = pn; u.slot = i; u.aux = 0; return true;
    }
    __device__ __forceinline__ void a_ready(const Unit&, int, int) const {}
};

template <class Epi, class Sched, int MODE, int LDA, int LDB, int KSA, int KSB, int NT, int ASPLIT>
__device__ __forceinline__ void gemm_phase(LAS unsigned char* lds, const char* wsb, const Sched& S, const Epi& E, const LAS int* tok_lds, int tid_in, unsigned long long* pts = nullptr) {
    constexpr Cfg cfg{LDA, LDB, KSA, KSB, NT, ASPLIT};
    int tid_ = tid_in; asm volatile("" : "+v"(tid_));
    const int tid = tid_, wid = __builtin_amdgcn_readfirstlane(tid >> 6), lane = tid & 63, wr = wid >> 2, wc = wid & 3, fr = lane & 15, fq = lane >> 4;
    constexpr int nt = NT;
    constexpr bool GATHER = (MODE & 1) != 0, TOKA = (MODE & 2) != 0, ZTILE = (MODE & 4) != 0, SPLIT = (MODE & 10) != 0, PLANE = (MODE & 16) != 0;
    int RA[2], CA[2]; unsigned voffA[2], voffB[2];
#pragma unroll
    for (int i = 0; i < 2; ++i) { int R, C; stage_rc(tid * 16 + i * 8192, R, C); const int Rb = Epi::PERM ? ((R & ~31) + perm32(R & 31)) : R;
        RA[i] = R; CA[i] = C;
        const unsigned acol = TOKA ? (unsigned)((C >> 4) * 2048 + (C & 15) * 2) : (PLANE ? (unsigned)((C >> 4) * 1048576 + (C & 15) * 2) : (unsigned)(C * 2));
        voffA[i] = (unsigned)R * (unsigned)cfg.lda + acol; voffB[i] = (unsigned)Rb * (unsigned)cfg.ldb + (unsigned)(C * 2); }
    constexpr unsigned kstepA = (unsigned)KSA, kstepB = (unsigned)KSB;
    constexpr unsigned hstepA = ZTILE ? 1048576u : (unsigned)HALF * (unsigned)LDA, hstepB = (unsigned)HALF * (unsigned)LDB;
    const unsigned ldsw = (unsigned)wid * 1024u;
    const int aoff = lds_byte(wr * 64 + fr, fq * 8), boff = lds_byte(wc * 32 + fr, fq * 8);
    unsigned gc00 = 0, gc01 = 0, gc10 = 0, gc11 = 0, gn00 = 0, gn01 = 0, gn10 = 0, gn11 = 0;
#define G8_SA(b, h) (((b) * 2 + (h)) * HTB)
#define G8_SB(b, h) ((4 + (b) * 2 + (h)) * HTB)
#define G8_GLDS(off32, ldsoff) __builtin_amdgcn_global_load_lds((const unsigned*)(wsb + (size_t)(unsigned)(off32)), (LAS unsigned*)(lds + (ldsoff)), 16, 0, 0)
#define G8_STAGE_B(bufoff, ub) do { G8_GLDS((ub) + voffB[0], (bufoff) + ldsw); G8_GLDS((ub) + voffB[1], (bufoff) + ldsw + 8192); } while (0)
#define G8_STAGE_A(bufoff, ua, h, o0, o1) do { if (GATHER) { G8_GLDS((ua) + (o0), (bufoff) + ldsw); G8_GLDS((ua) + (o1), (bufoff) + ldsw + 8192); } \
        else { G8_GLDS((ua) + (unsigned)(h) * hstepA + voffA[0], (bufoff) + ldsw); G8_GLDS((ua) + (unsigned)(h) * hstepA + voffA[1], (bufoff) + ldsw + 8192); } } while (0)
#define G8_LDA(dst, b, h) do { _Pragma("unroll") for (int m = 0; m < 4; ++m) _Pragma("unroll") for (int k = 0; k < 2; ++k) dst[m][k] = *(const LAS bf16x8*)(lds + G8_SA(b, h) + aoff + m * 2048 + k * 1024); } while (0)
#define G8_LDB(dst, b, h) do { _Pragma("unroll") for (int n = 0; n < 2; ++n) _Pragma("unroll") for (int k = 0; k < 2; ++k) dst[n][k] = *(const LAS bf16x8*)(lds + G8_SB(b, h) + boff + n * 2048 + k * 1024); } while (0)
#define G8_MMA(ai, bj, At, Bt) do { __builtin_amdgcn_s_setprio(1); _Pragma("unroll") for (int m = 0; m < 4; ++m) _Pragma("unroll") for (int n = 0; n < 2; ++n) _Pragma("unroll") for (int k = 0; k < 2; ++k) \
        { if constexpr (Epi::I8) acc[ai][bj][m][n] = __builtin_bit_cast(f32x4, __builtin_amdgcn_mfma_i32_16x16x64_i8(__builtin_bit_cast(i32x4, Bt[n][k]), __builtin_bit_cast(i32x4, At[m][k]), __builtin_bit_cast(i32x4, acc[ai][bj][m][n]), 0, 0, 0)); \
          else acc[ai][bj][m][n] = __builtin_amdgcn_mfma_f32_16x16x32_bf16(Bt[n][k], At[m][k], acc[ai][bj][m][n], 0, 0, 0); } __builtin_amdgcn_s_setprio(0); } while (0)
#define G8_WAIT_V(n) asm volatile("s_waitcnt vmcnt(" #n ")" ::: "memory")
#define G8_WAIT_L(n) asm volatile("s_waitcnt lgkmcnt(" #n ")" ::: "memory")
#define G8_BAR __builtin_amdgcn_s_barrier()
#define G8_SCHED __builtin_amdgcn_sched_barrier(0)
#define G8_APTR(u, kt) (ZTILE ? (u).A + (unsigned)((kt) >> 2) * 65536u + (unsigned)((kt) & 3) * 128u : ((SPLIT && (kt) >= cfg.asplit) ? (u).A2 + (unsigned)((kt) - cfg.asplit) * kstepA : (u).A + (unsigned)(kt) * kstepA))
#define G8_GOFF(u, d00, d01, d10, d11) do { if (GATHER) { const LAS int* _t = tok_lds + (u).slot * 256; \
        d00 = (unsigned)_t[RA[0]] * (unsigned)cfg.lda + (unsigned)(CA[0] * 2); d01 = (unsigned)_t[RA[1]] * (unsigned)cfg.lda + (unsigned)(CA[1] * 2); \
        d10 = (unsigned)_t[128 + RA[0]] * (unsigned)cfg.lda + (unsigned)(CA[0] * 2); d11 = (unsigned)_t[128 + RA[1]] * (unsigned)cfg.lda + (unsigned)(CA[1] * 2); } } while (0)
    Unit cur, nxt; int ui = 0;
    if (!S.next(0, cur)) return;
    f32x4 acc[2][2][4][2];
#pragma unroll
    for (int a = 0; a < 2; ++a)
#pragma unroll
        for (int b = 0; b < 2; ++b)
#pragma unroll
            for (int m = 0; m < 4; ++m)
#pragma unroll
                for (int n = 0; n < 2; ++n) acc[a][b][m][n] = (f32x4){0.f, 0.f, 0.f, 0.f};
    bf16x8 At[4][2], B0[2][2], B1[2][2];
    S.a_ready(cur, wid, lane);
    G8_GOFF(cur, gc00, gc01, gc10, gc11);
    {
        const unsigned cA0 = G8_APTR(cur, 0), cA1 = G8_APTR(cur, 1), cB = cur.B;
        G8_STAGE_B(G8_SB(0, 0), cB); G8_STAGE_B(G8_SB(0, 1), cB + hstepB); G8_STAGE_A(G8_SA(0, 0), cA0, 0, gc00, gc01); G8_STAGE_A(G8_SA(0, 1), cA0, 1, gc10, gc11);
        if (wr == 1) G8_BAR;
        G8_WAIT_V(2); G8_BAR;
        G8_STAGE_B(G8_SB(1, 0), cB + kstepB); G8_STAGE_A(G8_SA(1, 0), cA1, 0, gc00, gc01); G8_STAGE_B(G8_SB(1, 1), cB + hstepB + kstepB);
        G8_WAIT_V(6); G8_BAR;
    }
#define G8_PSTAMP(k) do { if (pts && blockIdx.x == 0 && wid == 0 && lane == 0 && ui == 0) pts[k] = __builtin_amdgcn_s_memrealtime(); } while (0)
    for (;;) {
        G8_PSTAMP(0);
        const bool has_next = S.next(ui + 1, nxt);
        if (!has_next) nxt = cur;
#pragma unroll 1
        for (int t = 0; t < nt; t += 2) {
            const bool last = (t == nt - 2);
            const unsigned a1 = G8_APTR(cur, t + 1);
            const unsigned a2 = last ? G8_APTR(nxt, 0) : G8_APTR(cur, t + 2), b2 = last ? nxt.B : cur.B + (unsigned)(t + 2) * kstepB;
            const unsigned a3 = last ? G8_APTR(nxt, 1) : G8_APTR(cur, t + 3), b3 = b2 + kstepB;
            if (last && has_next) S.a_ready(nxt, wid, lane);
            if (GATHER && last) { if (has_next) { G8_GOFF(nxt, gn00, gn01, gn10, gn11); } else { gn00 = gc00; gn01 = gc01; gn10 = gc10; gn11 = gc11; } }
            const unsigned s00 = last ? gn00 : gc00, s01 = last ? gn01 : gc01, s10 = last ? gn10 : gc10, s11 = last ? gn11 : gc11;
            G8_LDB(B0, 0, 0); G8_LDB(B1, 0, 1); G8_SCHED; G8_LDA(At, 0, 0); G8_STAGE_A(G8_SA(1, 1), a1, 1, gc10, gc11);
            G8_WAIT_V(8); G8_WAIT_L(0); G8_BAR; G8_MMA(0, 0, At, B0); G8_MMA(0, 1, At, B1); G8_BAR; G8_SCHED;
            G8_LDA(At, 0, 1); G8_STAGE_B(G8_SB(0, 0), b2); G8_STAGE_B(G8_SB(0, 1), b2 + hstepB); G8_STAGE_A(G8_SA(0, 0), a2, 0, s00, s01);
            G8_WAIT_V(8); G8_WAIT_L(0); G8_BAR; G8_MMA(1, 0, At, B0); G8_MMA(1, 1, At, B1); G8_BAR; G8_SCHED;
            G8_LDB(B0, 1, 0); G8_LDB(B1, 1, 1); G8_SCHED; G8_LDA(At, 1, 0); G8_STAGE_A(G8_SA(0, 1), a2, 1, s10, s11);
            G8_WAIT_V(8); G8_WAIT_L(0); G8_BAR; G8_MMA(0, 0, At, B0); G8_MMA(0, 1, At, B1); G8_BAR; G8_SCHED;
            G8_LDA(At, 1, 1); G8_STAGE_B(G8_SB(1, 0), b3); G8_STAGE_B(G8_SB(1, 1), b3 + hstepB); G8_STAGE_A(G8_SA(1, 0), a3, 0, s00, s01);
            G8_WAIT_V(8); G8_WAIT_L(0); G8_BAR; G8_MMA(1, 0, At, B0); G8_MMA(1, 1, At, B1); G8_BAR; G8_SCHED;
        }
        G8_PSTAMP(1);
        if (Epi::ALIGN && wr == 0) G8_BAR;
        G8_PSTAMP(2);
        if constexpr (!Epi::AFTER_DRAIN) { int efr = fr, efq = fq; asm volatile("" : "+v"(efr), "+v"(efq));
            E(acc, cur, wr, wc, efr, efq); }
        G8_PSTAMP(3);
        if (!has_next) break;
#pragma unroll
        for (int a = 0; a < 2; ++a)
#pragma unroll
            for (int b = 0; b < 2; ++b)
#pragma unroll
                for (int m = 0; m < 4; ++m)
#pragma unroll
                    for (int n = 0; n < 2; ++n) acc[a][b][m][n] = (f32x4){0.f, 0.f, 0.f, 0.f};
        cur = nxt; ++ui; gc00 = gn00; gc01 = gn01; gc10 = gn10; gc11 = gn11;
        if (Epi::ALIGN && wr == 1) G8_BAR;
    }
    G8_WAIT_V(0);
    if (!Epi::ALIGN && wr == 0) G8_BAR;
    G8_BAR;
    if constexpr (Epi::AFTER_DRAIN) { E.fused(acc, cur, wr, wc, fr, fq, lds, wid, lane); }
#undef G8_SA
#undef G8_SB
#undef G8_GLDS
#undef G8_STAGE_A
#undef G8_STAGE_B
#undef G8_LDA
#undef G8_LDB
#undef G8_MMA
#undef G8_WAIT_V
#undef G8_WAIT_L
#undef G8_BAR
#undef G8_SCHED
#undef G8_APTR
#undef G8_GOFF
#undef G8_PSTAMP
}
}
#ifndef EPI_ALIGN_DEFAULT
#define EPI_ALIGN_DEFAULT true
#endif
namespace g8 {
typedef const f32x4 (&AccRef)[2][2][4][2];

struct EpiRowScale {
    static constexpr bool PERM = true, AFTER_DRAIN = false, ALIGN = EPI_ALIGN_DEFAULT, I8 = false;
    bf16_t* O; int ldc; const LAS float* rs_lds;
    __device__ __forceinline__ void operator()(AccRef acc, const Unit& u, int wr, int wc, int fr, int fq) const {
        const int r0 = wr * 64 + fr; const int col0 = u.pn * BM + wc * 32 + 8 * fq;
#pragma unroll
        for (int ai = 0; ai < 2; ++ai)
#pragma unroll
            for (int m = 0; m < 4; ++m) { const int r = r0 + ai * HALF + m * 16; const float s = rs_lds[u.slot * 256 + r];
                bf16_t* rowp = O + (size_t)(u.pm * BM + r) * ldc + col0;
#pragma unroll
                for (int bj = 0; bj < 2; ++bj) { const f32x4 v0 = acc[ai][bj][m][0] * s, v1 = acc[ai][bj][m][1] * s;
                    u32x4 w; w.x = cvt_pk_bf16(v0[0], v0[1]); w.y = cvt_pk_bf16(v0[2], v0[3]); w.z = cvt_pk_bf16(v1[0], v1[1]); w.w = cvt_pk_bf16(v1[2], v1[3]);
                    gst128(rowp + bj * HALF, w); } }
    }
};
struct EpiU {
    static constexpr bool PERM = true, AFTER_DRAIN = false, ALIGN = EPI_ALIGN_DEFAULT, I8 = false;
    bf16_t* U2; const LAS float* rs_lds;
    __device__ __forceinline__ void operator()(AccRef acc, const Unit& u, int wr, int wc, int fr, int fq) const {
        const int r0 = wr * 64 + fr; const int col0 = u.pn * BM + wc * 32 + 8 * fq;
#pragma unroll
        for (int ai = 0; ai < 2; ++ai)
#pragma unroll
            for (int m = 0; m < 4; ++m) { const int r = r0 + ai * HALF + m * 16; const float s = rs_lds[u.slot * 256 + r]; const size_t row = (size_t)(u.pm * BM + r);
#pragma unroll
                for (int bj = 0; bj < 2; ++bj) { const int col = col0 + bj * HALF; const f32x4 v0 = acc[ai][bj][m][0] * s, v1 = acc[ai][bj][m][1] * s;
                    u32x4 w; w.x = cvt_pk_bf16(v0[0], v0[1]); w.y = cvt_pk_bf16(v0[2], v0[3]); w.z = cvt_pk_bf16(v1[0], v1[1]); w.w = cvt_pk_bf16(v1[2], v1[3]);
                    gst128(U2 + ((size_t)(col >> 4) * T_TOK + row) * 16 + (col & 15), w); } }
    }
};
struct EpiGmIn {
    static constexpr bool PERM = true, AFTER_DRAIN = false, ALIGN = EPI_ALIGN_DEFAULT, I8 = true;
    bf16_t* O; const LAS float* rs_lds; float* part; const float* sw;
    __device__ __forceinline__ void operator()(AccRef acc, const Unit& u, int wr, int wc, int fr, int fq) const {
        const int r0 = wr * 64 + fr; const int col0 = wc * 32 + 8 * fq;
        f32x4 cs[2][2];
#pragma unroll
        for (int bj = 0; bj < 2; ++bj)
#pragma unroll
            for (int n = 0; n < 2; ++n) cs[bj][n] = gldf4(sw + u.pn * BM + bj * HALF + col0 + 4 * n);
#pragma unroll
        for (int ai = 0; ai < 2; ++ai)
#pragma unroll
            for (int m = 0; m < 4; ++m) { const int rr = r0 + m * 16; const int r = rr + ai * HALF; const float s = rs_lds[u.slot * 256 + r];
                bf16_t* rowp = O + ((size_t)((u.pm * 2 + ai) * 16 + u.pn) * 128 + rr) * 256 + col0; float q = 0.f;
#pragma unroll
                for (int bj = 0; bj < 2; ++bj) { const i32x4 i0 = __builtin_bit_cast(i32x4, acc[ai][bj][m][0]), i1 = __builtin_bit_cast(i32x4, acc[ai][bj][m][1]);
                    f32x4 v0, v1;
#pragma unroll
                    for (int j = 0; j < 4; ++j) { v0[j] = gelu_tanh((float)i0[j] * s * cs[bj][0][j]); v1[j] = gelu_tanh((float)i1[j] * s * cs[bj][1][j]); }
                    u32x4 w; w.x = cvt_pk_bf16(v0[0], v0[1]); w.y = cvt_pk_bf16(v0[2], v0[3]); w.z = cvt_pk_bf16(v1[0], v1[1]); w.w = cvt_pk_bf16(v1[2], v1[3]);
                    gst128(rowp + bj * HALF, w);
                    q += bflo(w.x) * bflo(w.x) + bfhi(w.x) * bfhi(w.x) + bflo(w.y) * bflo(w.y) + bfhi(w.y) * bfhi(w.y) + bflo(w.z) * bflo(w.z) + bfhi(w.z) * bfhi(w.z) + bflo(w.w) * bflo(w.w) + bfhi(w.w) * bfhi(w.w); }
                if (u.pn >= 8) { q += __shfl_xor(q, 16); q += __shfl_xor(q, 32);
                    if (fq == 0) gstf(part + ((size_t)(u.pm * BM + r) * 32 + (u.pn - 8) * 4 + wc), q); } }
    }
};
struct EpiKV {
    static constexpr bool PERM = true, AFTER_DRAIN = false, ALIGN = EPI_ALIGN_DEFAULT, I8 = false;
    bf16_t* O0; const float* rinv_mem;
    __device__ __forceinline__ void operator()(AccRef acc, const Unit& u, int wr, int wc, int fr, int fq) const {
        const int r0 = wr * 64 + fr; const int col0 = u.pn * BM + wc * 32 + 8 * fq; bf16_t* Ob = O0 + (size_t)u.aux * 2097152;
#pragma unroll
        for (int ai = 0; ai < 2; ++ai)
#pragma unroll
            for (int m = 0; m < 4; ++m) { const int row = u.pm * BM + r0 + ai * HALF + m * 16; const float s = gldf(rinv_mem + row);
                bf16_t* rowp = Ob + (size_t)row * 2048 + col0;
#pragma unroll
                for (int bj = 0; bj < 2; ++bj) { const f32x4 v0 = acc[ai][bj][m][0] * s, v1 = acc[ai][bj][m][1] * s;
                    u32x4 w; w.x = cvt_pk_bf16(v0[0], v0[1]); w.y = cvt_pk_bf16(v0[2], v0[3]); w.z = cvt_pk_bf16(v1[0], v1[1]); w.w = cvt_pk_bf16(v1[2], v1[3]);
                    gst128(rowp + bj * HALF, w); } }
    }
};
struct EpiGluRes {
    static constexpr bool PERM = true, AFTER_DRAIN = false, ALIGN = EPI_ALIGN_DEFAULT, I8 = false;
    bf16_t* X; float* part;
    __device__ __forceinline__ void operator()(AccRef acc, const Unit& u, int wr, int wc, int fr, int fq) const {
        const int r0 = wr * 64 + fr; const int col0 = u.pn * HALF + wc * 32 + 8 * fq;
        u32x4 xo[2][4];
#pragma unroll
        for (int ai = 0; ai < 2; ++ai)
#pragma unroll
            for (int m = 0; m < 4; ++m) xo[ai][m] = gld128(X + (size_t)(u.pm * BM + r0 + ai * HALF + m * 16) * 1024 + col0);
#pragma unroll
        for (int ai = 0; ai < 2; ++ai)
#pragma unroll
            for (int m = 0; m < 4; ++m) { const int row = u.pm * BM + r0 + ai * HALF + m * 16;
                bf16_t* xp = X + (size_t)row * 1024 + col0; const u32x4 xv = xo[ai][m];
                f32x4 v0 = acc[ai][0][m][0], v1 = acc[ai][0][m][1]; const f32x4 g0 = acc[ai][1][m][0], g1 = acc[ai][1][m][1];
#pragma unroll
                for (int j = 0; j < 4; ++j) { v0[j] *= sigmoid_f(g0[j]); v1[j] *= sigmoid_f(g1[j]); }
                u32x4 w; w.x = cvt_pk_bf16(v0[0] + bflo(xv.x), v0[1] + bfhi(xv.x)); w.y = cvt_pk_bf16(v0[2] + bflo(xv.y), v0[3] + bfhi(xv.y));
                w.z = cvt_pk_bf16(v1[0] + bflo(xv.z), v1[1] + bfhi(xv.z)); w.w = cvt_pk_bf16(v1[2] + bflo(xv.w), v1[3] + bfhi(xv.w));
                gst128(xp, w);
                float q = bflo(w.x) * bflo(w.x) + bfhi(w.x) * bfhi(w.x) + bflo(w.y) * bflo(w.y) + bfhi(w.y) * bfhi(w.y) + bflo(w.z) * bflo(w.z) + bfhi(w.z) * bfhi(w.z) + bflo(w.w) * bflo(w.w) + bfhi(w.w) * bfhi(w.w);
                q += __shfl_xor(q, 16); q += __shfl_xor(q, 32);
                if (fq == 0) gstf(part + ((size_t)row * 32 + u.pn * 4 + wc), q); }
    }
};
template <bool PART> struct EpiRes {
    static constexpr bool PERM = true, AFTER_DRAIN = false, ALIGN = EPI_ALIGN_DEFAULT, I8 = false;
    bf16_t* X; float* part;
    __device__ __forceinline__ void operator()(AccRef acc, const Unit& u, int wr, int wc, int fr, int fq) const {
        const int r0 = wr * 64 + fr; const int col0 = u.pn * BM + wc * 32 + 8 * fq;
        u32x4 xo[2][4][2];
#pragma unroll
        for (int ai = 0; ai < 2; ++ai)
#pragma unroll
            for (int m = 0; m < 4; ++m)
#pragma unroll
                for (int bj = 0; bj < 2; ++bj) xo[ai][m][bj] = gld128(X + (size_t)(u.pm * BM + r0 + ai * HALF + m * 16) * 1024 + col0 + bj * HALF);
#pragma unroll
        for (int ai = 0; ai < 2; ++ai)
#pragma unroll
            for (int m = 0; m < 4; ++m) { const int row = u.pm * BM + r0 + ai * HALF + m * 16; float q = 0.f;
#pragma unroll
                for (int bj = 0; bj < 2; ++bj) { bf16_t* xp = X + (size_t)row * 1024 + col0 + bj * HALF; const u32x4 xv = xo[ai][m][bj];
                    const f32x4 v0 = acc[ai][bj][m][0], v1 = acc[ai][bj][m][1];
                    u32x4 w; w.x = cvt_pk_bf16(v0[0] + bflo(xv.x), v0[1] + bfhi(xv.x)); w.y = cvt_pk_bf16(v0[2] + bflo(xv.y), v0[3] + bfhi(xv.y));
                    w.z = cvt_pk_bf16(v1[0] + bflo(xv.z), v1[1] + bfhi(xv.z)); w.w = cvt_pk_bf16(v1[2] + bflo(xv.w), v1[3] + bfhi(xv.w));
                    gst128(xp, w);
                    if (PART) q += bflo(w.x) * bflo(w.x) + bfhi(w.x) * bfhi(w.x) + bflo(w.y) * bflo(w.y) + bfhi(w.y) * bfhi(w.y) + bflo(w.z) * bflo(w.z) + bfhi(w.z) * bfhi(w.z) + bflo(w.w) * bflo(w.w) + bfhi(w.w) * bfhi(w.w); }
                if (PART) { q += __shfl_xor(q, 16); q += __shfl_xor(q, 32); if (fq == 0) gstf(part + ((size_t)row * 32 + u.pn * 4 + wc), q); } }
    }
};
struct EpiS5B {
    static constexpr bool PERM = true, AFTER_DRAIN = false, ALIGN = EPI_ALIGN_DEFAULT, I8 = false;
    bf16_t* Y;
    __device__ __forceinline__ void operator()(AccRef acc, const Unit& u, int wr, int wc, int fr, int fq) const {
        const int r0 = wr * 64 + fr; const int g = u.aux;
#pragma unroll
        for (int ai = 0; ai < 2; ++ai)
#pragma unroll
            for (int m = 0; m < 4; ++m) { const int blk = u.pm * BM + r0 + ai * HALF + m * 16;
#pragma unroll
                for (int bj = 0; bj < 2; ++bj) { const int c = bj * HALF + wc * 32 + 8 * fq; const int tl = c >> 4, ch = c & 15;
                    f32x4 v0 = acc[ai][bj][m][0], v1 = acc[ai][bj][m][1];
#pragma unroll
                    for (int j = 0; j < 4; ++j) { v0[j] = gelu_tanh(v0[j]); v1[j] = gelu_tanh(v1[j]); }
                    u32x4 w; w.x = cvt_pk_bf16(v0[0], v0[1]); w.y = cvt_pk_bf16(v0[2], v0[3]); w.z = cvt_pk_bf16(v1[0], v1[1]); w.w = cvt_pk_bf16(v1[2], v1[3]);
                    gst128(Y + ((size_t)g * T_TOK + (size_t)blk * 16 + tl) * 16 + ch, w); } }
    }
};
struct EpiSoftmax {
    static constexpr bool PERM = true, AFTER_DRAIN = false, ALIGN = true, I8 = false;
    bf16_t* P; const LAS float* rs_lds; LAS float* tab;
    __device__ __forceinline__ void operator()(AccRef acc_in, const Unit& u, int wr, int wc, int fr, int fq) const {
        LAS float* RM = tab;
        LAS float* RS = tab + 1024;
        const int r0 = wr * 64 + fr;
        float mx[2][4], sc[2][4];
#pragma unroll
        for (int ai = 0; ai < 2; ++ai)
#pragma unroll
            for (int m = 0; m < 4; ++m) { float v = -3.0e38f; const float s = rs_lds[u.slot * 256 + r0 + ai * HALF + m * 16] * 1.4426950408889634f; sc[ai][m] = s;
#pragma unroll
                for (int bj = 0; bj < 2; ++bj)
#pragma unroll
                    for (int n = 0; n < 2; ++n) { const f32x4 x = acc_in[ai][bj][m][n]; v = fmaxf(v, fmaxf(fmaxf(x[0], x[1]), fmaxf(x[2], x[3]))); }
                v = fmaxf(v, __shfl_xor(v, 16)); v = fmaxf(v, __shfl_xor(v, 32));
                if (fq == 0) RM[(r0 + ai * HALF + m * 16) * 4 + wc] = v; }
        asm volatile("s_waitcnt lgkmcnt(0)" ::: "memory"); __builtin_amdgcn_s_barrier(); asm volatile("" ::: "memory");
#pragma unroll
        for (int ai = 0; ai < 2; ++ai)
#pragma unroll
            for (int m = 0; m < 4; ++m) { const f32x4 t = *(const LAS f32x4*)(RM + (r0 + ai * HALF + m * 16) * 4); mx[ai][m] = fmaxf(fmaxf(t[0], t[1]), fmaxf(t[2], t[3])) * sc[ai][m]; }
#pragma unroll
        for (int ai = 0; ai < 2; ++ai)
#pragma unroll
            for (int m = 0; m < 4; ++m) { float s = 0.f; const float mm = mx[ai][m], ss = sc[ai][m];
#pragma unroll
                for (int bj = 0; bj < 2; ++bj)
#pragma unroll
                    for (int n = 0; n < 2; ++n) { const f32x4 x = acc_in[ai][bj][m][n];
#pragma unroll
                        for (int j = 0; j < 4; ++j) s += fast_exp2(x[j] * ss - mm); }
                s += __shfl_xor(s, 16); s += __shfl_xor(s, 32);
                if (fq == 0) RS[(r0 + ai * HALF + m * 16) * 4 + wc] = s; }
        asm volatile("s_waitcnt lgkmcnt(0)" ::: "memory"); __builtin_amdgcn_s_barrier(); asm volatile("" ::: "memory");
#pragma unroll
        for (int ai = 0; ai < 2; ++ai)
#pragma unroll
            for (int m = 0; m < 4; ++m) { const int r = r0 + ai * HALF + m * 16; const f32x4 t = *(const LAS f32x4*)(RS + r * 4); const float inv = 1.0f / ((t[0] + t[1]) + (t[2] + t[3])); const float mm = mx[ai][m], ss = sc[ai][m];
                bf16_t* rowp = P + (size_t)(u.pm * BM + r) * 1024 + u.pn * BM + wc * 32 + 8 * fq;
#pragma unroll
                for (int bj = 0; bj < 2; ++bj) { f32x4 v0 = acc_in[ai][bj][m][0], v1 = acc_in[ai][bj][m][1];
#pragma unroll
                    for (int j = 0; j < 4; ++j) { v0[j] = fast_exp2(v0[j] * ss - mm) * inv; v1[j] = fast_exp2(v1[j] * ss - mm) * inv; }
                    u32x4 w; w.x = cvt_pk_bf16(v0[0], v0[1]); w.y = cvt_pk_bf16(v0[2], v0[3]); w.z = cvt_pk_bf16(v1[0], v1[1]); w.w = cvt_pk_bf16(v1[2], v1[3]);
                    gst128(rowp + bj * HALF, w); } }
        asm volatile("s_waitcnt lgkmcnt(0)" ::: "memory"); __builtin_amdgcn_s_barrier(); asm volatile("" ::: "memory");
    }
};
struct EpiStore {
    static constexpr bool PERM = true, AFTER_DRAIN = false, ALIGN = EPI_ALIGN_DEFAULT, I8 = false;
    bf16_t* O; int ldc;
    __device__ __forceinline__ void operator()(AccRef acc, const Unit& u, int wr, int wc, int fr, int fq) const {
        const int r0 = wr * 64 + fr; const int col0 = u.pn * BM + wc * 32 + 8 * fq;
#pragma unroll
        for (int ai = 0; ai < 2; ++ai)
#pragma unroll
            for (int m = 0; m < 4; ++m) { bf16_t* rowp = O + (size_t)(u.pm * BM + r0 + ai * HALF + m * 16) * ldc + col0;
#pragma unroll
                for (int bj = 0; bj < 2; ++bj) { const f32x4 v0 = acc[ai][bj][m][0], v1 = acc[ai][bj][m][1];
                    u32x4 w; w.x = cvt_pk_bf16(v0[0], v0[1]); w.y = cvt_pk_bf16(v0[2], v0[3]); w.z = cvt_pk_bf16(v1[0], v1[1]); w.w = cvt_pk_bf16(v1[2], v1[3]);
                    gst128(rowp + bj * HALF, w); } }
    }
};
struct EpiMoeUp {
    static constexpr bool PERM = true, AFTER_DRAIN = false, ALIGN = EPI_ALIGN_DEFAULT, I8 = true;
    __amdgpu_buffer_rsrc_t hrs; const LAS float* rs_lds; const LAS float* wt_lds; unsigned* done; const float* sw;
    __device__ __forceinline__ void operator()(AccRef acc, const Unit& u, int wr, int wc, int fr, int fq) const {
        const int r0 = wr * 64 + fr; const int col0 = u.pn * HALF + wc * 32 + 8 * fq;
        const float* swe = sw + (u.aux & 255) * 1024 + u.pn * BM + wc * 32 + 8 * fq;
        const f32x4 sg0 = gldf4(swe), sg1 = gldf4(swe + 4), su0 = gldf4(swe + HALF), su1 = gldf4(swe + HALF + 4);
#pragma unroll
        for (int ai = 0; ai < 2; ++ai)
#pragma unroll
            for (int m = 0; m < 4; ++m) { const int r = r0 + ai * HALF + m * 16; const float s = rs_lds[u.slot * 256 + r], wt = wt_lds[u.slot * 256 + r];
                const i32x4 ga = __builtin_bit_cast(i32x4, acc[ai][0][m][0]), gb = __builtin_bit_cast(i32x4, acc[ai][0][m][1]), ua = __builtin_bit_cast(i32x4, acc[ai][1][m][0]), ub = __builtin_bit_cast(i32x4, acc[ai][1][m][1]);
                f32x4 a0, a1;
#pragma unroll
                for (int j = 0; j < 4; ++j) { const float x0 = (float)ga[j] * s * sg0[j], x1 = (float)gb[j] * s * sg1[j], y0 = (float)ua[j] * s * su0[j], y1 = (float)ub[j] * s * su1[j];
                    a0[j] = wt * x0 * sigmoid_f(x0) * y0; a1[j] = wt * x1 * sigmoid_f(x1) * y1; }
                u32x4 w; w.x = cvt_pk_bf16(a0[0], a0[1]); w.y = cvt_pk_bf16(a0[2], a0[3]); w.z = cvt_pk_bf16(a1[0], a1[1]); w.w = cvt_pk_bf16(a1[2], a1[3]);
                __builtin_amdgcn_raw_buffer_store_b128(w, hrs, (unsigned)((u.pm + r) * 1024 + col0 * 2), 0,   16); }
        asm volatile("s_waitcnt vmcnt(0)" ::: "memory");
        if (fr == 0 && fq == 0) __hip_atomic_fetch_add(done + (u.pm >> 8) * 64, 1u, __ATOMIC_RELAXED, __HIP_MEMORY_SCOPE_AGENT);
    }
};
struct EpiMoeDown {
    static constexpr bool PERM = true, AFTER_DRAIN = false, ALIGN = EPI_ALIGN_DEFAULT, I8 = false;
    bf16_t* YS; const LAS int* tokk_lds;
    __device__ __forceinline__ void operator()(AccRef acc, const Unit& u, int wr, int wc, int fr, int fq) const {
        const int r0 = wr * 64 + fr; const int col0 = u.pn * BM + wc * 32 + 8 * fq;
#pragma unroll
        for (int ai = 0; ai < 2; ++ai)
#pragma unroll
            for (int m = 0; m < 4; ++m) { const int r = r0 + ai * HALF + m * 16; const int tk = tokk_lds[u.slot * 256 + r];
                if (tk >= 0) { bf16_t* rowp = YS + (size_t)tk * 1024 + col0;
#pragma unroll
                    for (int bj = 0; bj < 2; ++bj) { const f32x4 v0 = acc[ai][bj][m][0], v1 = acc[ai][bj][m][1];
                        u32x4 w; w.x = cvt_pk_bf16(v0[0], v0[1]); w.y = cvt_pk_bf16(v0[2], v0[3]); w.z = cvt_pk_bf16(v1[0], v1[1]); w.w = cvt_pk_bf16(v1[2], v1[3]);
                        gst128(rowp + bj * HALF, w); } } }
    }
};
}
struct Args { const float* in[33]; float* out; unsigned char* ws; };
__device__ __forceinline__ const float* ARG(int k) { const __attribute__((address_space(4))) volatile unsigned long long* p = (const __attribute__((address_space(4))) volatile unsigned long long*)__builtin_amdgcn_kernarg_segment_ptr(); return (const float*)p[k]; }
struct ArgsV { unsigned char* ws; };
enum { I_X = 0, I_MEM, I_S5_NORM, I_S5_WIN, I_S5_LRE, I_S5_LIM, I_S5_LOGDT, I_S5_BRE, I_S5_BIM, I_S5_CRE, I_S5_CIM, I_S5_D, I_S5_WOUT,
       I_GM_NORM, I_GM_WIN, I_GM_VNORM, I_GM_WS, I_GM_BS, I_GM_WOUT, I_MEM_NORM, I_XA_NORM, I_XA_WQ, I_XA_WKV, I_XA_WO,
       I_MOE_NORM, I_MOE_WG, I_MOE_BG, I_MOE_WE, I_MOE_BE, I_MOE_WGATE, I_MOE_WUP, I_MOE_WDOWN, I_FINAL_NORM };

struct TItem { const float* W; const float* ksc; bf16_t* WT; int ldw, k0, n0, ldt, drow0; float cs; };
__device__ __forceinline__ void titem_load(const TItem& d, f32x4 (&v)[16], float (&sc)[16], int lane) {
    const int lr = lane >> 4, lc = (lane & 15) * 4;
#pragma unroll
    for (int i = 0; i < 16; ++i) v[i] = __builtin_nontemporal_load((const GAS f32x4*)(d.W + (size_t)(d.k0 + 4 * i + lr) * d.ldw + d.n0 + lc));
#pragma unroll
    for (int i = 0; i < 16; ++i) sc[i] = d.ksc ? gldf(d.ksc + d.k0 + 4 * i + lr) * d.cs : d.cs;
}
__device__ __forceinline__ void titem_store(const TItem& d, const f32x4 (&v)[16], const float (&sc)[16], LAS float* scr, int lane) {
    const int lr = lane >> 4, lc = (lane & 15) * 4;
#pragma unroll
    for (int i = 0; i < 16; ++i) { LAS float* p = scr + (4 * i + lr) * 65 + lc; p[0] = v[i][0] * sc[i]; p[1] = v[i][1] * sc[i]; p[2] = v[i][2] * sc[i]; p[3] = v[i][3] * sc[i]; }
    asm volatile("s_waitcnt lgkmcnt(0)" ::: "memory");
    const int c = lane & 7;
#pragma unroll
    for (int j = 0; j < 8; ++j) { const int n = (lane >> 3) + 8 * j; const LAS float* s = scr + (8 * c) * 65 + n;
        u32x4 o; o.x = cvt_pk_bf16(s[0 * 65], s[1 * 65]); o.y = cvt_pk_bf16(s[2 * 65], s[3 * 65]); o.z = cvt_pk_bf16(s[4 * 65], s[5 * 65]); o.w = cvt_pk_bf16(s[6 * 65], s[7 * 65]);
        gst128(d.WT + (size_t)(d.drow0 + n) * d.ldt + d.k0 + 8 * c, o); }
    asm volatile("s_waitcnt lgkmcnt(0)" ::: "memory");
}
__device__ __forceinline__ int glu_row(int j0, int part) { return (j0 >> 7) * 256 + part * 128 + (j0 & 127); }

__device__ __forceinline__ void p0_item(int r, int KB, int& kb, int& nb) { kb = r % KB; nb = r / KB; }
__device__ __forceinline__ bool p0_desc(unsigned char* ws, int L, TItem& d) {
    constexpr int N_DENSE = 4352;
    int kb, nb; d.ksc = nullptr; d.cs = 1.f;
    if (L < 256) { p0_item(L, 16, kb, nb);
        d.W = ARG(I_S5_WIN); d.ldw = 1024; d.ksc = ARG(I_S5_NORM); d.WT = (bf16_t*)(ws + WS_W_S5IN); d.ldt = 1024; d.drow0 = nb * 64;
    } else if (L < 768) { p0_item(L - 256, 16, kb, nb); const int n0 = nb * 64;
        d.W = ARG(I_S5_WOUT); d.ldw = 2048; d.WT = (bf16_t*)(ws + WS_W_S5OUT); d.ldt = 1024; d.drow0 = glu_row(n0 & 1023, n0 >> 10);
    } else if (L < 1792) { p0_item(L - 768, 16, kb, nb);
        d.W = ARG(I_GM_WIN); d.ldw = 4096; d.ksc = ARG(I_GM_NORM); d.WT = (bf16_t*)(ws + WS_W_GMIN); d.ldt = 1024; d.drow0 = nb * 64;
    } else if (L < 2304) { p0_item(L - 1792, 32, kb, nb);
        d.W = ARG(I_GM_WOUT); d.ldw = 1024; d.WT = (bf16_t*)(ws + WS_W_GMOUT_P); d.ldt = 2112; d.drow0 = nb * 64;
    } else if (L < 2816) { return false;
    } else if (L < 3840) { const int r = L - 2816, l = r / 512; p0_item(r % 512, 16, kb, nb); const int n0 = nb * 64;
        d.W = ARG(I_XA_WKV) + (size_t)l * 2097152; d.ldw = 2048; d.ksc = ARG(I_MEM_NORM); d.WT = (bf16_t*)(ws + WS_W_XA + l * 8 * MiB + (n0 < 1024 ? 2 : 4) * MiB); d.ldt = 1024; d.drow0 = n0 & 1023;
    } else if (L < N_DENSE) { const int r = L - 3840, l = r / 256; p0_item(r % 256, 16, kb, nb);
        d.W = ARG(I_XA_WO) + (size_t)l * 1048576; d.ldw = 1024; d.WT = (bf16_t*)(ws + WS_W_XA + l * 8 * MiB + 6 * MiB); d.ldt = 1024; d.drow0 = nb * 64;
    } else { const int r = L - N_DENSE; const int kind = r / 8192, q = r % 8192, mat = q / 128, it = q % 128, l = mat / 32, e = mat % 32;
        if (kind < 2) { p0_item(it, 16, kb, nb);
            d.W = ARG(kind == 0 ? I_MOE_WGATE : I_MOE_WUP) + (size_t)mat * 524288; d.ldw = 512; d.ksc = ARG(I_MOE_NORM) + l * 1024;
            d.WT = (bf16_t*)(ws + WS_W_MOE + l * MOE_L_STRIDE) + (size_t)e * 1048576; d.ldt = 1024; d.drow0 = glu_row(nb * 64, kind);
        } else { p0_item(it, 8, kb, nb);
            d.W = ARG(I_MOE_WDOWN) + (size_t)mat * 524288; d.ldw = 1024; d.WT = (bf16_t*)(ws + WS_W_MOE + l * MOE_L_STRIDE + MOE_D_OFF) + (size_t)e * 524288; d.ldt = 512; d.drow0 = nb * 64; } }
    d.k0 = kb * 64; d.n0 = nb * 64; return true;
}
__device__ __forceinline__ void p0_weights(const ArgsV& a, LAS unsigned char* lds, int part, int j0, int j1, int gw, int NGW, int wave, int lane) {
    LAS float* scr = (LAS float*)(lds + wave * 16640);
    unsigned char* ws = a.ws;
    constexpr int TOTAL = 4352 + 24576;
    const int NJ = part == 0 ? 1280 : 3072 + 8192; if (j1 > NJ) j1 = NJ; (void)TOTAL;
#define P0_L(j_) (part == 0 ? ((j_) < 256 ? (j_) : (j_) - 256 + 2816) : ((j_) < 2560 ? (j_) + 256 : ((j_) < 3072 ? (j_) - 2560 + 3840 : (j_) - 3072 + 20736)))
    TItem cur, nxt; f32x4 va[16], vb[16]; float sa[16], sb[16];
    int j = j0 + gw; bool have = false;
    while (j < j1 && !(have = p0_desc(ws, P0_L(j), cur))) j += NGW;
    if (have) titem_load(cur, va, sa, lane);
    while (have) {
        int jn = j + NGW; bool hn = false;
        while (jn < j1 && !(hn = p0_desc(ws, P0_L(jn), nxt))) jn += NGW;
        if (hn) titem_load(nxt, vb, sb, lane);
        titem_store(cur, va, sa, scr, lane);
        if (hn) {
#pragma unroll
            for (int i = 0; i < 16; ++i) { va[i] = vb[i]; sa[i] = sb[i]; }
            cur = nxt; }
        have = hn; j = jn;
    }
#undef P0_L
}
__device__ __forceinline__ void p0_moe_gu_jobs(const ArgsV& a, LAS unsigned char* lds, int gw, int NGW, int wave, int lane) {
    LAS float* scr = (LAS float*)(lds + wave * 16640);
    unsigned char* ws = a.ws; float* swm = (float*)(ws + WS_SMALL + SM_MOESW);
    for (int J = gw; J < 1024; J += NGW) {
        const int kind = J >> 9, mat = (J >> 3) & 63, nb = J & 7, l = mat >> 5, e = mat & 31;
        TItem d; d.W = ARG(kind == 0 ? I_MOE_WGATE : I_MOE_WUP) + (size_t)mat * 524288; d.ldw = 512; d.ksc = ARG(I_MOE_NORM) + l * 1024; d.cs = 1.f;
        d.WT = (bf16_t*)(ws + WS_W_MOE + l * MOE_L_STRIDE) + (size_t)e * 1048576; d.ldt = 1024; d.drow0 = glu_row(nb * 64, kind); d.n0 = nb * 64; d.k0 = 0;
        f32x4 va[16], vb[16]; float rmax[8];
#pragma unroll
        for (int j = 0; j < 8; ++j) rmax[j] = 0.f;
        { const int lr = lane >> 4, lc = (lane & 15) * 4;
#pragma unroll
          for (int i = 0; i < 16; ++i) va[i] = __builtin_nontemporal_load((const GAS f32x4*)(d.W + (size_t)(4 * i + lr) * d.ldw + d.n0 + lc)); }
#pragma unroll 1
        for (int kb = 0; kb < 16; ++kb) {
            d.k0 = kb * 64;
            if (kb < 15) { const int lr = lane >> 4, lc = (lane & 15) * 4;
#pragma unroll
                for (int i = 0; i < 16; ++i) vb[i] = __builtin_nontemporal_load((const GAS f32x4*)(d.W + (size_t)(d.k0 + 64 + 4 * i + lr) * d.ldw + d.n0 + lc)); }
            const f32x4 kv0 = gldf4(d.ksc + d.k0 + 8 * (lane & 7)), kv1 = gldf4(d.ksc + d.k0 + 8 * (lane & 7) + 4);
            {
                const int lr = lane >> 4, lc = (lane & 15) * 4;
#pragma unroll
                for (int i = 0; i < 16; ++i) { LAS float* p = scr + (4 * i + lr) * 65 + lc; p[0] = va[i][0]; p[1] = va[i][1]; p[2] = va[i][2]; p[3] = va[i][3]; }
                asm volatile("s_waitcnt lgkmcnt(0)" ::: "memory");
                const int c = lane & 7;
#pragma unroll
                for (int j = 0; j < 8; ++j) { const int n = (lane >> 3) + 8 * j; const LAS float* s = scr + (8 * c) * 65 + n;
                    u32x4 o; o.x = cvt_pk_bf16(s[0 * 65] * kv0[0], s[1 * 65] * kv0[1]); o.y = cvt_pk_bf16(s[2 * 65] * kv0[2], s[3 * 65] * kv0[3]); o.z = cvt_pk_bf16(s[4 * 65] * kv1[0], s[5 * 65] * kv1[1]); o.w = cvt_pk_bf16(s[6 * 65] * kv1[2], s[7 * 65] * kv1[3]);
                    gst128(d.WT + (size_t)(d.drow0 + n) * d.ldt + d.k0 + 8 * c, o);
                    rmax[j] = fmaxf(rmax[j], fmaxf(fmaxf(fmaxf(fabsf(bflo(o.x)), fabsf(bfhi(o.x))), fmaxf(fabsf(bflo(o.y)), fabsf(bfhi(o.y)))), fmaxf(fmaxf(fabsf(bflo(o.z)), fabsf(bfhi(o.z))), fmaxf(fabsf(bflo(o.w)), fabsf(bfhi(o.w)))))); }
                asm volatile("s_waitcnt lgkmcnt(0)" ::: "memory"); }
            if (kb < 15) {
#pragma unroll
                for (int i = 0; i < 16; ++i) va[i] = vb[i]; }
        }
#pragma unroll
        for (int j = 0; j < 8; ++j) { float m = rmax[j]; m = fmaxf(m, __shfl_xor(m, 1)); m = fmaxf(m, __shfl_xor(m, 2)); m = fmaxf(m, __shfl_xor(m, 4)); rmax[j] = fmaxf(m, 1e-30f); }
        asm volatile("s_waitcnt vmcnt(0)" ::: "memory");
#pragma unroll
        for (int j = 0; j < 8; ++j) {
            u32x4 w0[8], w1[8];
#pragma unroll
            for (int q = 0; q < 8; ++q) { const bf16_t* rowp = d.WT + (size_t)(d.drow0 + q + 8 * j) * 1024; w0[q] = gld128(rowp + lane * 16); w1[q] = gld128(rowp + lane * 16 + 8); }
#pragma unroll
            for (int q = 0; q < 8; ++q) { const int rr = q + 8 * j; const float am = __shfl(rmax[j], q * 8); const float qs = 127.0f / am;
                bf16_t* rowp = d.WT + (size_t)(d.drow0 + rr) * 1024; const u32x4 a0 = w0[q], a1 = w1[q];
                u32x4 o;
                { const int q0 = (int)rintf(bflo(a0.x) * qs), q1 = (int)rintf(bfhi(a0.x) * qs), q2 = (int)rintf(bflo(a0.y) * qs), q3 = (int)rintf(bfhi(a0.y) * qs);
                  const int q4 = (int)rintf(bflo(a0.z) * qs), q5 = (int)rintf(bfhi(a0.z) * qs), q6 = (int)rintf(bflo(a0.w) * qs), q7 = (int)rintf(bfhi(a0.w) * qs);
                  o.x = (unsigned)(q0 & 255) | ((unsigned)(q1 & 255) << 8) | ((unsigned)(q2 & 255) << 16) | ((unsigned)(q3 & 255) << 24);
                  o.y = (unsigned)(q4 & 255) | ((unsigned)(q5 & 255) << 8) | ((unsigned)(q6 & 255) << 16) | ((unsigned)(q7 & 255) << 24); }
                { const int q0 = (int)rintf(bflo(a1.x) * qs), q1 = (int)rintf(bfhi(a1.x) * qs), q2 = (int)rintf(bflo(a1.y) * qs), q3 = (int)rintf(bfhi(a1.y) * qs);
                  const int q4 = (int)rintf(bflo(a1.z) * qs), q5 = (int)rintf(bfhi(a1.z) * qs), q6 = (int)rintf(bflo(a1.w) * qs), q7 = (int)rintf(bfhi(a1.w) * qs);
                  o.z = (unsigned)(q0 & 255) | ((unsigned)(q1 & 255) << 8) | ((unsigned)(q2 & 255) << 16) | ((unsigned)(q3 & 255) << 24);
                  o.w = (unsigned)(q4 & 255) | ((unsigned)(q5 & 255) << 8) | ((unsigned)(q6 & 255) << 16) | ((unsigned)(q7 & 255) << 24); }
                gst128((unsigned char*)rowp + lane * 16, o);
                if (lane == 0) gstf(swm + (size_t)mat * 1024 + d.drow0 + rr, am * (1.0f / 127.0f)); } }
    }
}
template <int NR>
__device__ __forceinline__ void rows_to_bf16(const float* xsrc, bf16_t* dst, float* rinv, int m0, int stride, int mmax, int lane) {
    f32x4 v[NR][4];
#pragma unroll
    for (int i = 0; i < NR; ++i) { const int m = m0 + i * stride; if (m < mmax) { const GAS f32x4* xr = (const GAS f32x4*)(xsrc + (size_t)m * 1024) + lane;
#pragma unroll
        for (int j = 0; j < 4; ++j) v[i][j] = __builtin_nontemporal_load(xr + 64 * j); } }
#pragma unroll
    for (int i = 0; i < NR; ++i) { const int m = m0 + i * stride; if (m < mmax) { float s = 0.f; GAS u32x2* o8 = (GAS u32x2*)(dst + (size_t)m * 1024) + lane;
#pragma unroll
        for (int j = 0; j < 4; ++j) { u32x2 w; w.x = cvt_pk_bf16(v[i][j][0], v[i][j][1]); w.y = cvt_pk_bf16(v[i][j][2], v[i][j][3]); o8[64 * j] = w;
            s += bflo(w.x) * bflo(w.x) + bfhi(w.x) * bfhi(w.x) + bflo(w.y) * bflo(w.y) + bfhi(w.y) * bfhi(w.y); }
        const float r = 1.0f / sqrtf(wave_sum(s) * (1.0f / 1024.0f) + RMS_EPS); if (lane == 0) gstf(rinv + m, r); } }
}
__device__ __forceinline__ void p0_rows(const ArgsV& a, int gw, int NGW, int lane) {
    unsigned char* ws = a.ws; bf16_t* X = (bf16_t*)(ws + WS_X); float* rinvA = (float*)(ws + WS_SMALL + SM_RINVA);
    { const float* xs = ARG(I_X); for (int m = gw; m < T_TOK; m += 8 * NGW) rows_to_bf16<8>(xs, X, rinvA, m, NGW, T_TOK, lane); }
    if (gw == 0) { u32x4* z = (u32x4*)(X + (size_t)T_TOK * 1024); z[lane] = (u32x4){0u, 0u, 0u, 0u}; z[lane + 64] = (u32x4){0u, 0u, 0u, 0u}; }
    bf16_t* MB = (bf16_t*)(ws + WS_MEMBF); float* rinvM = (float*)(ws + WS_SMALL + SM_RINVMEM);
    { const float* ms = ARG(I_MEM); for (int m = gw; m < MEMR; m += NGW) rows_to_bf16<1>(ms, MB, rinvM, m, NGW, MEMR, lane); }
    { const float* wq = ARG(I_XA_WQ); const float* xn = ARG(I_XA_NORM); bf16_t* base = (bf16_t*)(ws + WS_W_XA);
      for (int m = gw; m < 2048; m += NGW) { const int l = m >> 10, kin = m & 1023; const float sc = xn[m] * 0.0625f;
          const GAS f32x4* xr = (const GAS f32x4*)(wq + (size_t)m * 1024) + lane; GAS u32x2* o8 = (GAS u32x2*)(base + (size_t)l * 4 * MiB + (size_t)kin * 1024) + lane;
#pragma unroll
          for (int j = 0; j < 4; ++j) { const f32x4 v = xr[64 * j]; u32x2 w; w.x = cvt_pk_bf16(v[0] * sc, v[1] * sc); w.y = cvt_pk_bf16(v[2] * sc, v[3] * sc); o8[64 * j] = w; } } }
    { const float* wsp = ARG(I_GM_WS); bf16_t* WSB = (bf16_t*)(ws + WS_SMALL + SM_WSB);
      for (int i = gw * 64 + lane; i < 8 * 128 * 128; i += NGW * 64) { const int g = i >> 14, r = (i >> 7) & 127, cp = i & 127, qp = cp >> 3, e = cp & 7; const int cs = ((qp ^ (r & 15)) << 3) + e;
          const float v = ((r < 64) && (cs >= 64)) ? 0.f : wsp[(size_t)g * 16384 + r * 128 + cs];
          WSB[i] = (bf16_t)f2bf(v); } }
    bf16_t* RT = (bf16_t*)(ws + WS_W_RT);
    { const float* wgp = ARG(I_MOE_WG); const float* wep = ARG(I_MOE_WE); const float* mn = ARG(I_MOE_NORM);
      for (int i = gw * 64 + lane; i < 2 * 49152; i += NGW * 64) { const int l = i / 49152, r = i % 49152, e = r & 7, ln = (r >> 3) & 63, j = (r >> 9) % 3, ks = r / 1536;
        const int n = j * 16 + (ln & 15), k = ks * 32 + (ln >> 4) * 8 + e;
        float v = 0.f;
        if (n < 4) v = wgp[(size_t)l * 4096 + k * 4 + n]; else if (n < 36) v = wep[(size_t)l * 32768 + k * 32 + (n - 4)];
        v *= mn[l * 1024 + k];
        RT[(size_t)l * 49152 + r] = (bf16_t)f2bf(v); } }
}
__device__ __forceinline__ void p0_s5_tables(const ArgsV& a, LAS unsigned char* lds, int job, int tid) {
    const int g = job >> 2, qd = job & 3;
    LAS float* ABR = (LAS float*)lds;
    LAS float* ABI = ABR + 17 * 64;
    LAS float* CR = ABI + 17 * 64;
    LAS float* CI = CR + 1024;
    LAS float* BR = CI + 1024;
    LAS float* BI = BR + 1024;
    LAS float* KN = BI + 1024;
    __syncthreads();
    { const float dt = expf(ARG(I_S5_LOGDT)[g]);
      for (int i = tid; i < 17 * 64; i += NTHR) { const int lag = i >> 6, p = i & 63; const float lr = ARG(I_S5_LRE)[g * 64 + p], li = ARG(I_S5_LIM)[g * 64 + p];
          const float mag = expf(lr * dt * (float)lag); float sn, cs; sincosf(li * dt * (float)lag, &sn, &cs); ABR[i] = mag * cs; ABI[i] = mag * sn; }
      for (int i = tid; i < 1024; i += NTHR) { CR[i] = ARG(I_S5_CRE)[(size_t)g * 1024 + i]; CI[i] = ARG(I_S5_CIM)[(size_t)g * 1024 + i]; }
      __syncthreads();
      for (int i = tid; i < 1024; i += NTHR) { const int p = i >> 4; const float lr = ARG(I_S5_LRE)[g * 64 + p], li = ARG(I_S5_LIM)[g * 64 + p];
          const float ar = ABR[64 + p], ai = ABI[64 + p], den = lr * lr + li * li;
          const float cre = ((ar - 1.0f) * lr + ai * li) / den, cim = (ai * lr - (ar - 1.0f) * li) / den;
          const float br = ARG(I_S5_BRE)[(size_t)g * 1024 + i], bi = ARG(I_S5_BIM)[(size_t)g * 1024 + i];
          BR[i] = cre * br - cim * bi; BI[i] = cre * bi + cim * br; } }
    __syncthreads();
    for (int e = tid; e < 4096; e += NTHR) { const int lag = e >> 8, n = (e >> 4) & 15, np = e & 15; float acc = 0.f;
        for (int p = 0; p < 64; ++p) { const float ar = ABR[lag * 64 + p], ai = ABI[lag * 64 + p], br = BR[p * 16 + np], bi = BI[p * 16 + np];
            acc += CR[n * 64 + p] * (ar * br - ai * bi) - CI[n * 64 + p] * (ar * bi + ai * br); }
        KN[e] = acc; }
    __syncthreads();
    bf16_t* AF = (bf16_t*)(a.ws + WS_SCR + SC_S5A) + (size_t)g * 256 * 384;
    const float* dsk = ARG(I_S5_D);
    for (int e = tid; e < 64 * 384; e += NTHR) { const int r = qd * 64 + e / 384, k = e % 384, tl = r >> 4, n = r & 15; float v = 0.f;
        if (k < 256) { const int s = k >> 4, np = k & 15;
            if (s <= tl) { v = KN[((tl - s) * 16 + n) * 16 + np]; if (s == tl && np == n) v += dsk[g * 16 + n]; }
        } else { const int ci = k - 256, p = ci & 63; const float ar = ABR[(tl + 1) * 64 + p], ai = ABI[(tl + 1) * 64 + p], cr = CR[n * 64 + p], cim = CI[n * 64 + p];
            v = (ci < 64) ? (cr * ar - cim * ai) : -(cr * ai + cim * ar); }
        AF[(size_t)r * 384 + k] = (bf16_t)f2bf(v); }
    bf16_t* MS = (bf16_t*)(a.ws + WS_SCR + SC_S5M) + (size_t)g * 128 * 256;
    for (int e = tid; e < 32 * 256; e += NTHR) { const int pp = qd * 32 + e / 256, k = e % 256, s = k >> 4, np = k & 15, p = pp & 63;
        const float ar = ABR[(15 - s) * 64 + p], ai = ABI[(15 - s) * 64 + p], br = BR[p * 16 + np], bi = BI[p * 16 + np];
        const float v = (pp < 64) ? (ar * br - ai * bi) : (ar * bi + ai * br);
        MS[(size_t)pp * 256 + k] = (bf16_t)f2bf(v); }
    if (qd == 0 && tid < 64) { float* AB = (float*)(a.ws + WS_SMALL + SM_AB16) + (size_t)(g * 64 + tid) * 2; AB[0] = ABR[16 * 64 + tid]; AB[1] = ABI[16 * 64 + tid]; }
}

template <class Sched>
__device__ __forceinline__ void fill_rs(const Sched& S, LAS float* rs_lds, const float* direct, const float* part, int nslots, int tid) {
    g8::Unit u;
    for (int i = 0; i < 8 && S.next(i, u); ++i) {
        if (tid < 256) { const int row = u.pm * 256 + tid; float v;
            if (direct) v = direct[row];
            else { float s = 0.f; const f32x4* p = (const f32x4*)(part + (size_t)row * 32); for (int j = 0; j < nslots / 4; ++j) { const f32x4 t = p[j]; s += (t[0] + t[1]) + (t[2] + t[3]); } v = 1.0f / sqrtf(s * (1.0f / 1024.0f) + RMS_EPS); }
            rs_lds[i * 256 + tid] = v; }
    }
    __syncthreads();
}

struct S5Sched {
    int b, g;
    __device__ __forceinline__ bool next(int i, g8::Unit& u) const { if (i >= 2) return false;
        const int bt = b * 2 + i;
        const unsigned off = (unsigned)g * 1048576u + (unsigned)bt * (256u * 512u);
        u.A = (unsigned)(WS_SCR + SC_U) + off; u.A2 = (unsigned)(WS_SCR + SC_H2) + off; u.B = (unsigned)(WS_SCR + SC_S5A) + (unsigned)g * (256u * 768u); u.pm = bt; u.pn = 0; u.slot = i; u.aux = g; return true; }
    __device__ __forceinline__ void a_ready(const g8::Unit&, int, int) const {}
};
__device__ __forceinline__ void s5_scan_pair(const ArgsV& a, LAS unsigned char* lds, int b, int g, int tid, int wave, int lane, unsigned long long* pts = nullptr) {
#define S5_PST(k) do { if (pts && blockIdx.x == 0 && tid == 0) pts[k] = __builtin_amdgcn_s_memrealtime(); } while (0)
    S5_PST(0);
    unsigned char* ws = a.ws;
    const bf16_t* U = (const bf16_t*)(ws + WS_SCR + SC_U); bf16_t* H2 = (bf16_t*)(ws + WS_SCR + SC_H2);
    const bf16_t* MS = (const bf16_t*)(ws + WS_SCR + SC_S5M) + (size_t)g * 128 * 256;
    LAS unsigned char* UL = lds; LAS float* SL = (LAS float*)(lds + 67584); LAS float* LC = (LAS float*)(lds + 133120); LAS float* CC = LC + 1024;
    const int fr = lane & 15, fq = lane >> 4;
    bf16x8 mf[8];
#pragma unroll
    for (int ks = 0; ks < 8; ++ks) mf[ks] = *(const GAS bf16x8*)(MS + (size_t)(wave * 16 + fr) * 256 + ks * 32 + fq * 8);
    const int p = tid & 63, chk = tid >> 6;
    float a1r, a1i; { const float* AB = (const float*)(ws + WS_SMALL + SM_AB16) + (size_t)(g * 64 + p) * 2; a1r = AB[0]; a1i = AB[1]; }
    float a16r = a1r, a16i = a1i;
#pragma unroll
    for (int i = 0; i < 4; ++i) { const float r = a16r * a16r - a16i * a16i, im = 2.f * a16r * a16i; a16r = r; a16i = im; }
    float hr = 0.f, hi = 0.f;
    u32x4 pre[8];
#define S5_LOADQ(qt_) do { _Pragma("unroll") for (int i = 0; i < 8; ++i) { const int idx = tid + i * NTHR, t = idx >> 1, hf = idx & 1; \
        pre[i] = gld128(U + ((size_t)g * T_TOK + (size_t)(b * 512 + (qt_) * 128) * 16) * 16 + (size_t)idx * 8); (void)t; (void)hf; } } while (0)
    S5_LOADQ(0);
    for (int qt = 0; qt < 4; ++qt) {
        __syncthreads();
#pragma unroll
        for (int i = 0; i < 8; ++i) { const int idx = tid + i * NTHR, t = idx >> 1, hf = idx & 1; *(LAS u32x4*)(UL + (t >> 4) * 528 + (t & 15) * 32 + hf * 16) = pre[i]; }
        __syncthreads();
        if (qt < 3) S5_LOADQ(qt + 1);
#pragma unroll 1
        for (int bt = 0; bt < 8; ++bt) { f32x4 acc = (f32x4){0.f, 0.f, 0.f, 0.f};
#pragma unroll
            for (int ks = 0; ks < 8; ++ks) { const bf16x8 yb = *(const LAS bf16x8*)(UL + (bt * 16 + fr) * 528 + (2 * ks + (fq >> 1)) * 32 + (fq & 1) * 16);
                acc = __builtin_amdgcn_mfma_f32_16x16x32_bf16(mf[ks], yb, acc, 0, 0, 0); }
            *(LAS f32x4*)(SL + (bt * 16 + fr) * 128 + wave * 16 + fq * 4) = acc; }
        __syncthreads();
        { float lr = 0.f, li = 0.f;
#pragma unroll 4
          for (int j = 0; j < 16; ++j) { const float sr = SL[(chk * 16 + j) * 128 + p], si = SL[(chk * 16 + j) * 128 + 64 + p];
              const float nr = a1r * lr - a1i * li + sr, ni = a1r * li + a1i * lr + si; lr = nr; li = ni; }
          LC[(chk * 64 + p) * 2] = lr; LC[(chk * 64 + p) * 2 + 1] = li; }
        __syncthreads();
        if (tid < 64) {
#pragma unroll
            for (int cI = 0; cI < 8; ++cI) { CC[(cI * 64 + p) * 2] = hr; CC[(cI * 64 + p) * 2 + 1] = hi;
                const float lr = LC[(cI * 64 + p) * 2], li = LC[(cI * 64 + p) * 2 + 1];
                const float nr = a16r * hr - a16i * hi + lr, ni = a16r * hi + a16i * hr + li; hr = nr; hi = ni; } }
        __syncthreads();
        { float cr = CC[(chk * 64 + p) * 2], ci = CC[(chk * 64 + p) * 2 + 1];
#pragma unroll 4
          for (int j = 0; j < 16; ++j) { const int blk = b * 512 + qt * 128 + chk * 16 + j;
              GAS bf16_t* hrow = (GAS bf16_t*)(H2 + ((size_t)g * 2048 + blk) * 256);
              hrow[p] = (bf16_t)f2bf(cr); hrow[64 + p] = (bf16_t)f2bf(ci);
              const float sr = SL[(chk * 16 + j) * 128 + p], si = SL[(chk * 16 + j) * 128 + 64 + p];
              const float nr = a1r * cr - a1i * ci + sr, ni = a1r * ci + a1i * cr + si; cr = nr; ci = ni; } }
    }
#undef S5_LOADQ
    asm volatile("s_waitcnt vmcnt(0)" ::: "memory");
    __syncthreads();
    S5_PST(1);
    S5Sched S{b, g};
    g8::EpiS5B E{(bf16_t*)(ws + WS_SCR + SC_Y)};
    g8::gemm_phase<g8::EpiS5B, S5Sched, 8, 512, 768, 128, 128, 6, 4>(lds, (const char*)ws, S, E, nullptr, tid);
    S5_PST(2);
#undef S5_PST
}

struct PrepSched {
    unsigned A, B; int pm, pn;
    __device__ __forceinline__ bool next(int i, g8::Unit& u) const { if (i) return false; u.A = A; u.A2 = A; u.B = B; u.pm = pm; u.pn = pn; u.slot = 0; u.aux = 0; return true; }
    __device__ __forceinline__ void a_ready(const g8::Unit&, int, int) const {}
};
__device__ __forceinline__ void prep_phase(const ArgsV& a, LAS unsigned char* lds, int layer, int c, int tid) {
    unsigned char* ws = a.ws; const int x = c & 7, r = c >> 3, b = x >> 1, h = (r >> 2) & 3, t = r & 3;
    const unsigned KV = (unsigned)WS_KV + (unsigned)layer * (unsigned)(4 * MiB) + (unsigned)b * (256u * 4096u) + (unsigned)h * 512u;
    const unsigned WX = (unsigned)WS_W_XA + (unsigned)layer * (unsigned)(8 * MiB);
    bf16_t* GX = (bf16_t*)(ws + (layer == 0 ? WS_SCR + SC_G0 : WS_G1) + (size_t)x * 4 * MiB);
    if (r < 16) { PrepSched S{KV, WX + (unsigned)t * (256u * 2048u) + (unsigned)h * 512u, h, t};
        g8::EpiStore E{GX, 1024};
        g8::gemm_phase<g8::EpiStore, PrepSched, 0, 4096, 2048, 128, 128, 4, 4>(lds, (const char*)ws, S, E, nullptr, tid); }
    else { PrepSched S{WX + (unsigned)(6 * MiB) + (unsigned)t * (256u * 2048u) + (unsigned)h * 512u, KV + 2048u, t, h};
        g8::EpiStore E{GX + 1048576, 1024};
        g8::gemm_phase<g8::EpiStore, PrepSched, 0, 2048, 4096, 128, 128, 4, 4>(lds, (const char*)ws, S, E, nullptr, tid); }
}

__device__ __forceinline__ void router_phase(const ArgsV& a, LAS unsigned char* lds, int layer, int G, int c, int tid, int wave, int lane) {
    unsigned char* ws = a.ws;
    const bf16_t* X = (const bf16_t*)(ws + WS_X); const bf16_t* RT = (const bf16_t*)(ws + WS_W_RT) + (size_t)layer * 49152;
    float* rinvB = (float*)(ws + WS_SMALL + SM_RINVB); float* wts = (float*)(ws + WS_SMALL + SM_WTS); unsigned char* xq = ws + WS_SCR + SC_XQ;
    unsigned* cnt = (unsigned*)(ws + WS_CTL) + CW_CNT + layer * 64; int* list = (int*)(ws + WS_LIST);
    if (blockIdx.x == 0 && tid < 64) ((GAS u32x4*)(xq + (size_t)T_TOK * 1024))[tid] = (u32x4){0u, 0u, 0u, 0u};
    LAS float* LG = (LAS float*)(lds + 98304);
    LAS int* HIST = (LAS int*)(lds + 118784);
    LAS int* ASG = (LAS int*)(lds + 119040);
    const int fr = lane & 15, fq = lane >> 4;
    const float* bgp = ARG(I_MOE_BG); const float* bep = ARG(I_MOE_BE);
    __syncthreads();
#pragma unroll
    for (int t = 0; t < 12; ++t) { const int i = wave * 12 + t; __builtin_amdgcn_global_load_lds((const unsigned*)((const char*)RT + i * 1024 + lane * 16), (LAS unsigned*)(lds + i * 1024), 16, 0, 0); }
    for (int it = (c & 7) * (G >> 3) + (c >> 3); it < T_TOK / 128; it += G) {
        const int tok0 = it * 128 + wave * 16;
        bf16x8 xa[32];
        const bf16_t* xrow = X + (size_t)(tok0 + fr) * 1024 + fq * 8;
#pragma unroll
        for (int ks = 0; ks < 32; ++ks) xa[ks] = *(const GAS bf16x8*)(xrow + ks * 32);
        asm volatile("s_waitcnt vmcnt(0)" ::: "memory");
        __syncthreads();
        if (tid < 64) HIST[tid] = 0;
        f32x4 acc[3];
#pragma unroll
        for (int j = 0; j < 3; ++j) acc[j] = (f32x4){0.f, 0.f, 0.f, 0.f};
        float ss = 0.f, am = 0.f;
#pragma unroll
        for (int ks = 0; ks < 32; ++ks) { const u32x4 w = __builtin_bit_cast(u32x4, xa[ks]);
            ss += bflo(w.x) * bflo(w.x) + bfhi(w.x) * bfhi(w.x) + bflo(w.y) * bflo(w.y) + bfhi(w.y) * bfhi(w.y) + bflo(w.z) * bflo(w.z) + bfhi(w.z) * bfhi(w.z) + bflo(w.w) * bflo(w.w) + bfhi(w.w) * bfhi(w.w);
            am = fmaxf(am, fmaxf(fmaxf(fmaxf(fabsf(bflo(w.x)), fabsf(bfhi(w.x))), fmaxf(fabsf(bflo(w.y)), fabsf(bfhi(w.y)))), fmaxf(fmaxf(fabsf(bflo(w.z)), fabsf(bfhi(w.z))), fmaxf(fabsf(bflo(w.w)), fabsf(bfhi(w.w)))))); }
        ss += __shfl_xor(ss, 16); ss += __shfl_xor(ss, 32);
        am = fmaxf(am, __shfl_xor(am, 16)); am = fmaxf(am, __shfl_xor(am, 32)); am = fmaxf(am, 1e-20f);
        const float rinv = 1.0f / sqrtf(ss * (1.0f / 1024.0f) + RMS_EPS), qs = 127.0f / am;
        if (fq == 0) rinvB[tok0 + fr] = rinv * am * (1.0f / 127.0f);
        GAS u32x2* qrow = (GAS u32x2*)(xq + (size_t)(tok0 + fr) * 1024 + fq * 8);
#pragma unroll
        for (int ks = 0; ks < 32; ++ks) {
#pragma unroll
            for (int j = 0; j < 3; ++j) { const bf16x8 wb = *(const LAS bf16x8*)(lds + ((ks * 3 + j) * 64 + lane) * 16);
                acc[j] = __builtin_amdgcn_mfma_f32_16x16x32_bf16(xa[ks], wb, acc[j], 0, 0, 0); }
            { u32x4 w = __builtin_bit_cast(u32x4, xa[ks]); asm volatile("" : "+v"(w));
              const int q0 = (int)rintf(bflo(w.x) * qs), q1 = (int)rintf(bfhi(w.x) * qs), q2 = (int)rintf(bflo(w.y) * qs), q3 = (int)rintf(bfhi(w.y) * qs);
              const int q4 = (int)rintf(bflo(w.z) * qs), q5 = (int)rintf(bfhi(w.z) * qs), q6 = (int)rintf(bflo(w.w) * qs), q7 = (int)rintf(bfhi(w.w) * qs);
              u32x2 o; o.x = (unsigned)(q0 & 255) | ((unsigned)(q1 & 255) << 8) | ((unsigned)(q2 & 255) << 16) | ((unsigned)(q3 & 255) << 24);
              o.y = (unsigned)(q4 & 255) | ((unsigned)(q5 & 255) << 8) | ((unsigned)(q6 & 255) << 16) | ((unsigned)(q7 & 255) << 24);
              qrow[ks * 4] = o; } }
#pragma unroll
        for (int reg = 0; reg < 4; ++reg) { const float rv = __shfl(rinv, fq * 4 + reg);
#pragma unroll
            for (int j = 0; j < 3; ++j) { const int n = j * 16 + fr; if (n < 40) LG[(wave * 16 + fq * 4 + reg) * 40 + n] = acc[j][reg] * rv; } }
        __syncthreads();
        if (tid < 128) { const int t = tid; const LAS float* lg = LG + t * 40;
            float gl[4]; int gsel = 0; float gm = -3.0e38f;
#pragma unroll
            for (int j = 0; j < 4; ++j) { gl[j] = lg[j] + bgp[layer * 4 + j]; if (gl[j] > gm) { gm = gl[j]; gsel = j; } }
            float gs = 0.f;
#pragma unroll
            for (int j = 0; j < 4; ++j) gs += expf(gl[j] - gm);
            const float wg = 1.0f / gs;
            float v0 = -3.0e38f, v1 = -3.0e38f; int i0 = 0, i1 = 0;
            for (int j = 0; j < 8; ++j) { const float v = lg[4 + gsel * 8 + j] + bep[layer * 32 + gsel * 8 + j];
                if (v > v0) { v1 = v0; i1 = i0; v0 = v; i0 = j; } else if (v > v1) { v1 = v; i1 = j; } }
            const float e1 = expf(v1 - v0), den = 1.0f / (1.0f + e1);
            const int tok = it * 128 + t; const int ea = gsel * 8 + i0, eb = gsel * 8 + i1;
            wts[(size_t)tok * 2] = wg * den; wts[(size_t)tok * 2 + 1] = wg * e1 * den;
            ASG[t * 4] = ea; ASG[t * 4 + 1] = __hip_atomic_fetch_add(HIST + ea, 1, __ATOMIC_RELAXED, __HIP_MEMORY_SCOPE_WORKGROUP); ASG[t * 4 + 2] = eb; ASG[t * 4 + 3] = __hip_atomic_fetch_add(HIST + eb, 1, __ATOMIC_RELAXED, __HIP_MEMORY_SCOPE_WORKGROUP); }
        __syncthreads();
        if (tid < 32) { const int n = HIST[tid]; HIST[32 + tid] = n ? (int)atomicAdd(&cnt[tid], (unsigned)n) : 0; }
        __syncthreads();
        if (tid < 128) { const int tok = it * 128 + tid; const int ea = ASG[tid * 4], eb = ASG[tid * 4 + 2];
            list[(size_t)ea * 32768 + HIST[32 + ea] + ASG[tid * 4 + 1]] = tok * 2; list[(size_t)eb * 32768 + HIST[32 + eb] + ASG[tid * 4 + 3]] = tok * 2 + 1; }
    }
    asm volatile("s_waitcnt vmcnt(0)" ::: "memory");
}

__device__ __forceinline__ bool moe_unit(int uidx, const LAS int* TP, unsigned A, unsigned arow, unsigned Bw, unsigned bstride, unsigned btile, int slot, g8::Unit& u) {
    if (uidx < 0 || uidx >= TP[32] * 4) return false;
    const int rtile = uidx >> 2, pn = uidx & 3; int e = 0;
    for (int j = 1; j < 32; ++j) e += (TP[j] <= rtile) ? 1 : 0;
    u.A = A + (unsigned)rtile * 256u * arow; u.A2 = u.A; u.B = Bw + (unsigned)e * bstride + (unsigned)pn * btile;
    u.pm = rtile * 256; u.pn = pn; u.slot = slot; u.aux = e | ((rtile - TP[e]) << 8); return true;
}
struct MoeUpSched {
    unsigned Bw; const LAS int* TP; int r;
    const LAS int* UD;
    __device__ __forceinline__ bool make(int i, g8::Unit& u) const { return moe_unit(i * 256 + r, TP, (unsigned)(WS_SCR + SC_XQ), 0u, Bw, (unsigned)(2 * MiB), 512u * 1024u, i, u); }
    __device__ __forceinline__ bool next(int i, g8::Unit& u) const { if (i >= 5) return false; const LAS int* d = UD + i * 8; if (!d[0]) return false;
        u.A = (unsigned)d[1]; u.A2 = u.A; u.B = (unsigned)d[2]; u.pm = d[3]; u.pn = d[4]; u.aux = d[5]; u.slot = i; return true; }
    __device__ __forceinline__ void a_ready(const g8::Unit&, int, int) const {}
};
struct MoeDownSched {
    unsigned Bw; const LAS int* TP; int r; unsigned* done; unsigned* tmo;
    __device__ __forceinline__ int didx(int i) const {
        const int NU = TP[32] * 4, n5 = NU - 1024;
        if (n5 < 0 || n5 > 85) return i * 256 + r;
        if (r < n5) return i < 3 ? i * 256 + r : -1;
        if (i < 4) return i * 256 + r;
        if (i == 4) { if (r < 2 * n5) return 768 + (r - n5); if (r < 3 * n5) return 1024 + (r - 2 * n5); }
        return -1;
    }
    const LAS int* UD;
    __device__ __forceinline__ bool make(int i, g8::Unit& u) const { return moe_unit(didx(i), TP, (unsigned)(WS_SCR + SC_HB), 1024u, Bw, (unsigned)(1 * MiB), 256u * 1024u, i, u); }
    __device__ __forceinline__ bool next(int i, g8::Unit& u) const { if (i >= 5) return false; const LAS int* d = UD + i * 8; if (!d[0]) return false;
        u.A = (unsigned)d[1]; u.A2 = u.A; u.B = (unsigned)d[2]; u.pm = d[3]; u.pn = d[4]; u.aux = d[5]; u.slot = i; return true; }
    __device__ __forceinline__ void a_ready(const g8::Unit& u, int wid, int lane) const {
        if (wid == 0) { unsigned* w = done + (u.pm >> 8) * 64; unsigned sp = 0;
            while ((unsigned)__builtin_amdgcn_readfirstlane(__hip_atomic_load(w, __ATOMIC_RELAXED, __HIP_MEMORY_SCOPE_AGENT)) < 32u) {
                __builtin_amdgcn_s_sleep(2);
                if (++sp > (1u << 20)) { if (lane == 0) __hip_atomic_fetch_add(tmo, 1u, __ATOMIC_RELAXED, __HIP_MEMORY_SCOPE_AGENT); break; } }
            __builtin_amdgcn_fence(__ATOMIC_ACQUIRE, "agent");
            asm volatile("s_waitcnt vmcnt(0)" ::: "memory"); }
        asm volatile("" ::: "memory"); __builtin_amdgcn_s_barrier(); asm volatile("" ::: "memory");
    }
};
__device__ __forceinline__ void moe_tables(const ArgsV& a, LAS unsigned char* lds, int layer, const MoeUpSched& SU, const MoeDownSched& SD, int tid) {
    unsigned char* ws = a.ws; const unsigned* cnt = (const unsigned*)(ws + WS_CTL) + CW_CNT + layer * 64; const int* list = (const int*)(ws + WS_LIST);
    const float* rinvB = (const float*)(ws + WS_SMALL + SM_RINVB); const float* wts = (const float*)(ws + WS_SMALL + SM_WTS);
    LAS int* TP = (LAS int*)(lds + LX_TAB); LAS int* TOK = TP + 64; LAS float* RS = (LAS float*)(TOK + 5 * 256); LAS float* WT = RS + 5 * 256; LAS int* TOKK = (LAS int*)(WT + 5 * 256);
    __syncthreads();
    if (tid == 0) { int s = 0; for (int e = 0; e < 32; ++e) { TP[e] = s; s += ((int)cnt[e] + 255) >> 8; } TP[32] = s; }
    __syncthreads();
    g8::Unit u;
    if (tid == 0) { LAS int* du = (LAS int*)SU.UD; LAS int* dd = (LAS int*)SD.UD; bool ok = true;
        for (int i = 0; i < 5; ++i) { ok = ok && SU.make(i, u); du[i * 8] = ok ? 1 : 0; du[i * 8 + 1] = (int)u.A; du[i * 8 + 2] = (int)u.B; du[i * 8 + 3] = u.pm; du[i * 8 + 4] = u.pn; du[i * 8 + 5] = u.aux; }
        ok = true;
        for (int i = 0; i < 5; ++i) { ok = ok && SD.make(i, u); dd[i * 8] = ok ? 1 : 0; dd[i * 8 + 1] = (int)u.A; dd[i * 8 + 2] = (int)u.B; dd[i * 8 + 3] = u.pm; dd[i * 8 + 4] = u.pn; dd[i * 8 + 5] = u.aux; } }
    __syncthreads();
    for (int i = 0; i < 5 && SU.next(i, u); ++i) {
        if (tid < 256) { const int e = u.aux & 255, rt = u.aux >> 8; const int pos = rt * 256 + tid; const int n = (int)cnt[e];
            int tok = T_TOK; float rs = 0.f, wt = 0.f;
            if (pos < n) { const int tk = list[(size_t)e * 32768 + pos]; tok = tk >> 1; rs = rinvB[tok]; wt = wts[tk]; }
            TOK[i * 256 + tid] = tok; RS[i * 256 + tid] = rs; WT[i * 256 + tid] = wt; } }
    for (int i = 0; i < 5 && SD.next(i, u); ++i) {
        if (tid < 256) { const int e = u.aux & 255, rt = u.aux >> 8; const int pos = rt * 256 + tid; const int n = (int)cnt[e];
            TOKK[i * 256 + tid] = (pos < n) ? list[(size_t)e * 32768 + pos] : -1; } }
    __syncthreads();
}
__device__ __forceinline__ void requant_gmin(const ArgsV& a, int gw, int NGW, int lane) {
    unsigned char* ws = a.ws; const bf16_t* W = (const bf16_t*)(ws + WS_W_GMIN); unsigned char* Q = ws + WS_W_GMQ; float* sw = (float*)(ws + WS_SMALL + SM_GMSW);
    for (int n = gw; n < 4096; n += NGW) {
        const GAS u32x4* wp = (const GAS u32x4*)(W + (size_t)n * 1024) + lane; u32x4 wv[2]; float am = 0.f;
#pragma unroll
        for (int j = 0; j < 2; ++j) { wv[j] = wp[64 * j]; const u32x4 w = wv[j];
            am = fmaxf(am, fmaxf(fmaxf(fmaxf(fabsf(bflo(w.x)), fabsf(bfhi(w.x))), fmaxf(fabsf(bflo(w.y)), fabsf(bfhi(w.y)))), fmaxf(fmaxf(fabsf(bflo(w.z)), fabsf(bfhi(w.z))), fmaxf(fabsf(bflo(w.w)), fabsf(bfhi(w.w)))))); }
#pragma unroll
        for (int o = 1; o < 64; o <<= 1) am = fmaxf(am, __shfl_xor(am, o));
        am = fmaxf(am, 1e-30f); const float qs = 127.0f / am;
        GAS u32x2* qp = (GAS u32x2*)(Q + (size_t)n * 1024) + lane;
#pragma unroll
        for (int j = 0; j < 2; ++j) { const u32x4 w = wv[j];
            const int q0 = (int)rintf(bflo(w.x) * qs), q1 = (int)rintf(bfhi(w.x) * qs), q2 = (int)rintf(bflo(w.y) * qs), q3 = (int)rintf(bfhi(w.y) * qs);
            const int q4 = (int)rintf(bflo(w.z) * qs), q5 = (int)rintf(bfhi(w.z) * qs), q6 = (int)rintf(bflo(w.w) * qs), q7 = (int)rintf(bfhi(w.w) * qs);
            u32x2 o; o.x = (unsigned)(q0 & 255) | ((unsigned)(q1 & 255) << 8) | ((unsigned)(q2 & 255) << 16) | ((unsigned)(q3 & 255) << 24);
            o.y = (unsigned)(q4 & 255) | ((unsigned)(q5 & 255) << 8) | ((unsigned)(q6 & 255) << 16) | ((unsigned)(q7 & 255) << 24);
            qp[64 * j] = o; }
        if (lane == 0) gstf(sw + n, am * (1.0f / 127.0f)); }
}
__device__ __forceinline__ void combine_phase(const ArgsV& a, int base, int lw, int stride, int nk, int lane, bool last) {
    unsigned char* ws = a.ws; bf16_t* X = (bf16_t*)(ws + WS_X); const bf16_t* YS = (const bf16_t*)(ws + WS_SCR + SC_YS); float* rinvA = (float*)(ws + WS_SMALL + SM_RINVA); unsigned char* xq = ws + WS_P1;
    for (int k = 0; k < nk; ++k) { const int m = base + lw + k * stride;
        GAS u32x4* xp = (GAS u32x4*)(X + (size_t)m * 1024) + lane; const GAS u32x4* y0 = (const GAS u32x4*)(YS + (size_t)m * 2048) + lane; const GAS u32x4* y1 = y0 + 128;
        float v[2][8]; float s = 0.f;
#pragma unroll
        for (int j = 0; j < 2; ++j) { const u32x4 xv = xp[64 * j], p = y0[64 * j], q = y1[64 * j];
            v[j][0] = bflo(xv.x) + bflo(p.x) + bflo(q.x); v[j][1] = bfhi(xv.x) + bfhi(p.x) + bfhi(q.x); v[j][2] = bflo(xv.y) + bflo(p.y) + bflo(q.y); v[j][3] = bfhi(xv.y) + bfhi(p.y) + bfhi(q.y);
            v[j][4] = bflo(xv.z) + bflo(p.z) + bflo(q.z); v[j][5] = bfhi(xv.z) + bfhi(p.z) + bfhi(q.z); v[j][6] = bflo(xv.w) + bflo(p.w) + bflo(q.w); v[j][7] = bfhi(xv.w) + bfhi(p.w) + bfhi(q.w); }
        if (!last) {
            u32x4 wv[2];
#pragma unroll
            for (int j = 0; j < 2; ++j) { u32x4 w; w.x = cvt_pk_bf16(v[j][0], v[j][1]); w.y = cvt_pk_bf16(v[j][2], v[j][3]); w.z = cvt_pk_bf16(v[j][4], v[j][5]); w.w = cvt_pk_bf16(v[j][6], v[j][7]); xp[64 * j] = w; wv[j] = w;
                s += bflo(w.x) * bflo(w.x) + bfhi(w.x) * bfhi(w.x) + bflo(w.y) * bflo(w.y) + bfhi(w.y) * bfhi(w.y) + bflo(w.z) * bflo(w.z) + bfhi(w.z) * bfhi(w.z) + bflo(w.w) * bflo(w.w) + bfhi(w.w) * bfhi(w.w); }
            const float r = 1.0f / sqrtf(wave_sum(s) * (1.0f / 1024.0f) + RMS_EPS);
            float am = 0.f;
#pragma unroll
            for (int j = 0; j < 2; ++j) { const u32x4 w = wv[j];
                am = fmaxf(am, fmaxf(fmaxf(fmaxf(fabsf(bflo(w.x)), fabsf(bfhi(w.x))), fmaxf(fabsf(bflo(w.y)), fabsf(bfhi(w.y)))), fmaxf(fmaxf(fabsf(bflo(w.z)), fabsf(bfhi(w.z))), fmaxf(fabsf(bflo(w.w)), fabsf(bfhi(w.w)))))); }
#pragma unroll
            for (int o = 1; o < 64; o <<= 1) am = fmaxf(am, __shfl_xor(am, o));
            am = fmaxf(am, 1e-20f); const float qs = 127.0f / am;
            GAS u32x2* qp = (GAS u32x2*)(xq + (size_t)m * 2048) + lane;
#pragma unroll
            for (int j = 0; j < 2; ++j) { const u32x4 w = wv[j];
                const int q0 = (int)rintf(bflo(w.x) * qs), q1 = (int)rintf(bfhi(w.x) * qs), q2 = (int)rintf(bflo(w.y) * qs), q3 = (int)rintf(bfhi(w.y) * qs);
                const int q4 = (int)rintf(bflo(w.z) * qs), q5 = (int)rintf(bfhi(w.z) * qs), q6 = (int)rintf(bflo(w.w) * qs), q7 = (int)rintf(bfhi(w.w) * qs);
                u32x2 o; o.x = (unsigned)(q0 & 255) | ((unsigned)(q1 & 255) << 8) | ((unsigned)(q2 & 255) << 16) | ((unsigned)(q3 & 255) << 24);
                o.y = (unsigned)(q4 & 255) | ((unsigned)(q5 & 255) << 8) | ((unsigned)(q6 & 255) << 16) | ((unsigned)(q7 & 255) << 24);
                qp[64 * j] = o; }
            if (lane == 0) gstf(rinvA + m, r * am * (1.0f / 127.0f));
        } else {
#pragma unroll
            for (int j = 0; j < 2; ++j)
#pragma unroll
                for (int k = 0; k < 8; ++k) s += v[j][k] * v[j][k];
            const float r = 1.0f / sqrtf(wave_sum(s) * (1.0f / 1024.0f) + RMS_EPS);
#pragma unroll
            for (int j = 0; j < 2; ++j) { const GAS f32x4* gp = (const GAS f32x4*)(ARG(I_FINAL_NORM) + (64 * j + lane) * 8); const f32x4 g0 = gp[0], g1 = gp[1];
                GAS f32x4* op = (GAS f32x4*)(((float*)ARG(33)) + (size_t)m * 1024 + (64 * j + lane) * 8);
                op[0] = (f32x4){v[j][0] * r * g0[0], v[j][1] * r * g0[1], v[j][2] * r * g0[2], v[j][3] * r * g0[3]};
                op[1] = (f32x4){v[j][4] * r * g1[0], v[j][5] * r * g1[1], v[j][6] * r * g1[2], v[j][7] * r * g1[3]}; }
        }
    }
}

__device__ __forceinline__ void spatial_phase(const ArgsV& a, LAS unsigned char* lds, int G, int c, int tid, int wave, int lane) {
    unsigned char* ws = a.ws; bf16_t* Z = (bf16_t*)(ws + WS_SCR + SC_Z); const float* part = (const float*)(ws + WS_PART);
    const char* WSB = (const char*)(ws + WS_SMALL + SM_WSB);
    LAS float* RV = (LAS float*)lds;
    LAS unsigned char* WLB = lds + 512;
    LAS bf16_t* ZL = (LAS bf16_t*)(lds + 512 + 65536);
    const int fr = lane & 15, fq = lane >> 4;
    const float* VN = ARG(I_GM_VNORM); const float* BS = ARG(I_GM_BS);
    for (int span = (c & 7) * (G >> 3) + (c >> 3); span < 256; span += G) {
        const size_t row0 = (size_t)span * 128;
        u32x4 zr[8]; u32x4 uv[8], un[8];
#define SP_LOADZ(gg_) do { _Pragma("unroll") for (int i = 0; i < 8; ++i) { const int idx = tid + i * NTHR; zr[i] = gld128(Z + ((size_t)span * 16 + 8 + (gg_)) * 32768 + (size_t)idx * 8); } } while (0)
#define SP_LOADU(dst, gg_) do { _Pragma("unroll") for (int mt = 0; mt < 8; ++mt) \
            dst[mt] = gld128(Z + ((size_t)span * 16 + (gg_)) * 32768 + (mt * 16 + fr) * 256 + wave * 32 + fq * 8); } while (0)
#define SP_DMAW(gg_) do { _Pragma("unroll") for (int t = 0; t < 4; ++t) { const int i = wave * 4 + t; \
            __builtin_amdgcn_global_load_lds((const unsigned*)(WSB + (size_t)(gg_) * 32768 + i * 1024 + lane * 16), (LAS unsigned*)(WLB + ((gg_) & 1) * 32768 + i * 1024), 16, 0, 0); } } while (0)
        __syncthreads();
        SP_LOADZ(0); SP_LOADU(un, 0); SP_DMAW(0);
        if (tid < 128) { float s = 0.f; const GAS f32x4* pp = (const GAS f32x4*)(part + (row0 + tid) * 32);
#pragma unroll
            for (int j = 0; j < 8; ++j) { const f32x4 t = pp[j]; s += (t[0] + t[1]) + (t[2] + t[3]); }
            RV[tid] = 1.0f / sqrtf(s * (1.0f / 2048.0f) + RMS_EPS); }
        __syncthreads();
#pragma unroll 1
        for (int gg = 0; gg < 8; ++gg) {
            asm volatile("s_waitcnt vmcnt(0)" ::: "memory");
#pragma unroll
            for (int i = 0; i < 8; ++i) { const int idx = tid + i * NTHR, j = idx >> 5, c8 = idx & 31; const float rv = RV[j];
                LAS unsigned* d = (LAS unsigned*)(ZL + j * 258 + c8 * 8);
                d[0] = cvt_pk_bf16(bflo(zr[i].x) * rv, bfhi(zr[i].x) * rv); d[1] = cvt_pk_bf16(bflo(zr[i].y) * rv, bfhi(zr[i].y) * rv);
                d[2] = cvt_pk_bf16(bflo(zr[i].z) * rv, bfhi(zr[i].z) * rv); d[3] = cvt_pk_bf16(bflo(zr[i].w) * rv, bfhi(zr[i].w) * rv); }
#pragma unroll
            for (int mt = 0; mt < 8; ++mt) uv[mt] = un[mt];
            __syncthreads();
            if (gg < 7) { SP_DMAW(gg + 1); SP_LOADZ(gg + 1); SP_LOADU(un, gg + 1); }
            LAS unsigned char* WL = WLB + (gg & 1) * 32768;
            const f32x4 vn0 = gldf4(VN + gg * 256 + wave * 32 + fq * 8), vn1 = gldf4(VN + gg * 256 + wave * 32 + fq * 8 + 4);
#pragma unroll
            for (int hf = 0; hf < 2; ++hf) {
                f32x4 acc[2][4];
#pragma unroll
                for (int t = 0; t < 2; ++t)
#pragma unroll
                    for (int mt = 0; mt < 4; ++mt) acc[t][mt] = (f32x4){0.f, 0.f, 0.f, 0.f};
#pragma unroll 1
                for (int ks = 0; ks < 4; ++ks) {
                    bf16x8 za[2];
#pragma unroll
                    for (int t = 0; t < 2; ++t) { const int cc = wave * 32 + 8 * (fr >> 2) + 4 * t + (fr & 3); const LAS bf16_t* zp = ZL + (ks * 32 + fq * 8) * 258 + cc;
#pragma unroll
                        for (int jj = 0; jj < 8; ++jj) za[t][jj] = (short)zp[jj * 258]; }
#pragma unroll
                    for (int mt = 0; mt < 4; ++mt) { const bf16x8 wb = *(const LAS bf16x8*)(WL + ((hf * 4 + mt) * 16 + fr) * 256 + (((ks * 4 + fq) ^ fr) << 4));
                        acc[0][mt] = __builtin_amdgcn_mfma_f32_16x16x32_bf16(za[0], wb, acc[0][mt], 0, 0, 0);
                        acc[1][mt] = __builtin_amdgcn_mfma_f32_16x16x32_bf16(za[1], wb, acc[1][mt], 0, 0, 0); } }
#pragma unroll
                for (int mt = 0; mt < 4; ++mt) { const int i = (hf * 4 + mt) * 16 + fr; const float bs = gldf(BS + gg * 128 + i);
                    const u32x4 uvv = uv[hf * 4 + mt]; const f32x4 m0 = acc[0][mt], m1 = acc[1][mt];
                    u32x4 o; o.x = cvt_pk_bf16(bflo(uvv.x) * (vn0[0] * m0[0] + bs), bfhi(uvv.x) * (vn0[1] * m0[1] + bs)); o.y = cvt_pk_bf16(bflo(uvv.y) * (vn0[2] * m0[2] + bs), bfhi(uvv.y) * (vn0[3] * m0[3] + bs));
                    o.z = cvt_pk_bf16(bflo(uvv.z) * (vn1[0] * m1[0] + bs), bfhi(uvv.z) * (vn1[1] * m1[1] + bs)); o.w = cvt_pk_bf16(bflo(uvv.w) * (vn1[2] * m1[2] + bs), bfhi(uvv.w) * (vn1[3] * m1[3] + bs));
                    gst128(Z + ((size_t)span * 16 + gg) * 32768 + i * 256 + wave * 32 + fq * 8, o); }
            }
            __syncthreads();
        }
#undef SP_LOADZ
#undef SP_LOADU
#undef SP_DMAW
    }
    asm volatile("s_waitcnt vmcnt(0)" ::: "memory");
}
struct KvSched {
    int G, c;
    __device__ __forceinline__ bool next(int i, g8::Unit& u) const {
        const int idx = i * G + c; if (idx >= 64) return false;
        const int l = idx >> 5, pm = (idx >> 3) & 3, pn = idx & 7;
        u.A = (unsigned)WS_MEMBF + (unsigned)pm * (256u * 2048u); u.A2 = u.A; u.B = (unsigned)WS_W_XA + (unsigned)l * (unsigned)(8 * MiB) + (unsigned)(2 * MiB) + (unsigned)pn * (256u * 2048u);
        u.pm = pm; u.pn = pn; u.slot = i; u.aux = l; return true; }
    __device__ __forceinline__ void a_ready(const g8::Unit&, int, int) const {}
};

#ifndef ONLY
#define ONLY -1
#endif
#define PH(n) (ONLY < 0 || ONLY == (n))
#ifndef P0_EARLY_LATE
#define P0_EARLY_LATE 8192
#endif
#define PHASE_CTX \
    ArgsV a; a.ws = (unsigned char*)ARG(34); unsigned char* ws = a.ws; const char* wsb = (const char*)ws; (void)wsb; \
    int tid_ = wave0 * 64 + lane_id(); asm volatile("" : "+v"(tid_)); const int tid = tid_, lane = tid & 63, wave = wave0; \
    const int G = gridDim.x; const volatile LAS unsigned* MS_ = (const volatile LAS unsigned*)(lds + LX_MISC); const int regular = __builtin_amdgcn_readfirstlane((int)MS_[10]) == 1; \
    const int c = regular ? __builtin_amdgcn_readfirstlane((int)(MS_[12] * 8u + MS_[13])) : (int)blockIdx.x;     \
    const int gw = c * NWAVES + wave, NGW = G * NWAVES; (void)gw; (void)NGW; (void)lane; \
    LAS float* RSL = (LAS float*)(lds + LX_TAB); bf16_t* X = (bf16_t*)(ws + WS_X); float* part = (float*)(ws + WS_PART); const float* rinvA = (const float*)(ws + WS_SMALL + SM_RINVA); \
    (void)RSL; (void)X; (void)part; (void)rinvA;
#ifndef PROBE_A
#define PROBE_A -1
#define PROBE_B -1
#endif
#ifndef PROBE_TICKS
#define PROBE_TICKS 1600
#endif
#define TSTAMP() do { if (PROBE_A >= 0 && blockIdx.x == 0 && wave0 == 0 && lane_id() == 0) { unsigned long long* ts_ = (unsigned long long*)((unsigned char*)ARG(34) + WS_CTL) + CW_DBG / 2; unsigned* n_ = (unsigned*)(ts_ + 200); ts_[*n_] = __builtin_amdgcn_s_memrealtime(); *n_ = *n_ + 1; } } while (0)
#define SUBSTAMP(k) do { if (PROBE_A >= 0 && blockIdx.x == 0 && wave0 == 0 && lane_id() == 0) { unsigned long long* ts_ = (unsigned long long*)((unsigned char*)ARG(34) + WS_CTL) + CW_DBG / 2; ts_[k] = __builtin_amdgcn_s_memrealtime(); } } while (0)
#define GRID_BAR() do { XcdBarrier bar_; bar_.bar = (unsigned*)((unsigned char*)ARG(34) + WS_CTL) + CW_BAR; bar_.x = xb_xcc_id(); bar_.st = (volatile LAS unsigned*)(lds + LX_MISC) + 8; xcd_barrier(bar_, wave0 == 0 && lane_id() == 0); TSTAMP(); } while (0)
#define LOCAL_BAR() do { const volatile LAS unsigned* ms_ = (const volatile LAS unsigned*)(lds + LX_MISC); if (__builtin_amdgcn_readfirstlane((int)ms_[10]) == 1) \
        xcc_local_barrier((unsigned*)((unsigned char*)ARG(34) + WS_CTL) + CW_BAR, (unsigned)__builtin_amdgcn_readfirstlane((int)ms_[13]), (unsigned)__builtin_amdgcn_readfirstlane((int)ms_[8]), wave0 == 0 && lane_id() == 0); \
    else GRID_BAR(); } while (0)
typedef g8::StdSched<128, 4, 256u * 2048u, 256u * 2048u> SchedN1024;

__global__ void __launch_bounds__(NTHR, 2) fwd_megakernel(Args a_unused) {
    extern __shared__ __attribute__((aligned(16))) unsigned char lds_raw[];
    LAS unsigned char* lds = (LAS unsigned char*)lds_raw;
    const int wave0 = __builtin_amdgcn_readfirstlane((int)threadIdx.x >> 6);
    { volatile LAS unsigned* MISC = (volatile LAS unsigned*)(lds + LX_MISC);
      if (wave0 == 0) MISC[lane_id()] = 0u;
      __syncthreads();
      if (wave0 == 0 && lane_id() == 0) { const unsigned x_ = xb_xcc_id(); MISC[13] = x_; MISC[12] = xcd_barrier_post((unsigned*)((unsigned char*)ARG(34) + WS_CTL) + CW_BAR, x_, true); }
      __syncthreads(); }
    TSTAMP();

    if (PH(0)) { PHASE_CTX
      SUBSTAMP(24);
      if (c < 256) p0_s5_tables(a, lds, c, tid);
      __syncthreads();
      SUBSTAMP(25);
      p0_weights(a, lds, 0, 0, 1 << 30, gw, NGW, wave, lane);
      SUBSTAMP(26);
      p0_rows(a, gw, NGW, lane);
      SUBSTAMP(27);
      p0_weights(a, lds, 1, 0, P0_EARLY_LATE, gw, NGW, wave, lane); }
    GRID_BAR();

    if (PH(1)) { PHASE_CTX
      if ((c >> 3) < (G >> 4)) {
        const int cg = c - ((c >> 3) >= (G >> 4) ? (G >> 1) : 0), Gg = G >> 1;
        { typedef g8::StdSched<128, 4, 256u * 2048u, 256u * 2048u> Sc; Sc S{(unsigned)WS_X, (unsigned)WS_W_S5IN, Gg, cg};
          fill_rs(S, RSL, rinvA, nullptr, 0, tid);
          g8::EpiU E{(bf16_t*)(ws + WS_SCR + SC_U), RSL};
          g8::gemm_phase<g8::EpiU, Sc, 0, 2048, 2048, 128, 128, 16, 16>(lds, wsb, S, E, nullptr, tid); }
        { KvSched S{Gg, cg};
          g8::EpiKV E{(bf16_t*)(ws + WS_KV), (const float*)(ws + WS_SMALL + SM_RINVMEM)};
          g8::gemm_phase<g8::EpiKV, KvSched, 0, 2048, 2048, 128, 128, 16, 16>(lds, wsb, S, E, nullptr, tid); }
      } else {
        const int cw = c - (G >> 1);
        p0_weights(a, lds, 1, P0_EARLY_LATE, 1 << 30, cw * NWAVES + wave, (G >> 1) * NWAVES, wave, lane);
        p0_moe_gu_jobs(a, lds, cw * NWAVES + wave, (G >> 1) * NWAVES, wave, lane);
      } }
    GRID_BAR();

    if (PH(3)) { PHASE_CTX
      { const int pr = c; if (pr < 256) { const int q = pr >> 3; s5_scan_pair(a, lds, q >> 3, (pr & 7) * 8 + (q & 7), tid, wave, lane, PROBE_A >= 0 ? (unsigned long long*)(ws + WS_CTL) + CW_DBG / 2 + 48 : nullptr); } }
      requant_gmin(a, gw, NGW, lane);
      prep_phase(a, lds, 0, c, tid); }
    GRID_BAR();

    if (PH(4)) { PHASE_CTX
      typedef g8::StdSched<128, 8, 256u * 32u, 256u * 2048u> Sc; Sc S{(unsigned)(WS_SCR + SC_Y), (unsigned)WS_W_S5OUT, G, c};
      g8::EpiGluRes E{X, part};
      g8::gemm_phase<g8::EpiGluRes, Sc, 16, 32, 2048, 4194304, 128, 16, 16>(lds, wsb, S, E, nullptr, tid); }
    LOCAL_BAR();

#pragma unroll 1
    for (int layer = 0; layer < 2; ++layer) {
        if (layer == 1) {
            if (PH(5)) { PHASE_CTX
              typedef g8::StdSched<128, 16, 256u * 2048u, 256u * 1024u> Sc; Sc S{(unsigned)WS_P1, (unsigned)WS_W_GMQ, G, c};
              fill_rs(S, RSL, rinvA, nullptr, 0, tid);
              g8::EpiGmIn E{(bf16_t*)(ws + WS_SCR + SC_Z), RSL, part, (const float*)(ws + WS_SMALL + SM_GMSW)};
              g8::gemm_phase<g8::EpiGmIn, Sc, 0, 2048, 1024, 128, 128, 8, 8>(lds, wsb, S, E, nullptr, tid); }
            LOCAL_BAR();
            if (PH(6)) { PHASE_CTX
              spatial_phase(a, lds, G, c, tid, wave, lane); }
            LOCAL_BAR();
            if (PH(7)) { PHASE_CTX
              typedef g8::StdSched<128, 4, 256u * 8192u, 256u * 4224u> Sc; Sc S{(unsigned)(WS_SCR + SC_Z), (unsigned)WS_W_GMOUT_P, G, c};
              g8::EpiRes<true> E{X, part};
              g8::gemm_phase<g8::EpiRes<true>, Sc, 4, 512, 4224, 128, 128, 32, 32>(lds, wsb, S, E, nullptr, tid, (PROBE_A >= 0) ? (unsigned long long*)(ws + WS_CTL) + CW_DBG / 2 + 40 : nullptr);
              prep_phase(a, lds, 1, c, tid); }
            LOCAL_BAR();
        }
        if (PH(8)) { PHASE_CTX
          const unsigned GXo = (layer == 0 ? (unsigned)(WS_SCR + SC_G0) : (unsigned)WS_G1) + (unsigned)(c & 7) * (unsigned)(4 * MiB);
          SchedN1024 S{(unsigned)WS_X, GXo, G, c};
          fill_rs(S, RSL, nullptr, part, layer == 0 ? 32 : 16, tid);
          g8::EpiSoftmax E{(bf16_t*)(ws + (layer == 0 ? WS_SCR + SC_P0 : WS_P1)), RSL, (LAS float*)(lds + LX_TAB + 8192)};
          g8::gemm_phase<g8::EpiSoftmax, SchedN1024, 0, 2048, 2048, 128, 128, 16, 16>(lds, wsb, S, E, nullptr, tid, (PROBE_A >= 0 && layer == 0) ? (unsigned long long*)(ws + WS_CTL) + CW_DBG / 2 + 32 : nullptr); }
        LOCAL_BAR();
        if (PH(10)) { PHASE_CTX
          const unsigned GXo = (layer == 0 ? (unsigned)(WS_SCR + SC_G0) : (unsigned)WS_G1) + (unsigned)(c & 7) * (unsigned)(4 * MiB) + (unsigned)(2 * MiB);
          SchedN1024 S{layer == 0 ? (unsigned)(WS_SCR + SC_P0) : (unsigned)WS_P1, GXo, G, c};
          g8::EpiRes<false> E{X, part};
          g8::gemm_phase<g8::EpiRes<false>, SchedN1024, 0, 2048, 2048, 128, 128, 16, 16>(lds, wsb, S, E, nullptr, tid); }
        GRID_BAR();
        if (PH(11)) { PHASE_CTX
          router_phase(a, lds, layer, G, c, tid, wave, lane); }
        GRID_BAR();
        if (PH(12)) { PHASE_CTX
          LAS int* TP = (LAS int*)(lds + LX_TAB); LAS int* TOK = TP + 64; LAS float* RS = (LAS float*)(TOK + 5 * 256); LAS float* WT = RS + 5 * 256; LAS int* TOKK = (LAS int*)(WT + 5 * 256);
          unsigned* done = (unsigned*)(ws + WS_CTL) + CW_DONE + layer * 32768;
          const int r = (c & 7) * (G >> 3) + (c >> 3);
          LAS int* UDU = TOKK + 5 * 256; LAS int* UDD = UDU + 64;
          MoeUpSched SU{(unsigned)WS_W_MOE + (unsigned)layer * (unsigned)MOE_L_STRIDE, TP, r, UDU};
          MoeDownSched SD{(unsigned)WS_W_MOE + (unsigned)layer * (unsigned)MOE_L_STRIDE + (unsigned)MOE_D_OFF, TP, r, done, (unsigned*)(ws + WS_CTL) + CW_BAR + XB_TMO, UDD};
          moe_tables(a, lds, layer, SU, SD, tid);
          { g8::EpiMoeUp E{__builtin_amdgcn_make_buffer_rsrc((void*)(ws + WS_SCR + SC_HB), (short)0, (int)(73728u * 1024u), 0x00020000), RS, WT, done, (const float*)(ws + WS_SMALL + SM_MOESW) + layer * 32768};
            g8::gemm_phase<g8::EpiMoeUp, MoeUpSched, 1, 1024, 2048, 128, 128, 8, 8>(lds, wsb, SU, E, TOK, tid); }
          { g8::EpiMoeDown E{(bf16_t*)(ws + WS_SCR + SC_YS), TOKK};
            g8::gemm_phase<g8::EpiMoeDown, MoeDownSched, 0, 1024, 1024, 128, 128, 8, 8>(lds, wsb, SD, E, nullptr, tid); } }
        GRID_BAR();
        if (PH(14)) { PHASE_CTX
          if (regular) combine_phase(a, (c & 7) * 4096, (c >> 3) * NWAVES + wave, (G >> 3) * NWAVES, 16, lane, layer == 1);
          else combine_phase(a, 0, gw, NGW, T_TOK / NGW, lane, layer == 1); }
        if (layer == 0) LOCAL_BAR();
    }
    if (PROBE_A >= 0 && blockIdx.x == 0 && wave0 == 0 && lane_id() == 0) {
        asm volatile("s_waitcnt vmcnt(0)" ::: "memory");
        unsigned long long* ts_ = (unsigned long long*)((unsigned char*)ARG(34) + WS_CTL) + CW_DBG / 2; const unsigned long long te = __builtin_amdgcn_s_memrealtime(); ts_[21] = te;
        unsigned long long qa = (ts_[PROBE_A + 1] - ts_[PROBE_A] + PROBE_TICKS / 2) / PROBE_TICKS, qb = (ts_[PROBE_B + 1] - ts_[PROBE_B] + PROBE_TICKS / 2) / PROBE_TICKS; if (qa > 63) qa = 63; if (qb > 63) qb = 63;
        const unsigned long long D = (qa + 64 * qb) * 6400;
        while (__builtin_amdgcn_s_memrealtime() - te < D) __builtin_amdgcn_s_sleep(32);
    }
    { unsigned* ctl = (unsigned*)((unsigned char*)ARG(34) + WS_CTL);
      if (xb_ld(ctl + CW_BAR + XB_TMO) != 0u && blockIdx.x == 0 && wave0 == 0 && lane_id() == 0) ((float*)ARG(33))[0] = __builtin_nanf(""); }
}

extern "C" void kernel_launch(void* const* d_in, const int* in_sizes, int n_in, void* d_out, int out_size, void* d_ws, size_t ws_size, hipStream_t stream) {
    static int grid = 0;
    if (grid == 0) {
        if (n_in != 33 || in_sizes[0] != T_TOK * DM || out_size != T_TOK * DM || ws_size < WS_END) {
            fprintf(stderr, "kernel_launch: unexpected problem (n_in %d, in0 %d, out %d, ws %zu < %zu)\n", n_in, n_in > 0 ? in_sizes[0] : -1, out_size, ws_size, (size_t)WS_END); grid = -1; return; }
        int dev = 0, cus = 0, per_cu = 0;
        if (hipGetDevice(&dev) != hipSuccess || hipDeviceGetAttribute(&cus, hipDeviceAttributeMultiprocessorCount, dev) != hipSuccess) { grid = -1; return; }
        if (hipFuncSetAttribute((const void*)fwd_megakernel, hipFuncAttributeMaxDynamicSharedMemorySize, LDS_BYTES) != hipSuccess) { fprintf(stderr, "kernel_launch: hipFuncSetAttribute failed\n"); grid = -1; return; }
        if (hipOccupancyMaxActiveBlocksPerMultiprocessor(&per_cu, (const void*)fwd_megakernel, NTHR, LDS_BYTES) != hipSuccess || per_cu < 1) { fprintf(stderr, "kernel_launch: occupancy query says %d blocks per CU\n", per_cu); (void)hipGetLastError(); grid = -1; return; }
        grid = cus;
        if (grid != 256) { fprintf(stderr, "kernel_launch: built for 256 CUs, device has %d\n", cus); grid = -1; return; }
    }
    if (grid < 0) return;
    if (hipMemsetAsync((char*)d_ws + WS_CTL, 0, CTL_BYTES, stream) != hipSuccess) { fprintf(stderr, "kernel_launch: memset failed\n"); return; }
    Args a{};
    for (int i = 0; i < 33; ++i) a.in[i] = (const float*)d_in[i];
    a.out = (float*)d_out; a.ws = (unsigned char*)d_ws;
    void* args[] = {&a};
    const hipError_t e = hipLaunchCooperativeKernel((const void*)fwd_megakernel, dim3(grid), dim3(NTHR), args, LDS_BYTES, stream);
    if (e != hipSuccess) fprintf(stderr, "kernel_launch: cooperative launch failed: %s\n", hipGetErrorString(e));
}
```

```cpp
#include <hip/hip_runtime.h>
#include <cstdio>
#include <cstdint>

#define LAS __attribute__((address_space(3)))
typedef unsigned short bf16_t;
typedef short bf16x8 __attribute__((ext_vector_type(8)));
typedef float f32x4 __attribute__((ext_vector_type(4)));
typedef float f32x2 __attribute__((ext_vector_type(2)));
typedef unsigned u32x4 __attribute__((ext_vector_type(4)));
typedef unsigned u32x2 __attribute__((ext_vector_type(2)));
typedef int i32x4 __attribute__((ext_vector_type(4)));

constexpr int T_TOK = 32768, DM = 1024, NBATCH = 4, SEQ = 8192, MEMR = 1024;
constexpr float RMS_EPS = 1e-6f;
constexpr int NWAVES = 8, NTHR = 512;

constexpr size_t MiB = 1u << 20;
constexpr size_t WS_CTL = 0, CTL_BYTES = 1 * MiB;
constexpr size_t WS_W_S5IN = 1 * MiB, WS_W_S5OUT = 3 * MiB, WS_W_GMIN = 7 * MiB, WS_W_GMOUT = 15 * MiB, WS_W_XA = 19 * MiB  ;
constexpr size_t WS_W_RT = 35 * MiB;
constexpr size_t WS_W_MOE = 36 * MiB;
constexpr size_t MOE_L_STRIDE = 96 * MiB, MOE_D_OFF = 64 * MiB;
constexpr size_t WS_MEMBF = 228 * MiB, WS_KV = 230 * MiB;
constexpr size_t WS_SMALL = 238 * MiB;
constexpr size_t SM_RINVMEM = 0, SM_RINVA = 64 * 1024, SM_RINVB = 256 * 1024, SM_WTS = 512 * 1024, SM_AB16 = 1024 * 1024, SM_MOESW = 1536 * 1024  , SM_GMSW = 1024 * 1024 + 32768  , SM_WSB = 1024 * 1024 + 65536  ;
constexpr size_t WS_PART = 240 * MiB, WS_LIST = 244 * MiB, WS_X = 248 * MiB, WS_SCR = 313 * MiB, WS_W_GMOUT_P = 569 * MiB  , WS_W_GMQ = 574 * MiB  , WS_END = 578 * MiB;
constexpr size_t SC_U = 0, SC_H2 = 64 * MiB, SC_Y = 128 * MiB, SC_S5A = 192 * MiB, SC_S5M = 204 * MiB;
constexpr size_t SC_P0 = 0, SC_G0 = 208 * MiB;
constexpr size_t WS_G1 = WS_W_MOE, WS_P1 = WS_W_MOE + 32 * MiB;
constexpr size_t SC_XQ = 0  , SC_HB = 32 * MiB, SC_YS = 104 * MiB;
constexpr size_t SC_Z = 0;
constexpr int CW_BAR = 4096, CW_CNT = 16384  , CW_DBG = 20480, CW_DONE = 65536  ;

constexpr int LDS_BYTES = 155648;
constexpr int LDS_EXTRA = 131072;
constexpr int LX_MISC = LDS_BYTES - 256;
constexpr int LX_TAB = LDS_EXTRA;

#define GAS __attribute__((address_space(1)))
__device__ __forceinline__ u32x4 gld128(const void* p) { return *(const GAS u32x4*)p; }
__device__ __forceinline__ void gst128(void* p, u32x4 v) { *(GAS u32x4*)p = v; }
__device__ __forceinline__ f32x4 gldf4(const void* p) { return *(const GAS f32x4*)p; }
__device__ __forceinline__ float gldf(const float* p) { return *(const GAS float*)p; }
__device__ __forceinline__ void gstf(float* p, float v) { *(GAS float*)p = v; }
__device__ __forceinline__ unsigned cvt_pk_bf16(float lo, float hi) { unsigned r; asm volatile("v_cvt_pk_bf16_f32 %0, %1, %2" : "=v"(r) : "v"(lo), "v"(hi)); return r; }
__device__ __forceinline__ unsigned f2bf(float f) { unsigned u = __builtin_bit_cast(unsigned, f); return (u + 0x7fffu + ((u >> 16) & 1u)) >> 16; }
__device__ __forceinline__ float bf2f(unsigned h) { return __builtin_bit_cast(float, h << 16); }
__device__ __forceinline__ float bflo(unsigned w) { return __builtin_bit_cast(float, w << 16); }
__device__ __forceinline__ float bfhi(unsigned w) { return __builtin_bit_cast(float, w & 0xffff0000u); }
__device__ __forceinline__ float wave_sum(float v) {
#pragma unroll
    for (int o = 1; o < 64; o <<= 1) v += __shfl_xor(v, o);
    return v;
}
__device__ __forceinline__ int lane_id() { int l; asm volatile("v_mbcnt_lo_u32_b32 %0, -1, 0\n\tv_mbcnt_hi_u32_b32 %0, -1, %0" : "=v"(l)); return l; }
__device__ __forceinline__ float fast_rcp(float x) { return __builtin_amdgcn_rcpf(x); }
__device__ __forceinline__ float fast_exp2(float x) { return __builtin_amdgcn_exp2f(x); }
__device__ __forceinline__ float sigmoid_f(float g) { return fast_rcp(1.0f + fast_exp2(-1.4426950408889634f * g)); }
__device__ __forceinline__ float gelu_tanh(float x) {
    const float t = x * (1.0f + 0.044715f * x * x);
    return x * fast_rcp(1.0f + fast_exp2(-2.302208198f * t));
}

#define XB_TMO      128
#define XB_XCNT(j)  (256  + 64 * (j))
#define XB_XSUB(j)  (1280 + 64 * (j))
#define XB_XGEN(j)  (2304 + 64 * (j))
#define XB_TOP      3328
#define XB_TOPGEN   3392
#define XCD_BAR_WORDS 3456
#define XB_SPIN_CAP (1u << 18)
__device__ __forceinline__ unsigned xb_ld(unsigned* p)              { return __hip_atomic_load(p, __ATOMIC_RELAXED, __HIP_MEMORY_SCOPE_AGENT); }
__device__ __forceinline__ unsigned xb_add(unsigned* p, unsigned v) { return __hip_atomic_fetch_add(p, v, __ATOMIC_RELAXED, __HIP_MEMORY_SCOPE_AGENT); }
__device__ __forceinline__ unsigned xb_xcc_id() { return (unsigned)__builtin_amdgcn_s_getreg((3 << 11) | 20) & 0xFu; }
#define XB_SPIN(cond, bar) do { unsigned _sp = 0; while (cond) { __builtin_amdgcn_s_sleep(1); \
    if ((++_sp & 255u) == 0u) { if (xb_ld(&(bar)[XB_TMO])) break; if (_sp > XB_SPIN_CAP) { atomicAdd(&(bar)[XB_TMO], 1u); break; } } } } while (0)
struct XcdBarrier { unsigned* bar; unsigned x; volatile LAS unsigned* st; };
__device__ __forceinline__ unsigned xcd_barrier_post(unsigned* bar, unsigned x, bool leader) {
    unsigned rank = 0u;
    if (leader) rank = xb_add(&bar[XB_XCNT(x)], 1u);
    return rank;
}
__device__ __forceinline__ void xcd_barrier_complete(unsigned* bar, unsigned x, unsigned& nloc, unsigned& nx, unsigned& regular) {
    const unsigned G = gridDim.x * gridDim.y * gridDim.z;
    unsigned sum, cnt, mine, bad, sp = 0u;
    for (;;) {
        sum = 0u; cnt = 0u; mine = 0u; bad = 0u;
#pragma unroll
        for (unsigned j = 0; j < 16; ++j) { const unsigned c = xb_ld(&bar[XB_XCNT(j)]); sum += c; cnt += (c > 0u) ? 1u : 0u; mine = (j == x) ? c : mine; bad += (c != 0u && c * 8u != G) ? 1u : 0u; }
        if (sum == G) break;
        __builtin_amdgcn_s_sleep(1);
        if ((++sp & 255u) == 0u) { if (xb_ld(&bar[XB_TMO])) break; if (sp > XB_SPIN_CAP) { atomicAdd(&bar[XB_TMO], 1u); break; } }
    }
    nloc = mine > 0u ? mine : 1u; nx = cnt > 0u ? cnt : 1u; regular = (sum == G && cnt == 8u && bad == 0u) ? 1u : 2u;
}
__device__ __forceinline__ void xcd_barrier(const XcdBarrier& b, bool leader) {
    asm volatile("s_waitcnt vmcnt(0)" ::: "memory");
    __syncthreads();
    if (leader) {
        unsigned* bar = b.bar;
        __builtin_amdgcn_s_waitcnt(0);
        unsigned nloc = b.st[0], nx = b.st[1];
        if (nloc == 0u) { unsigned reg; xcd_barrier_complete(bar, b.x, nloc, nx, reg); b.st[0] = nloc; b.st[1] = nx; b.st[2] = reg; }
        const unsigned old = xb_add(&bar[XB_XSUB(b.x)], 1u);
        const unsigned gen = old / nloc;
        if (old + 1u == (gen + 1u) * nloc) {
            __builtin_amdgcn_fence(__ATOMIC_RELEASE, "agent");
            asm volatile("s_waitcnt vmcnt(0)" ::: "memory");
            const unsigned og = xb_add(&bar[XB_TOP], 1u);
            const unsigned tg = og / nx;
            if (og + 1u == (tg + 1u) * nx) xb_add(&bar[XB_TOPGEN], 1u);
            else XB_SPIN(xb_ld(&bar[XB_TOPGEN]) == tg, bar);
            __builtin_amdgcn_fence(__ATOMIC_ACQUIRE, "agent");
            xb_add(&bar[XB_XGEN(b.x)], 1u);
            asm volatile("s_waitcnt vmcnt(0)" ::: "memory");
        } else {
            XB_SPIN(xb_ld(&bar[XB_XGEN(b.x)]) == gen, bar);
            __builtin_amdgcn_fence(__ATOMIC_ACQUIRE, "agent");
            asm volatile("s_waitcnt vmcnt(0)" ::: "memory");
        }
    }
    __syncthreads();
}

#define XL_SUB(j) (4096 + 64 * (j))
#define XL_GEN(j) (5120 + 64 * (j))
__device__ __forceinline__ void xcc_local_barrier(unsigned* bar, unsigned x, unsigned nloc, bool leader) {
    asm volatile("s_waitcnt vmcnt(0)" ::: "memory");
    __syncthreads();
    if (leader) {
        __builtin_amdgcn_s_waitcnt(0);
        const unsigned old = xb_add(&bar[XL_SUB(x)], 1u);
        const unsigned gen = old / nloc;
        if (old + 1u == (gen + 1u) * nloc) xb_add(&bar[XL_GEN(x)], 1u);
        else XB_SPIN(xb_ld(&bar[XL_GEN(x)]) == gen, bar);
        __builtin_amdgcn_fence(__ATOMIC_ACQUIRE, "agent");
        asm volatile("s_waitcnt vmcnt(0)" ::: "memory");
    }
    __syncthreads();
}

namespace g8 {
constexpr int BM = 256, BK = 64, HALF = 128, HTB = HALF * BK * 2, STAGE_BYTES = 8 * HTB, NXCD = 8, WGM = 8;
__host__ __device__ __forceinline__ int lds_byte(int r, int c) { const int st = (r >> 4) * 2 + (c >> 5), rr = r & 15, cc = c & 31, ob = rr * 64 + cc * 2; return st * 1024 + (ob ^ (((ob >> 9) & 1) << 5)); }
__host__ __device__ __forceinline__ void stage_rc(int b, int& R, int& C) { const int st = b / 1024, sb = b % 1024, swz = sb ^ (((sb >> 9) & 1) << 5); R = (st >> 1) * 16 + swz / 64; C = (st & 1) * 32 + (swz % 64) / 2; }
__host__ __device__ __forceinline__ int perm32(int rho) { const int n = rho >> 4, i = rho & 15; return 8 * (i >> 2) + 4 * n + (i & 3); }

struct Unit {
    unsigned A;
    unsigned A2;
    unsigned B;
    int pm, pn;
    int slot;
    int aux;
};
struct Cfg { int lda, ldb, kstepA, kstepB, nt, asplit; };

__device__ __forceinline__ bool static_order(int i, int G, int c, int nM, int nN, int& pm, int& pn) {
    const int nwg = nM * nN; const int L = i * G + c; if (L >= nwg) return false;
    int wgid = L; { const int q = nwg / NXCD, r = nwg % NXCD, xcd = wgid % NXCD, off = wgid / NXCD; wgid = (xcd < r ? xcd * (q + 1) : r * (q + 1) + (xcd - r) * q) + off; }
    const int nig = WGM * nN, gid = wgid / nig, fm = gid * WGM, gsz = (nM - fm) < WGM ? (nM - fm) : WGM;
    pm = fm + ((wgid % nig) % gsz); pn = (wgid % nig) / gsz; return true;
}
template <int NM, int NN, unsigned TSA, unsigned TSB>
struct StdSched {
    unsigned A, B; int G, c;
    __device__ __forceinline__ bool next(int i, Unit& u) const {
        int pm, pn; if (!static_order(i, G, c, NM, NN, pm, pn)) return false;
        u.A = A + (unsigned)pm * TSA; u.A2 = u.A; u.B = B + (unsigned)pn * TSB; u.pm = pm; u.pn = pn; u.slot = i; u.aux = 0; return true;
    }
    __device__ __forceinline__ void a_ready(const Unit&, int, int) const {}
};

template <class Epi, class Sched, int MODE, int LDA, int LDB, int KSA, int KSB, int NT, int ASPLIT>
__device__ __forceinline__ void gemm_phase(LAS unsigned char* lds, const char* wsb, const Sched& S, const Epi& E, const LAS int* tok_lds, int tid_in, unsigned long long* pts = nullptr) {
    constexpr Cfg cfg{LDA, LDB, KSA, KSB, NT, ASPLIT};
    int tid_ = tid_in; asm volatile("" : "+v"(tid_));
    const int tid = tid_, wid = __builtin_amdgcn_readfirstlane(tid >> 6), lane = tid & 63, wr = wid >> 2, wc = wid & 3, fr = lane & 15, fq = lane >> 4;
    constexpr int nt = NT;
    constexpr bool GATHER = (MODE & 1) != 0, TOKA = (MODE & 2) != 0, ZTILE = (MODE & 4) != 0, SPLIT = (MODE & 10) != 0, PLANE = (MODE & 16) != 0;
    int RA[2], CA[2]; unsigned voffA[2], voffB[2];
#pragma unroll
    for (int i = 0; i < 2; ++i) { int R, C; stage_rc(tid * 16 + i * 8192, R, C); const int Rb = Epi::PERM ? ((R & ~31) + perm32(R & 31)) : R;
        RA[i] = R; CA[i] = C;
        const unsigned acol = TOKA ? (unsigned)((C >> 4) * 2048 + (C & 15) * 2) : (PLANE ? (unsigned)((C >> 4) * 1048576 + (C & 15) * 2) : (unsigned)(C * 2));
        voffA[i] = (unsigned)R * (unsigned)cfg.lda + acol; voffB[i] = (unsigned)Rb * (unsigned)cfg.ldb + (unsigned)(C * 2); }
    constexpr unsigned kstepA = (unsigned)KSA, kstepB = (unsigned)KSB;
    constexpr unsigned hstepA = ZTILE ? 1048576u : (unsigned)HALF * (unsigned)LDA, hstepB = (unsigned)HALF * (unsigned)LDB;
    const unsigned ldsw = (unsigned)wid * 1024u;
    const int aoff = lds_byte(wr * 64 + fr, fq * 8), boff = lds_byte(wc * 32 + fr, fq * 8);
    unsigned gc00 = 0, gc01 = 0, gc10 = 0, gc11 = 0, gn00 = 0, gn01 = 0, gn10 = 0, gn11 = 0;
#define G8_SA(b, h) (((b) * 2 + (h)) * HTB)
#define G8_SB(b, h) ((4 + (b) * 2 + (h)) * HTB)
#define G8_GLDS(off32, ldsoff) __builtin_amdgcn_global_load_lds((const unsigned*)(wsb + (size_t)(unsigned)(off32)), (LAS unsigned*)(lds + (ldsoff)), 16, 0, 0)
#define G8_STAGE_B(bufoff, ub) do { G8_GLDS((ub) + voffB[0], (bufoff) + ldsw); G8_GLDS((ub) + voffB[1], (bufoff) + ldsw + 8192); } while (0)
#define G8_STAGE_A(bufoff, ua, h, o0, o1) do { if (GATHER) { G8_GLDS((ua) + (o0), (bufoff) + ldsw); G8_GLDS((ua) + (o1), (bufoff) + ldsw + 8192); } \
        else { G8_GLDS((ua) + (unsigned)(h) * hstepA + voffA[0], (bufoff) + ldsw); G8_GLDS((ua) + (unsigned)(h) * hstepA + voffA[1], (bufoff) + ldsw + 8192); } } while (0)
#define G8_LDA(dst, b, h) do { _Pragma("unroll") for (int m = 0; m < 4; ++m) _Pragma("unroll") for (int k = 0; k < 2; ++k) dst[m][k] = *(const LAS bf16x8*)(lds + G8_SA(b, h) + aoff + m * 2048 + k * 1024); } while (0)
#define G8_LDB(dst, b, h) do { _Pragma("unroll") for (int n = 0; n < 2; ++n) _Pragma("unroll") for (int k = 0; k < 2; ++k) dst[n][k] = *(const LAS bf16x8*)(lds + G8_SB(b, h) + boff + n * 2048 + k * 1024); } while (0)
#define G8_MMA(ai, bj, At, Bt) do { __builtin_amdgcn_s_setprio(1); _Pragma("unroll") for (int m = 0; m < 4; ++m) _Pragma("unroll") for (int n = 0; n < 2; ++n) _Pragma("unroll") for (int k = 0; k < 2; ++k) \
        { if constexpr (Epi::I8) acc[ai][bj][m][n] = __builtin_bit_cast(f32x4, __builtin_amdgcn_mfma_i32_16x16x64_i8(__builtin_bit_cast(i32x4, Bt[n][k]), __builtin_bit_cast(i32x4, At[m][k]), __builtin_bit_cast(i32x4, acc[ai][bj][m][n]), 0, 0, 0)); \
          else acc[ai][bj][m][n] = __builtin_amdgcn_mfma_f32_16x16x32_bf16(Bt[n][k], At[m][k], acc[ai][bj][m][n], 0, 0, 0); } __builtin_amdgcn_s_setprio(0); } while (0)
#define G8_WAIT_V(n) asm volatile("s_waitcnt vmcnt(" #n ")" ::: "memory")
#define G8_WAIT_L(n) asm volatile("s_waitcnt lgkmcnt(" #n ")" ::: "memory")
#define G8_BAR __builtin_amdgcn_s_barrier()
#define G8_SCHED __builtin_amdgcn_sched_barrier(0)
#define G8_APTR(u, kt) (ZTILE ? (u).A + (unsigned)((kt) >> 2) * 65536u + (unsigned)((kt) & 3) * 128u : ((SPLIT && (kt) >= cfg.asplit) ? (u).A2 + (unsigned)((kt) - cfg.asplit) * kstepA : (u).A + (unsigned)(kt) * kstepA))
#define G8_GOFF(u, d00, d01, d10, d11) do { if (GATHER) { const LAS int* _t = tok_lds + (u).slot * 256; \
        d00 = (unsigned)_t[RA[0]] * (unsigned)cfg.lda + (unsigned)(CA[0] * 2); d01 = (unsigned)_t[RA[1]] * (unsigned)cfg.lda + (unsigned)(CA[1] * 2); \
        d10 = (unsigned)_t[128 + RA[0]] * (unsigned)cfg.lda + (unsigned)(CA[0] * 2); d11 = (unsigned)_t[128 + RA[1]] * (unsigned)cfg.lda + (unsigned)(CA[1] * 2); } } while (0)
    Unit cur, nxt; int ui = 0;
    if (!S.next(0, cur)) return;
    f32x4 acc[2][2][4][2];
#pragma unroll
    for (int a = 0; a < 2; ++a)
#pragma unroll
        for (int b = 0; b < 2; ++b)
#pragma unroll
            for (int m = 0; m < 4; ++m)
#pragma unroll
                for (int n = 0; n < 2; ++n) acc[a][b][m][n] = (f32x4){0.f, 0.f, 0.f, 0.f};
    bf16x8 At[4][2], B0[2][2], B1[2][2];
    S.a_ready(cur, wid, lane);
    G8_GOFF(cur, gc00, gc01, gc10, gc11);
    {
        const unsigned cA0 = G8_APTR(cur, 0), cA1 = G8_APTR(cur, 1), cB = cur.B;
        G8_STAGE_B(G8_SB(0, 0), cB); G8_STAGE_B(G8_SB(0, 1), cB + hstepB); G8_STAGE_A(G8_SA(0, 0), cA0, 0, gc00, gc01); G8_STAGE_A(G8_SA(0, 1), cA0, 1, gc10, gc11);
        if (wr == 1) G8_BAR;
        G8_WAIT_V(2); G8_BAR;
        G8_STAGE_B(G8_SB(1, 0), cB + kstepB); G8_STAGE_A(G8_SA(1, 0), cA1, 0, gc00, gc01); G8_STAGE_B(G8_SB(1, 1), cB + hstepB + kstepB);
        G8_WAIT_V(6); G8_BAR;
    }
#define G8_PSTAMP(k) do { if (pts && blockIdx.x == 0 && wid == 0 && lane == 0 && ui == 0) pts[k] = __builtin_amdgcn_s_memrealtime(); } while (0)
    for (;;) {
        G8_PSTAMP(0);
        const bool has_next = S.next(ui + 1, nxt);
        if (!has_next) nxt = cur;
#pragma unroll 1
        for (int t = 0; t < nt; t += 2) {
            const bool last = (t == nt - 2);
            const unsigned a1 = G8_APTR(cur, t + 1);
            const unsigned a2 = last ? G8_APTR(nxt, 0) : G8_APTR(cur, t + 2), b2 = last ? nxt.B : cur.B + (unsigned)(t + 2) * kstepB;
            const unsigned a3 = last ? G8_APTR(nxt, 1) : G8_APTR(cur, t + 3), b3 = b2 + kstepB;
            if (last && has_next) S.a_ready(nxt, wid, lane);
            if (GATHER && last) { if (has_next) { G8_GOFF(nxt, gn00, gn01, gn10, gn11); } else { gn00 = gc00; gn01 = gc01; gn10 = gc10; gn11 = gc11; } }
            const unsigned s00 = last ? gn00 : gc00, s01 = last ? gn01 : gc01, s10 = last ? gn10 : gc10, s11 = last ? gn11 : gc11;
            G8_LDB(B0, 0, 0); G8_LDB(B1, 0, 1); G8_SCHED; G8_LDA(At, 0, 0); G8_STAGE_A(G8_SA(1, 1), a1, 1, gc10, gc11);
            G8_WAIT_V(8); G8_WAIT_L(0); G8_BAR; G8_MMA(0, 0, At, B0); G8_MMA(0, 1, At, B1); G8_BAR; G8_SCHED;
            G8_LDA(At, 0, 1); G8_STAGE_B(G8_SB(0, 0), b2); G8_STAGE_B(G8_SB(0, 1), b2 + hstepB); G8_STAGE_A(G8_SA(0, 0), a2, 0, s00, s01);
            G8_WAIT_V(8); G8_WAIT_L(0); G8_BAR; G8_MMA(1, 0, At, B0); G8_MMA(1, 1, At, B1); G8_BAR; G8_SCHED;
            G8_LDB(B0, 1, 0); G8_LDB(B1, 1, 1); G8_SCHED; G8_LDA(At, 1, 0); G8_STAGE_A(G8_SA(0, 1), a2, 1, s10, s11);
            G8_WAIT_V(8); G8_WAIT_L(0); G8_BAR; G8_MMA(0, 0, At, B0); G8_MMA(0, 1, At, B1); G8_BAR; G8_SCHED;
            G8_LDA(At, 1, 1); G8_STAGE_B(G8_SB(1, 0), b3); G8_STAGE_B(G8_SB(1, 1), b3 + hstepB); G8_STAGE_A(G8_SA(1, 0), a3, 0, s00, s01);
            G8_WAIT_V(8); G8_WAIT_L(0); G8_BAR; G8_MMA(1, 0, At, B0); G8_MMA(1, 1, At, B1); G8_BAR; G8_SCHED;
        }
        G8_PSTAMP(1);
        if (Epi::ALIGN && wr == 0) G8_BAR;
        G8_PSTAMP(2);
        if constexpr (!Epi::AFTER_DRAIN) { int efr = fr, efq = fq; asm volatile("" : "+v"(efr), "+v"(efq));
            E(acc, cur, wr, wc, efr, efq); }
        G8_PSTAMP(3);
        if (!has_next) break;
#pragma unroll
        for (int a = 0; a < 2; ++a)
#pragma unroll
            for (int b = 0; b < 2; ++b)
#pragma unroll
                for (int m = 0; m < 4; ++m)
#pragma unroll
                    for (int n = 0; n < 2; ++n) acc[a][b][m][n] = (f32x4){0.f, 0.f, 0.f, 0.f};
        cur = nxt; ++ui; gc00 = gn00; gc01 = gn01; gc10 = gn10; gc11 = gn11;
        if (Epi::ALIGN && wr == 1) G8_BAR;
    }
    G8_WAIT_V(0);
    if (!Epi::ALIGN && wr == 0) G8_BAR;
    G8_BAR;
    if constexpr (Epi::AFTER_DRAIN) { E.fused(acc, cur, wr, wc, fr, fq, lds, wid, lane); }
#undef G8_SA
#undef G8_SB
#undef G8_GLDS
#undef G8_STAGE_A
#undef G8_STAGE_B
#undef G8_LDA
#undef G8_LDB
#undef G8_MMA
#undef G8_WAIT_V
#undef G8_WAIT_L
#undef G8_BAR
#undef G8_SCHED
#undef G8_APTR
#undef G8_GOFF
#undef G8_PSTAMP
}
}
#ifndef EPI_ALIGN_DEFAULT
#define EPI_ALIGN_DEFAULT true
#endif
namespace g8 {
typedef const f32x4 (&AccRef)[2][2][4][2];

struct EpiRowScale {
    static constexpr bool PERM = true, AFTER_DRAIN = false, ALIGN = EPI_ALIGN_DEFAULT, I8 = false;
    bf16_t* O; int ldc; const LAS float* rs_lds;
    __device__ __forceinline__ void operator()(AccRef acc, const Unit& u, int wr, int wc, int fr, int fq) const {
        const int r0 = wr * 64 + fr; const int col0 = u.pn * BM + wc * 32 + 8 * fq;
#pragma unroll
        for (int ai = 0; ai < 2; ++ai)
#pragma unroll
            for (int m = 0; m < 4; ++m) { const int r = r0 + ai * HALF + m * 16; const float s = rs_lds[u.slot * 256 + r];
                bf16_t* rowp = O + (size_t)(u.pm * BM + r) * ldc + col0;
#pragma unroll
                for (int bj = 0; bj < 2; ++bj) { const f32x4 v0 = acc[ai][bj][m][0] * s, v1 = acc[ai][bj][m][1] * s;
                    u32x4 w; w.x = cvt_pk_bf16(v0[0], v0[1]); w.y = cvt_pk_bf16(v0[2], v0[3]); w.z = cvt_pk_bf16(v1[0], v1[1]); w.w = cvt_pk_bf16(v1[2], v1[3]);
                    gst128(rowp + bj * HALF, w); } }
    }
};
struct EpiU {
    static constexpr bool PERM = true, AFTER_DRAIN = false, ALIGN = EPI_ALIGN_DEFAULT, I8 = false;
    bf16_t* U2; const LAS float* rs_lds;
    __device__ __forceinline__ void operator()(AccRef acc, const Unit& u, int wr, int wc, int fr, int fq) const {
        const int r0 = wr * 64 + fr; const int col0 = u.pn * BM + wc * 32 + 8 * fq;
#pragma unroll
        for (int ai = 0; ai < 2; ++ai)
#pragma unroll
            for (int m = 0; m < 4; ++m) { const int r = r0 + ai * HALF + m * 16; const float s = rs_lds[u.slot * 256 + r]; const size_t row = (size_t)(u.pm * BM + r);
#pragma unroll
                for (int bj = 0; bj < 2; ++bj) { const int col = col0 + bj * HALF; const f32x4 v0 = acc[ai][bj][m][0] * s, v1 = acc[ai][bj][m][1] * s;
                    u32x4 w; w.x = cvt_pk_bf16(v0[0], v0[1]); w.y = cvt_pk_bf16(v0[2], v0[3]); w.z = cvt_pk_bf16(v1[0], v1[1]); w.w = cvt_pk_bf16(v1[2], v1[3]);
                    gst128(U2 + ((size_t)(col >> 4) * T_TOK + row) * 16 + (col & 15), w); } }
    }
};
struct EpiGmIn {
    static constexpr bool PERM = true, AFTER_DRAIN = false, ALIGN = EPI_ALIGN_DEFAULT, I8 = true;
    bf16_t* O; const LAS float* rs_lds; float* part; const float* sw;
    __device__ __forceinline__ void operator()(AccRef acc, const Unit& u, int wr, int wc, int fr, int fq) const {
        const int r0 = wr * 64 + fr; const int col0 = wc * 32 + 8 * fq;
        f32x4 cs[2][2];
#pragma unroll
        for (int bj = 0; bj < 2; ++bj)
#pragma unroll
            for (int n = 0; n < 2; ++n) cs[bj][n] = gldf4(sw + u.pn * BM + bj * HALF + col0 + 4 * n);
#pragma unroll
        for (int ai = 0; ai < 2; ++ai)
#pragma unroll
            for (int m = 0; m < 4; ++m) { const int rr = r0 + m * 16; const int r = rr + ai * HALF; const float s = rs_lds[u.slot * 256 + r];
                bf16_t* rowp = O + ((size_t)((u.pm * 2 + ai) * 16 + u.pn) * 128 + rr) * 256 + col0; float q = 0.f;
#pragma unroll
                for (int bj = 0; bj < 2; ++bj) { const i32x4 i0 = __builtin_bit_cast(i32x4, acc[ai][bj][m][0]), i1 = __builtin_bit_cast(i32x4, acc[ai][bj][m][1]);
                    f32x4 v0, v1;
#pragma unroll
                    for (int j = 0; j < 4; ++j) { v0[j] = gelu_tanh((float)i0[j] * s * cs[bj][0][j]); v1[j] = gelu_tanh((float)i1[j] * s * cs[bj][1][j]); }
                    u32x4 w; w.x = cvt_pk_bf16(v0[0], v0[1]); w.y = cvt_pk_bf16(v0[2], v0[3]); w.z = cvt_pk_bf16(v1[0], v1[1]); w.w = cvt_pk_bf16(v1[2], v1[3]);
                    gst128(rowp + bj * HALF, w);
                    q += bflo(w.x) * bflo(w.x) + bfhi(w.x) * bfhi(w.x) + bflo(w.y) * bflo(w.y) + bfhi(w.y) * bfhi(w.y) + bflo(w.z) * bflo(w.z) + bfhi(w.z) * bfhi(w.z) + bflo(w.w) * bflo(w.w) + bfhi(w.w) * bfhi(w.w); }
                if (u.pn >= 8) { q += __shfl_xor(q, 16); q += __shfl_xor(q, 32);
                    if (fq == 0) gstf(part + ((size_t)(u.pm * BM + r) * 32 + (u.pn - 8) * 4 + wc), q); } }
    }
};
struct EpiKV {
    static constexpr bool PERM = true, AFTER_DRAIN = false, ALIGN = EPI_ALIGN_DEFAULT, I8 = false;
    bf16_t* O0; const float* rinv_mem;
    __device__ __forceinline__ void operator()(AccRef acc, const Unit& u, int wr, int wc, int fr, int fq) const {
        const int r0 = wr * 64 + fr; const int col0 = u.pn * BM + wc * 32 + 8 * fq; bf16_t* Ob = O0 + (size_t)u.aux * 2097152;
#pragma unroll
        for (int ai = 0; ai < 2; ++ai)
#pragma unroll
            for (int m = 0; m < 4; ++m) { const int row = u.pm * BM + r0 + ai * HALF + m * 16; const float s = gldf(rinv_mem + row);
                bf16_t* rowp = Ob + (size_t)row * 2048 + col0;
#pragma unroll
                for (int bj = 0; bj < 2; ++bj) { const f32x4 v0 = acc[ai][bj][m][0] * s, v1 = acc[ai][bj][m][1] * s;
                    u32x4 w; w.x = cvt_pk_bf16(v0[0], v0[1]); w.y = cvt_pk_bf16(v0[2], v0[3]); w.z = cvt_pk_bf16(v1[0], v1[1]); w.w = cvt_pk_bf16(v1[2], v1[3]);
                    gst128(rowp + bj * HALF, w); } }
    }
};
struct EpiGluRes {
    static constexpr bool PERM = true, AFTER_DRAIN = false, ALIGN = EPI_ALIGN_DEFAULT, I8 = false;
    bf16_t* X; float* part;
    __device__ __forceinline__ void operator()(AccRef acc, const Unit& u, int wr, int wc, int fr, int fq) const {
        const int r0 = wr * 64 + fr; const int col0 = u.pn * HALF + wc * 32 + 8 * fq;
        u32x4 xo[2][4];
#pragma unroll
        for (int ai = 0; ai < 2; ++ai)
#pragma unroll
            for (int m = 0; m < 4; ++m) xo[ai][m] = gld128(X + (size_t)(u.pm * BM + r0 + ai * HALF + m * 16) * 1024 + col0);
#pragma unroll
        for (int ai = 0; ai < 2; ++ai)
#pragma unroll
            for (int m = 0; m < 4; ++m) { const int row = u.pm * BM + r0 + ai * HALF + m * 16;
                bf16_t* xp = X + (size_t)row * 1024 + col0; const u32x4 xv = xo[ai][m];
                f32x4 v0 = acc[ai][0][m][0], v1 = acc[ai][0][m][1]; const f32x4 g0 = acc[ai][1][m][0], g1 = acc[ai][1][m][1];
#pragma unroll
                for (int j = 0; j < 4; ++j) { v0[j] *= sigmoid_f(g0[j]); v1[j] *= sigmoid_f(g1[j]); }
                u32x4 w; w.x = cvt_pk_bf16(v0[0] + bflo(xv.x), v0[1] + bfhi(xv.x)); w.y = cvt_pk_bf16(v0[2] + bflo(xv.y), v0[3] + bfhi(xv.y));
                w.z = cvt_pk_bf16(v1[0] + bflo(xv.z), v1[1] + bfhi(xv.z)); w.w = cvt_pk_bf16(v1[2] + bflo(xv.w), v1[3] + bfhi(xv.w));
                gst128(xp, w);
                float q = bflo(w.x) * bflo(w.x) + bfhi(w.x) * bfhi(w.x) + bflo(w.y) * bflo(w.y) + bfhi(w.y) * bfhi(w.y) + bflo(w.z) * bflo(w.z) + bfhi(w.z) * bfhi(w.z) + bflo(w.w) * bflo(w.w) + bfhi(w.w) * bfhi(w.w);
                q += __shfl_xor(q, 16); q += __shfl_xor(q, 32);
                if (fq == 0) gstf(part + ((size_t)row * 32 + u.pn * 4 + wc), q); }
    }
};
template <bool PART> struct EpiRes {
    static constexpr bool PERM = true, AFTER_DRAIN = false, ALIGN = EPI_ALIGN_DEFAULT, I8 = false;
    bf16_t* X; float* part;
    __device__ __forceinline__ void operator()(AccRef acc, const Unit& u, int wr, int wc, int fr, int fq) const {
        const int r0 = wr * 64 + fr; const int col0 = u.pn * BM + wc * 32 + 8 * fq;
        u32x4 xo[2][4][2];
#pragma unroll
        for (int ai = 0; ai < 2; ++ai)
#pragma unroll
            for (int m = 0; m < 4; ++m)
#pragma unroll
                for (int bj = 0; bj < 2; ++bj) xo[ai][m][bj] = gld128(X + (size_t)(u.pm * BM + r0 + ai * HALF + m * 16) * 1024 + col0 + bj * HALF);
#pragma unroll
        for (int ai = 0; ai < 2; ++ai)
#pragma unroll
            for (int m = 0; m < 4; ++m) { const int row = u.pm * BM + r0 + ai * HALF + m * 16; float q = 0.f;
#pragma unroll
                for (int bj = 0; bj < 2; ++bj) { bf16_t* xp = X + (size_t)row * 1024 + col0 + bj * HALF; const u32x4 xv = xo[ai][m][bj];
                    const f32x4 v0 = acc[ai][bj][m][0], v1 = acc[ai][bj][m][1];
                    u32x4 w; w.x = cvt_pk_bf16(v0[0] + bflo(xv.x), v0[1] + bfhi(xv.x)); w.y = cvt_pk_bf16(v0[2] + bflo(xv.y), v0[3] + bfhi(xv.y));
                    w.z = cvt_pk_bf16(v1[0] + bflo(xv.z), v1[1] + bfhi(xv.z)); w.w = cvt_pk_bf16(v1[2] + bflo(xv.w), v1[3] + bfhi(xv.w));
                    gst128(xp, w);
                    if (PART) q += bflo(w.x) * bflo(w.x) + bfhi(w.x) * bfhi(w.x) + bflo(w.y) * bflo(w.y) + bfhi(w.y) * bfhi(w.y) + bflo(w.z) * bflo(w.z) + bfhi(w.z) * bfhi(w.z) + bflo(w.w) * bflo(w.w) + bfhi(w.w) * bfhi(w.w); }
                if (PART) { q += __shfl_xor(q, 16); q += __shfl_xor(q, 32); if (fq == 0) gstf(part + ((size_t)row * 32 + u.pn * 4 + wc), q); } }
    }
};
struct EpiS5B {
    static constexpr bool PERM = true, AFTER_DRAIN = false, ALIGN = EPI_ALIGN_DEFAULT, I8 = false;
    bf16_t* Y;
    __device__ __forceinline__ void operator()(AccRef acc, const Unit& u, int wr, int wc, int fr, int fq) const {
        const int r0 = wr * 64 + fr; const int g = u.aux;
#pragma unroll
        for (int ai = 0; ai < 2; ++ai)
#pragma unroll
            for (int m = 0; m < 4; ++m) { const int blk = u.pm * BM + r0 + ai * HALF + m * 16;
#pragma unroll
                for (int bj = 0; bj < 2; ++bj) { const int c = bj * HALF + wc * 32 + 8 * fq; const int tl = c >> 4, ch = c & 15;
                    f32x4 v0 = acc[ai][bj][m][0], v1 = acc[ai][bj][m][1];
#pragma unroll
                    for (int j = 0; j < 4; ++j) { v0[j] = gelu_tanh(v0[j]); v1[j] = gelu_tanh(v1[j]); }
                    u32x4 w; w.x = cvt_pk_bf16(v0[0], v0[1]); w.y = cvt_pk_bf16(v0[2], v0[3]); w.z = cvt_pk_bf16(v1[0], v1[1]); w.w = cvt_pk_bf16(v1[2], v1[3]);
                    gst128(Y + ((size_t)g * T_TOK + (size_t)blk * 16 + tl) * 16 + ch, w); } }
    }
};
struct EpiSoftmax {
    static constexpr bool PERM = true, AFTER_DRAIN = false, ALIGN = true, I8 = false;
    bf16_t* P; const LAS float* rs_lds; LAS float* tab;
    __device__ __forceinline__ void operator()(AccRef acc_in, const Unit& u, int wr, int wc, int fr, int fq) const {
        LAS float* RM = tab;
        LAS float* RS = tab + 1024;
        const int r0 = wr * 64 + fr;
        float mx[2][4], sc[2][4];
#pragma unroll
        for (int ai = 0; ai < 2; ++ai)
#pragma unroll
            for (int m = 0; m < 4; ++m) { float v = -3.0e38f; const float s = rs_lds[u.slot * 256 + r0 + ai * HALF + m * 16] * 1.4426950408889634f; sc[ai][m] = s;
#pragma unroll
                for (int bj = 0; bj < 2; ++bj)
#pragma unroll
                    for (int n = 0; n < 2; ++n) { const f32x4 x = acc_in[ai][bj][m][n]; v = fmaxf(v, fmaxf(fmaxf(x[0], x[1]), fmaxf(x[2], x[3]))); }
                v = fmaxf(v, __shfl_xor(v, 16)); v = fmaxf(v, __shfl_xor(v, 32));
                if (fq == 0) RM[(r0 + ai * HALF + m * 16) * 4 + wc] = v; }
        asm volatile("s_waitcnt lgkmcnt(0)" ::: "memory"); __builtin_amdgcn_s_barrier(); asm volatile("" ::: "memory");
#pragma unroll
        for (int ai = 0; ai < 2; ++ai)
#pragma unroll
            for (int m = 0; m < 4; ++m) { const f32x4 t = *(const LAS f32x4*)(RM + (r0 + ai * HALF + m * 16) * 4); mx[ai][m] = fmaxf(fmaxf(t[0], t[1]), fmaxf(t[2], t[3])) * sc[ai][m]; }
#pragma unroll
        for (int ai = 0; ai < 2; ++ai)
#pragma unroll
            for (int m = 0; m < 4; ++m) { float s = 0.f; const float mm = mx[ai][m], ss = sc[ai][m];
#pragma unroll
                for (int bj = 0; bj < 2; ++bj)
#pragma unroll
                    for (int n = 0; n < 2; ++n) { const f32x4 x = acc_in[ai][bj][m][n];
#pragma unroll
                        for (int j = 0; j < 4; ++j) s += fast_exp2(x[j] * ss - mm); }
                s += __shfl_xor(s, 16); s += __shfl_xor(s, 32);
                if (fq == 0) RS[(r0 + ai * HALF + m * 16) * 4 + wc] = s; }
        asm volatile("s_waitcnt lgkmcnt(0)" ::: "memory"); __builtin_amdgcn_s_barrier(); asm volatile("" ::: "memory");
#pragma unroll
        for (int ai = 0; ai < 2; ++ai)
#pragma unroll
            for (int m = 0; m < 4; ++m) { const int r = r0 + ai * HALF + m * 16; const f32x4 t = *(const LAS f32x4*)(RS + r * 4); const float inv = 1.0f / ((t[0] + t[1]) + (t[2] + t[3])); const float mm = mx[ai][m], ss = sc[ai][m];
                bf16_t* rowp = P + (size_t)(u.pm * BM + r) * 1024 + u.pn * BM + wc * 32 + 8 * fq;
#pragma unroll
                for (int bj = 0; bj < 2; ++bj) { f32x4 v0 = acc_in[ai][bj][m][0], v1 = acc_in[ai][bj][m][1];
#pragma unroll
                    for (int j = 0; j < 4; ++j) { v0[j] = fast_exp2(v0[j] * ss - mm) * inv; v1[j] = fast_exp2(v1[j] * ss - mm) * inv; }
                    u32x4 w; w.x = cvt_pk_bf16(v0[0], v0[1]); w.y = cvt_pk_bf16(v0[2], v0[3]); w.z = cvt_pk_bf16(v1[0], v1[1]); w.w = cvt_pk_bf16(v1[2], v1[3]);
                    gst128(rowp + bj * HALF, w); } }
        asm volatile("s_waitcnt lgkmcnt(0)" ::: "memory"); __builtin_amdgcn_s_barrier(); asm volatile("" ::: "memory");
    }
};
struct EpiStore {
    static constexpr bool PERM = true, AFTER_DRAIN = false, ALIGN = EPI_ALIGN_DEFAULT, I8 = false;
    bf16_t* O; int ldc;
    __device__ __forceinline__ void operator()(AccRef acc, const Unit& u, int wr, int wc, int fr, int fq) const {
        const int r0 = wr * 64 + fr; const int col0 = u.pn * BM + wc * 32 + 8 * fq;
#pragma unroll
        for (int ai = 0; ai < 2; ++ai)
#pragma unroll
            for (int m = 0; m < 4; ++m) { bf16_t* rowp = O + (size_t)(u.pm * BM + r0 + ai * HALF + m * 16) * ldc + col0;
#pragma unroll
                for (int bj = 0; bj < 2; ++bj) { const f32x4 v0 = acc[ai][bj][m][0], v1 = acc[ai][bj][m][1];
                    u32x4 w; w.x = cvt_pk_bf16(v0[0], v0[1]); w.y = cvt_pk_bf16(v0[2], v0[3]); w.z = cvt_pk_bf16(v1[0], v1[1]); w.w = cvt_pk_bf16(v1[2], v1[3]);
                    gst128(rowp + bj * HALF, w); } }
    }
};
struct EpiMoeUp {
    static constexpr bool PERM = true, AFTER_DRAIN = false, ALIGN = EPI_ALIGN_DEFAULT, I8 = true;
    __amdgpu_buffer_rsrc_t hrs; const LAS float* rs_lds; const LAS float* wt_lds; unsigned* done; const float* sw;
    __device__ __forceinline__ void operator()(AccRef acc, const Unit& u, int wr, int wc, int fr, int fq) const {
        const int r0 = wr * 64 + fr; const int col0 = u.pn * HALF + wc * 32 + 8 * fq;
        const float* swe = sw + (u.aux & 255) * 1024 + u.pn * BM + wc * 32 + 8 * fq;
        const f32x4 sg0 = gldf4(swe), sg1 = gldf4(swe + 4), su0 = gldf4(swe + HALF), su1 = gldf4(swe + HALF + 4);
#pragma unroll
        for (int ai = 0; ai < 2; ++ai)
#pragma unroll
            for (int m = 0; m < 4; ++m) { const int r = r0 + ai * HALF + m * 16; const float s = rs_lds[u.slot * 256 + r], wt = wt_lds[u.slot * 256 + r];
                const i32x4 ga = __builtin_bit_cast(i32x4, acc[ai][0][m][0]), gb = __builtin_bit_cast(i32x4, acc[ai][0][m][1]), ua = __builtin_bit_cast(i32x4, acc[ai][1][m][0]), ub = __builtin_bit_cast(i32x4, acc[ai][1][m][1]);
                f32x4 a0, a1;
#pragma unroll
                for (int j = 0; j < 4; ++j) { const float x0 = (float)ga[j] * s * sg0[j], x1 = (float)gb[j] * s * sg1[j], y0 = (float)ua[j] * s * su0[j], y1 = (float)ub[j] * s * su1[j];
                    a0[j] = wt * x0 * sigmoid_f(x0) * y0; a1[j] = wt * x1 * sigmoid_f(x1) * y1; }
                u32x4 w; w.x = cvt_pk_bf16(a0[0], a0[1]); w.y = cvt_pk_bf16(a0[2], a0[3]); w.z = cvt_pk_bf16(a1[0], a1[1]); w.w = cvt_pk_bf16(a1[2], a1[3]);
                __builtin_amdgcn_raw_buffer_store_b128(w, hrs, (unsigned)((u.pm + r) * 1024 + col0 * 2), 0,   16); }
        asm volatile("s_waitcnt vmcnt(0)" ::: "memory");
        if (fr == 0 && fq == 0) __hip_atomic_fetch_add(done + (u.pm >> 8) * 64, 1u, __ATOMIC_RELAXED, __HIP_MEMORY_SCOPE_AGENT);
    }
};
struct EpiMoeDown {
    static constexpr bool PERM = true, AFTER_DRAIN = false, ALIGN = EPI_ALIGN_DEFAULT, I8 = false;
    bf16_t* YS; const LAS int* tokk_lds;
    __device__ __forceinline__ void operator()(AccRef acc, const Unit& u, int wr, int wc, int fr, int fq) const {
        const int r0 = wr * 64 + fr; const int col0 = u.pn * BM + wc * 32 + 8 * fq;
#pragma unroll
        for (int ai = 0; ai < 2; ++ai)
#pragma unroll
            for (int m = 0; m < 4; ++m) { const int r = r0 + ai * HALF + m * 16; const int tk = tokk_lds[u.slot * 256 + r];
                if (tk >= 0) { bf16_t* rowp = YS + (size_t)tk * 1024 + col0;
#pragma unroll
                    for (int bj = 0; bj < 2; ++bj) { const f32x4 v0 = acc[ai][bj][m][0], v1 = acc[ai][bj][m][1];
                        u32x4 w; w.x = cvt_pk_bf16(v0[0], v0[1]); w.y = cvt_pk_bf16(v0[2], v0[3]); w.z = cvt_pk_bf16(v1[0], v1[1]); w.w = cvt_pk_bf16(v1[2], v1[3]);
                        gst128(rowp + bj * HALF, w); } } }
    }
};
}
struct Args { const float* in[33]; float* out; unsigned char* ws; };
__device__ __forceinline__ const float* ARG(int k) { const __attribute__((address_space(4))) volatile unsigned long long* p = (const __attribute__((address_space(4))) volatile unsigned long long*)__builtin_amdgcn_kernarg_segment_ptr(); return (const float*)p[k]; }
struct ArgsV { unsigned char* ws; };
enum { I_X = 0, I_MEM, I_S5_NORM, I_S5_WIN, I_S5_LRE, I_S5_LIM, I_S5_LOGDT, I_S5_BRE, I_S5_BIM, I_S5_CRE, I_S5_CIM, I_S5_D, I_S5_WOUT,
       I_GM_NORM, I_GM_WIN, I_GM_VNORM, I_GM_WS, I_GM_BS, I_GM_WOUT, I_MEM_NORM, I_XA_NORM, I_XA_WQ, I_XA_WKV, I_XA_WO,
       I_MOE_NORM, I_MOE_WG, I_MOE_BG, I_MOE_WE, I_MOE_BE, I_MOE_WGATE, I_MOE_WUP, I_MOE_WDOWN, I_FINAL_NORM };

struct TItem { const float* W; const float* ksc; bf16_t* WT; int ldw, k0, n0, ldt, drow0; float cs; };
__device__ __forceinline__ void titem_load(const TItem& d, f32x4 (&v)[16], float (&sc)[16], int lane) {
    const int lr = lane >> 4, lc = (lane & 15) * 4;
#pragma unroll
    for (int i = 0; i < 16; ++i) v[i] = __builtin_nontemporal_load((const GAS f32x4*)(d.W + (size_t)(d.k0 + 4 * i + lr) * d.ldw + d.n0 + lc));
#pragma unroll
    for (int i = 0; i < 16; ++i) sc[i] = d.ksc ? gldf(d.ksc + d.k0 + 4 * i + lr) * d.cs : d.cs;
}
__device__ __forceinline__ void titem_store(const TItem& d, const f32x4 (&v)[16], const float (&sc)[16], LAS float* scr, int lane) {
    const int lr = lane >> 4, lc = (lane & 15) * 4;
#pragma unroll
    for (int i = 0; i < 16; ++i) { LAS float* p = scr + (4 * i + lr) * 65 + lc; p[0] = v[i][0] * sc[i]; p[1] = v[i][1] * sc[i]; p[2] = v[i][2] * sc[i]; p[3] = v[i][3] * sc[i]; }
    asm volatile("s_waitcnt lgkmcnt(0)" ::: "memory");
    const int c = lane & 7;
#pragma unroll
    for (int j = 0; j < 8; ++j) { const int n = (lane >> 3) + 8 * j; const LAS float* s = scr + (8 * c) * 65 + n;
        u32x4 o; o.x = cvt_pk_bf16(s[0 * 65], s[1 * 65]); o.y = cvt_pk_bf16(s[2 * 65], s[3 * 65]); o.z = cvt_pk_bf16(s[4 * 65], s[5 * 65]); o.w = cvt_pk_bf16(s[6 * 65], s[7 * 65]);
        gst128(d.WT + (size_t)(d.drow0 + n) * d.ldt + d.k0 + 8 * c, o); }
    asm volatile("s_waitcnt lgkmcnt(0)" ::: "memory");
}
__device__ __forceinline__ int glu_row(int j0, int part) { return (j0 >> 7) * 256 + part * 128 + (j0 & 127); }

__device__ __forceinline__ void p0_item(int r, int KB, int& kb, int& nb) { kb = r % KB; nb = r / KB; }
__device__ __forceinline__ bool p0_desc(unsigned char* ws, int L, TItem& d) {
    constexpr int N_DENSE = 4352;
    int kb, nb; d.ksc = nullptr; d.cs = 1.f;
    if (L < 256) { p0_item(L, 16, kb, nb);
        d.W = ARG(I_S5_WIN); d.ldw = 1024; d.ksc = ARG(I_S5_NORM); d.WT = (bf16_t*)(ws + WS_W_S5IN); d.ldt = 1024; d.drow0 = nb * 64;
    } else if (L < 768) { p0_item(L - 256, 16, kb, nb); const int n0 = nb * 64;
        d.W = ARG(I_S5_WOUT); d.ldw = 2048; d.WT = (bf16_t*)(ws + WS_W_S5OUT); d.ldt = 1024; d.drow0 = glu_row(n0 & 1023, n0 >> 10);
    } else if (L < 1792) { p0_item(L - 768, 16, kb, nb);
        d.W = ARG(I_GM_WIN); d.ldw = 4096; d.ksc = ARG(I_GM_NORM); d.WT = (bf16_t*)(ws + WS_W_GMIN); d.ldt = 1024; d.drow0 = nb * 64;
    } else if (L < 2304) { p0_item(L - 1792, 32, kb, nb);
        d.W = ARG(I_GM_WOUT); d.ldw = 1024; d.WT = (bf16_t*)(ws + WS_W_GMOUT_P); d.ldt = 2112; d.drow0 = nb * 64;
    } else if (L < 2816) { return false;
    } else if (L < 3840) { const int r = L - 2816, l = r / 512; p0_item(r % 512, 16, kb, nb); const int n0 = nb * 64;
        d.W = ARG(I_XA_WKV) + (size_t)l * 2097152; d.ldw = 2048; d.ksc = ARG(I_MEM_NORM); d.WT = (bf16_t*)(ws + WS_W_XA + l * 8 * MiB + (n0 < 1024 ? 2 : 4) * MiB); d.ldt = 1024; d.drow0 = n0 & 1023;
    } else if (L < N_DENSE) { const int r = L - 3840, l = r / 256; p0_item(r % 256, 16, kb, nb);
        d.W = ARG(I_XA_WO) + (size_t)l * 1048576; d.ldw = 1024; d.WT = (bf16_t*)(ws + WS_W_XA + l * 8 * MiB + 6 * MiB); d.ldt = 1024; d.drow0 = nb * 64;
    } else { const int r = L - N_DENSE; const int kind = r / 8192, q = r % 8192, mat = q / 128, it = q % 128, l = mat / 32, e = mat % 32;
        if (kind < 2) { p0_item(it, 16, kb, nb);
            d.W = ARG(kind == 0 ? I_MOE_WGATE : I_MOE_WUP) + (size_t)mat * 524288; d.ldw = 512; d.ksc = ARG(I_MOE_NORM) + l * 1024;
            d.WT = (bf16_t*)(ws + WS_W_MOE + l * MOE_L_STRIDE) + (size_t)e * 1048576; d.ldt = 1024; d.drow0 = glu_row(nb * 64, kind);
        } else { p0_item(it, 8, kb, nb);
            d.W = ARG(I_MOE_WDOWN) + (size_t)mat * 524288; d.ldw = 1024; d.WT = (bf16_t*)(ws + WS_W_MOE + l * MOE_L_STRIDE + MOE_D_OFF) + (size_t)e * 524288; d.ldt = 512; d.drow0 = nb * 64; } }
    d.k0 = kb * 64; d.n0 = nb * 64; return true;
}
__device__ __forceinline__ void p0_weights(const ArgsV& a, LAS unsigned char* lds, int part, int j0, int j1, int gw, int NGW, int wave, int lane) {
    LAS float* scr = (LAS float*)(lds + wave * 16640);
    unsigned char* ws = a.ws;
    constexpr int TOTAL = 4352 + 24576;
    const int NJ = part == 0 ? 1280 : 3072 + 8192; if (j1 > NJ) j1 = NJ; (void)TOTAL;
#define P0_L(j_) (part == 0 ? ((j_) < 256 ? (j_) : (j_) - 256 + 2816) : ((j_) < 2560 ? (j_) + 256 : ((j_) < 3072 ? (j_) - 2560 + 3840 : (j_) - 3072 + 20736)))
    TItem cur, nxt; f32x4 va[16], vb[16]; float sa[16], sb[16];
    int j = j0 + gw; bool have = false;
    while (j < j1 && !(have = p0_desc(ws, P0_L(j), cur))) j += NGW;
    if (have) titem_load(cur, va, sa, lane);
    while (have) {
        int jn = j + NGW; bool hn = false;
        while (jn < j1 && !(hn = p0_desc(ws, P0_L(jn), nxt))) jn += NGW;
        if (hn) titem_load(nxt, vb, sb, lane);
        titem_store(cur, va, sa, scr, lane);
        if (hn) {
#pragma unroll
            for (int i = 0; i < 16; ++i) { va[i] = vb[i]; sa[i] = sb[i]; }
            cur = nxt; }
        have = hn; j = jn;
    }
#undef P0_L
}
__device__ __forceinline__ void p0_moe_gu_jobs(const ArgsV& a, LAS unsigned char* lds, int gw, int NGW, int wave, int lane) {
    LAS float* scr = (LAS float*)(lds + wave * 16640);
    unsigned char* ws = a.ws; float* swm = (float*)(ws + WS_SMALL + SM_MOESW);
    for (int J = gw; J < 1024; J += NGW) {
        const int kind = J >> 9, mat = (J >> 3) & 63, nb = J & 7, l = mat >> 5, e = mat & 31;
        TItem d; d.W = ARG(kind == 0 ? I_MOE_WGATE : I_MOE_WUP) + (size_t)mat * 524288; d.ldw = 512; d.ksc = ARG(I_MOE_NORM) + l * 1024; d.cs = 1.f;
        d.WT = (bf16_t*)(ws + WS_W_MOE + l * MOE_L_STRIDE) + (size_t)e * 1048576; d.ldt = 1024; d.drow0 = glu_row(nb * 64, kind); d.n0 = nb * 64; d.k0 = 0;
        f32x4 va[16], vb[16]; float rmax[8];
#pragma unroll
        for (int j = 0; j < 8; ++j) rmax[j] = 0.f;
        { const int lr = lane >> 4, lc = (lane & 15) * 4;
#pragma unroll
          for (int i = 0; i < 16; ++i) va[i] = __builtin_nontemporal_load((const GAS f32x4*)(d.W + (size_t)(4 * i + lr) * d.ldw + d.n0 + lc)); }
#pragma unroll 1
        for (int kb = 0; kb < 16; ++kb) {
            d.k0 = kb * 64;
            if (kb < 15) { const int lr = lane >> 4, lc = (lane & 15) * 4;
#pragma unroll
                for (int i = 0; i < 16; ++i) vb[i] = __builtin_nontemporal_load((const GAS f32x4*)(d.W + (size_t)(d.k0 + 64 + 4 * i + lr) * d.ldw + d.n0 + lc)); }
            const f32x4 kv0 = gldf4(d.ksc + d.k0 + 8 * (lane & 7)), kv1 = gldf4(d.ksc + d.k0 + 8 * (lane & 7) + 4);
            {
                const int lr = lane >> 4, lc = (lane & 15) * 4;
#pragma unroll
                for (int i = 0; i < 16; ++i) { LAS float* p = scr + (4 * i + lr) * 65 + lc; p[0] = va[i][0]; p[1] = va[i][1]; p[2] = va[i][2]; p[3] = va[i][3]; }
                asm volatile("s_waitcnt lgkmcnt(0)" ::: "memory");
                const int c = lane & 7;
#pragma unroll
                for (int j = 0; j < 8; ++j) { const int n = (lane >> 3) + 8 * j; const LAS float* s = scr + (8 * c) * 65 + n;
                    u32x4 o; o.x = cvt_pk_bf16(s[0 * 65] * kv0[0], s[1 * 65] * kv0[1]); o.y = cvt_pk_bf16(s[2 * 65] * kv0[2], s[3 * 65] * kv0[3]); o.z = cvt_pk_bf16(s[4 * 65] * kv1[0], s[5 * 65] * kv1[1]); o.w = cvt_pk_bf16(s[6 * 65] * kv1[2], s[7 * 65] * kv1[3]);
                    gst128(d.WT + (size_t)(d.drow0 + n) * d.ldt + d.k0 + 8 * c, o);
                    rmax[j] = fmaxf(rmax[j], fmaxf(fmaxf(fmaxf(fabsf(bflo(o.x)), fabsf(bfhi(o.x))), fmaxf(fabsf(bflo(o.y)), fabsf(bfhi(o.y)))), fmaxf(fmaxf(fabsf(bflo(o.z)), fabsf(bfhi(o.z))), fmaxf(fabsf(bflo(o.w)), fabsf(bfhi(o.w)))))); }
                asm volatile("s_waitcnt lgkmcnt(0)" ::: "memory"); }
            if (kb < 15) {
#pragma unroll
                for (int i = 0; i < 16; ++i) va[i] = vb[i]; }
        }
#pragma unroll
        for (int j = 0; j < 8; ++j) { float m = rmax[j]; m = fmaxf(m, __shfl_xor(m, 1)); m = fmaxf(m, __shfl_xor(m, 2)); m = fmaxf(m, __shfl_xor(m, 4)); rmax[j] = fmaxf(m, 1e-30f); }
        asm volatile("s_waitcnt vmcnt(0)" ::: "memory");
#pragma unroll
        for (int j = 0; j < 8; ++j) {
            u32x4 w0[8], w1[8];
#pragma unroll
            for (int q = 0; q < 8; ++q) { const bf16_t* rowp = d.WT + (size_t)(d.drow0 + q + 8 * j) * 1024; w0[q] = gld128(rowp + lane * 16); w1[q] = gld128(rowp + lane * 16 + 8); }
#pragma unroll
            for (int q = 0; q < 8; ++q) { const int rr = q + 8 * j; const float am = __shfl(rmax[j], q * 8); const float qs = 127.0f / am;
                bf16_t* rowp = d.WT + (size_t)(d.drow0 + rr) * 1024; const u32x4 a0 = w0[q], a1 = w1[q];
                u32x4 o;
                { const int q0 = (int)rintf(bflo(a0.x) * qs), q1 = (int)rintf(bfhi(a0.x) * qs), q2 = (int)rintf(bflo(a0.y) * qs), q3 = (int)rintf(bfhi(a0.y) * qs);
                  const int q4 = (int)rintf(bflo(a0.z) * qs), q5 = (int)rintf(bfhi(a0.z) * qs), q6 = (int)rintf(bflo(a0.w) * qs), q7 = (int)rintf(bfhi(a0.w) * qs);
                  o.x = (unsigned)(q0 & 255) | ((unsigned)(q1 & 255) << 8) | ((unsigned)(q2 & 255) << 16) | ((unsigned)(q3 & 255) << 24);
                  o.y = (unsigned)(q4 & 255) | ((unsigned)(q5 & 255) << 8) | ((unsigned)(q6 & 255) << 16) | ((unsigned)(q7 & 255) << 24); }
                { const int q0 = (int)rintf(bflo(a1.x) * qs), q1 = (int)rintf(bfhi(a1.x) * qs), q2 = (int)rintf(bflo(a1.y) * qs), q3 = (int)rintf(bfhi(a1.y) * qs);
                  const int q4 = (int)rintf(bflo(a1.z) * qs), q5 = (int)rintf(bfhi(a1.z) * qs), q6 = (int)rintf(bflo(a1.w) * qs), q7 = (int)rintf(bfhi(a1.w) * qs);
                  o.z = (unsigned)(q0 & 255) | ((unsigned)(q1 & 255) << 8) | ((unsigned)(q2 & 255) << 16) | ((unsigned)(q3 & 255) << 24);
                  o.w = (unsigned)(q4 & 255) | ((unsigned)(q5 & 255) << 8) | ((unsigned)(q6 & 255) << 16) | ((unsigned)(q7 & 255) << 24); }
                gst128((unsigned char*)rowp + lane * 16, o);
                if (lane == 0) gstf(swm + (size_t)mat * 1024 + d.drow0 + rr, am * (1.0f / 127.0f)); } }
    }
}
template <int NR>
__device__ __forceinline__ void rows_to_bf16(const float* xsrc, bf16_t* dst, float* rinv, int m0, int stride, int mmax, int lane) {
    f32x4 v[NR][4];
#pragma unroll
    for (int i = 0; i < NR; ++i) { const int m = m0 + i * stride; if (m < mmax) { const GAS f32x4* xr = (const GAS f32x4*)(xsrc + (size_t)m * 1024) + lane;
#pragma unroll
        for (int j = 0; j < 4; ++j) v[i][j] = __builtin_nontemporal_load(xr + 64 * j); } }
#pragma unroll
    for (int i = 0; i < NR; ++i) { const int m = m0 + i * stride; if (m < mmax) { float s = 0.f; GAS u32x2* o8 = (GAS u32x2*)(dst + (size_t)m * 1024) + lane;
#pragma unroll
        for (int j = 0; j < 4; ++j) { u32x2 w; w.x = cvt_pk_bf16(v[i][j][0], v[i][j][1]); w.y = cvt_pk_bf16(v[i][j][2], v[i][j][3]); o8[64 * j] = w;
            s += bflo(w.x) * bflo(w.x) + bfhi(w.x) * bfhi(w.x) + bflo(w.y) * bflo(w.y) + bfhi(w.y) * bfhi(w.y); }
        const float r = 1.0f / sqrtf(wave_sum(s) * (1.0f / 1024.0f) + RMS_EPS); if (lane == 0) gstf(rinv + m, r); } }
}
__device__ __forceinline__ void p0_rows(const ArgsV& a, int gw, int NGW, int lane) {
    unsigned char* ws = a.ws; bf16_t* X = (bf16_t*)(ws + WS_X); float* rinvA = (float*)(ws + WS_SMALL + SM_RINVA);
    { const float* xs = ARG(I_X); for (int m = gw; m < T_TOK; m += 8 * NGW) rows_to_bf16<8>(xs, X, rinvA, m, NGW, T_TOK, lane); }
    if (gw == 0) { u32x4* z = (u32x4*)(X + (size_t)T_TOK * 1024); z[lane] = (u32x4){0u, 0u, 0u, 0u}; z[lane + 64] = (u32x4){0u, 0u, 0u, 0u}; }
    bf16_t* MB = (bf16_t*)(ws + WS_MEMBF); float* rinvM = (float*)(ws + WS_SMALL + SM_RINVMEM);
    { const float* ms = ARG(I_MEM); for (int m = gw; m < MEMR; m += NGW) rows_to_bf16<1>(ms, MB, rinvM, m, NGW, MEMR, lane); }
    { const float* wq = ARG(I_XA_WQ); const float* xn = ARG(I_XA_NORM); bf16_t* base = (bf16_t*)(ws + WS_W_XA);
      for (int m = gw; m < 2048; m += NGW) { const int l = m >> 10, kin = m & 1023; const float sc = xn[m] * 0.0625f;
          const GAS f32x4* xr = (const GAS f32x4*)(wq + (size_t)m * 1024) + lane; GAS u32x2* o8 = (GAS u32x2*)(base + (size_t)l * 4 * MiB + (size_t)kin * 1024) + lane;
#pragma unroll
          for (int j = 0; j < 4; ++j) { const f32x4 v = xr[64 * j]; u32x2 w; w.x = cvt_pk_bf16(v[0] * sc, v[1] * sc); w.y = cvt_pk_bf16(v[2] * sc, v[3] * sc); o8[64 * j] = w; } } }
    { const float* wsp = ARG(I_GM_WS); bf16_t* WSB = (bf16_t*)(ws + WS_SMALL + SM_WSB);
      for (int i = gw * 64 + lane; i < 8 * 128 * 128; i += NGW * 64) { const int g = i >> 14, r = (i >> 7) & 127, cp = i & 127, qp = cp >> 3, e = cp & 7; const int cs = ((qp ^ (r & 15)) << 3) + e;
          const float v = ((r < 64) && (cs >= 64)) ? 0.f : wsp[(size_t)g * 16384 + r * 128 + cs];
          WSB[i] = (bf16_t)f2bf(v); } }
    bf16_t* RT = (bf16_t*)(ws + WS_W_RT);
    { const float* wgp = ARG(I_MOE_WG); const float* wep = ARG(I_MOE_WE); const float* mn = ARG(I_MOE_NORM);
      for (int i = gw * 64 + lane; i < 2 * 49152; i += NGW * 64) { const int l = i / 49152, r = i % 49152, e = r & 7, ln = (r >> 3) & 63, j = (r >> 9) % 3, ks = r / 1536;
        const int n = j * 16 + (ln & 15), k = ks * 32 + (ln >> 4) * 8 + e;
        float v = 0.f;
        if (n < 4) v = wgp[(size_t)l * 4096 + k * 4 + n]; else if (n < 36) v = wep[(size_t)l * 32768 + k * 32 + (n - 4)];
        v *= mn[l * 1024 + k];
        RT[(size_t)l * 49152 + r] = (bf16_t)f2bf(v); } }
}
__device__ __forceinline__ void p0_s5_tables(const ArgsV& a, LAS unsigned char* lds, int g, int tid) {
    constexpr int CS = 65;
    LAS float* ABR = (LAS float*)lds;
    LAS float* ABI = ABR + 17 * 64;
    LAS float* CR = ABI + 17 * 64;
    LAS float* CI = CR + 16 * CS;
    LAS float* BR = CI + 16 * CS;
    LAS float* BI = BR + 1024;
    LAS float* KN = BI + 1024;
    __syncthreads();
    { const float dt = expf(ARG(I_S5_LOGDT)[g]);
      for (int i = tid; i < 17 * 64; i += NTHR) { const int lag = i >> 6, p = i & 63; const float lr = ARG(I_S5_LRE)[g * 64 + p], li = ARG(I_S5_LIM)[g * 64 + p];
          const float mag = expf(lr * dt * (float)lag); float sn, cs; sincosf(li * dt * (float)lag, &sn, &cs); ABR[i] = mag * cs; ABI[i] = mag * sn; }
      for (int i = tid; i < 1024; i += NTHR) { const int n = i >> 6, p = i & 63; CR[n * CS + p] = ARG(I_S5_CRE)[(size_t)g * 1024 + i]; CI[n * CS + p] = ARG(I_S5_CIM)[(size_t)g * 1024 + i]; }
      __syncthreads();
      for (int i = tid; i < 1024; i += NTHR) { const int p = i >> 4; const float lr = ARG(I_S5_LRE)[g * 64 + p], li = ARG(I_S5_LIM)[g * 64 + p];
          const float ar = ABR[64 + p], ai = ABI[64 + p], den = lr * lr + li * li;
          const float cre = ((ar - 1.0f) * lr + ai * li) / den, cim = (ai * lr - (ar - 1.0f) * li) / den;
          const float br = ARG(I_S5_BRE)[(size_t)g * 1024 + i], bi = ARG(I_S5_BIM)[(size_t)g * 1024 + i];
          BR[i] = cre * br - cim * bi; BI[i] = cre * bi + cim * br; } }
    __syncthreads();
    {
        const int n = (tid >> 4) & 15, np = tid & 15, l0 = tid >> 8;
        float k0 = 0.f, k1 = 0.f, k2 = 0.f, k3 = 0.f, k4 = 0.f, k5 = 0.f, k6 = 0.f, k7 = 0.f;
        for (int p = 0; p < 64; ++p) { const float cr = CR[n * CS + p], ci = CI[n * CS + p], br = BR[p * 16 + np], bi = BI[p * 16 + np];
            const float xr = cr * br - ci * bi, xi = cr * bi + ci * br; const LAS float* pr = ABR + l0 * 64 + p; const LAS float* pi = ABI + l0 * 64 + p;
            k0 += xr * pr[0 * 128] - xi * pi[0 * 128]; k1 += xr * pr[1 * 128] - xi * pi[1 * 128]; k2 += xr * pr[2 * 128] - xi * pi[2 * 128]; k3 += xr * pr[3 * 128] - xi * pi[3 * 128];
            k4 += xr * pr[4 * 128] - xi * pi[4 * 128]; k5 += xr * pr[5 * 128] - xi * pi[5 * 128]; k6 += xr * pr[6 * 128] - xi * pi[6 * 128]; k7 += xr * pr[7 * 128] - xi * pi[7 * 128]; }
        LAS float* ko = KN + (l0 * 16 + n) * 16 + np;
        ko[0 * 512] = k0; ko[1 * 512] = k1; ko[2 * 512] = k2; ko[3 * 512] = k3; ko[4 * 512] = k4; ko[5 * 512] = k5; ko[6 * 512] = k6; ko[7 * 512] = k7; }
    __syncthreads();
    bf16_t* AF = (bf16_t*)(a.ws + WS_SCR + SC_S5A) + (size_t)g * 256 * 384;
    const float* dsk = ARG(I_S5_D);
    for (int e = tid; e < 256 * 48; e += NTHR) { const int r = e / 48, k = (e % 48) * 8, tl = r >> 4, n = r & 15; float v[8];
        if (k < 256) { const int s = k >> 4, np0 = k & 15;
#pragma unroll
            for (int i = 0; i < 8; ++i) { float t = 0.f; if (s <= tl) { t = KN[((tl - s) * 16 + n) * 16 + np0 + i]; if (s == tl && np0 + i == n) t += dsk[g * 16 + n]; } v[i] = t; }
        } else { const int ci0 = k - 256, p0 = ci0 & 63;
#pragma unroll
            for (int i = 0; i < 8; ++i) { const int p = p0 + i; const float ar = ABR[(tl + 1) * 64 + p], ai = ABI[(tl + 1) * 64 + p], cr = CR[n * CS + p], cim = CI[n * CS + p];
                v[i] = (ci0 < 64) ? (cr * ar - cim * ai) : -(cr * ai + cim * ar); } }
        u32x4 o; o.x = cvt_pk_bf16(v[0], v[1]); o.y = cvt_pk_bf16(v[2], v[3]); o.z = cvt_pk_bf16(v[4], v[5]); o.w = cvt_pk_bf16(v[6], v[7]);
        gst128(AF + (size_t)r * 384 + k, o); }
    bf16_t* MS = (bf16_t*)(a.ws + WS_SCR + SC_S5M) + (size_t)g * 128 * 256;
    for (int e = tid; e < 128 * 32; e += NTHR) { const int pp = e >> 5, k = (e & 31) * 8, s = k >> 4, np0 = k & 15, p = pp & 63; float v[8];
        const float ar = ABR[(15 - s) * 64 + p], ai = ABI[(15 - s) * 64 + p];
#pragma unroll
        for (int i = 0; i < 8; ++i) { const float br = BR[p * 16 + np0 + i], bi = BI[p * 16 + np0 + i]; v[i] = (pp < 64) ? (ar * br - ai * bi) : (ar * bi + ai * br); }
        u32x4 o; o.x = cvt_pk_bf16(v[0], v[1]); o.y = cvt_pk_bf16(v[2], v[3]); o.z = cvt_pk_bf16(v[4], v[5]); o.w = cvt_pk_bf16(v[6], v[7]);
        gst128(MS + (size_t)pp * 256 + k, o); }
    if (tid < 64) { float* AB = (float*)(a.ws + WS_SMALL + SM_AB16) + (size_t)(g * 64 + tid) * 2; AB[0] = ABR[16 * 64 + tid]; AB[1] = ABI[16 * 64 + tid]; }
}

template <class Sched>
__device__ __forceinline__ void fill_rs(const Sched& S, LAS float* rs_lds, const float* direct, const float* part, int nslots, int tid) {
    g8::Unit u;
    for (int i = 0; i < 8 && S.next(i, u); ++i) {
        if (tid < 256) { const int row = u.pm * 256 + tid; float v;
            if (direct) v = direct[row];
            else { float s = 0.f; const f32x4* p = (const f32x4*)(part + (size_t)row * 32); for (int j = 0; j < nslots / 4; ++j) { const f32x4 t = p[j]; s += (t[0] + t[1]) + (t[2] + t[3]); } v = 1.0f / sqrtf(s * (1.0f / 1024.0f) + RMS_EPS); }
            rs_lds[i * 256 + tid] = v; }
    }
    __syncthreads();
}

struct S5Sched {
    int b, g;
    __device__ __forceinline__ bool next(int i, g8::Unit& u) const { if (i >= 2) return false;
        const int bt = b * 2 + i;
        const unsigned off = (unsigned)g * 1048576u + (unsigned)bt * (256u * 512u);
        u.A = (unsigned)(WS_SCR + SC_U) + off; u.A2 = (unsigned)(WS_SCR + SC_H2) + off; u.B = (unsigned)(WS_SCR + SC_S5A) + (unsigned)g * (256u * 768u); u.pm = bt; u.pn = 0; u.slot = i; u.aux = g; return true; }
    __device__ __forceinline__ void a_ready(const g8::Unit&, int, int) const {}
};
__device__ __forceinline__ void s5_scan_pair(const ArgsV& a, LAS unsigned char* lds, int b, int g, int tid, int wave, int lane, unsigned long long* pts = nullptr) {
#define S5_PST(k) do { if (pts && blockIdx.x == 0 && tid == 0) pts[k] = __builtin_amdgcn_s_memrealtime(); } while (0)
    S5_PST(0);
    unsigned char* ws = a.ws;
    const bf16_t* U = (const bf16_t*)(ws + WS_SCR + SC_U); bf16_t* H2 = (bf16_t*)(ws + WS_SCR + SC_H2);
    const bf16_t* MS = (const bf16_t*)(ws + WS_SCR + SC_S5M) + (size_t)g * 128 * 256;
    LAS unsigned char* UL = lds; LAS float* SL = (LAS float*)(lds + 67584); LAS float* LC = (LAS float*)(lds + 133120); LAS float* CC = LC + 1024;
    const int fr = lane & 15, fq = lane >> 4;
    bf16x8 mf[8];
#pragma unroll
    for (int ks = 0; ks < 8; ++ks) mf[ks] = *(const GAS bf16x8*)(MS + (size_t)(wave * 16 + fr) * 256 + ks * 32 + fq * 8);
    const int p = tid & 63, chk = tid >> 6;
    float a1r, a1i; { const float* AB = (const float*)(ws + WS_SMALL + SM_AB16) + (size_t)(g * 64 + p) * 2; a1r = AB[0]; a1i = AB[1]; }
    float a16r = a1r, a16i = a1i;
#pragma unroll
    for (int i = 0; i < 4; ++i) { const float r = a16r * a16r - a16i * a16i, im = 2.f * a16r * a16i; a16r = r; a16i = im; }
    float hr = 0.f, hi = 0.f;
    u32x4 pre[8];
#define S5_LOADQ(qt_) do { _Pragma("unroll") for (int i = 0; i < 8; ++i) { const int idx = tid + i * NTHR, t = idx >> 1, hf = idx & 1; \
        pre[i] = gld128(U + ((size_t)g * T_TOK + (size_t)(b * 512 + (qt_) * 128) * 16) * 16 + (size_t)idx * 8); (void)t; (void)hf; } } while (0)
    S5_LOADQ(0);
    for (int qt = 0; qt < 4; ++qt) {
        __syncthreads();
#pragma unroll
        for (int i = 0; i < 8; ++i) { const int idx = tid + i * NTHR, t = idx >> 1, hf = idx & 1; *(LAS u32x4*)(UL + (t >> 4) * 528 + (t & 15) * 32 + hf * 16) = pre[i]; }
        __syncthreads();
        if (qt < 3) S5_LOADQ(qt + 1);
#pragma unroll 1
        for (int bt = 0; bt < 8; ++bt) { f32x4 acc = (f32x4){0.f, 0.f, 0.f, 0.f};
#pragma unroll
            for (int ks = 0; ks < 8; ++ks) { const bf16x8 yb = *(const LAS bf16x8*)(UL + (bt * 16 + fr) * 528 + (2 * ks + (fq >> 1)) * 32 + (fq & 1) * 16);
                acc = __builtin_amdgcn_mfma_f32_16x16x32_bf16(mf[ks], yb, acc, 0, 0, 0); }
            *(LAS f32x4*)(SL + (bt * 16 + fr) * 128 + wave * 16 + fq * 4) = acc; }
        __syncthreads();
        { float lr = 0.f, li = 0.f;
#pragma unroll 4
          for (int j = 0; j < 16; ++j) { const float sr = SL[(chk * 16 + j) * 128 + p], si = SL[(chk * 16 + j) * 128 + 64 + p];
              const float nr = a1r * lr - a1i * li + sr, ni = a1r * li + a1i * lr + si; lr = nr; li = ni; }
          LC[(chk * 64 + p) * 2] = lr; LC[(chk * 64 + p) * 2 + 1] = li; }
        __syncthreads();
        if (tid < 64) {
#pragma unroll
            for (int cI = 0; cI < 8; ++cI) { CC[(cI * 64 + p) * 2] = hr; CC[(cI * 64 + p) * 2 + 1] = hi;
                const float lr = LC[(cI * 64 + p) * 2], li = LC[(cI * 64 + p) * 2 + 1];
                const float nr = a16r * hr - a16i * hi + lr, ni = a16r * hi + a16i * hr + li; hr = nr; hi = ni; } }
        __syncthreads();
        { float cr = CC[(chk * 64 + p) * 2], ci = CC[(chk * 64 + p) * 2 + 1];
#pragma unroll 4
          for (int j = 0; j < 16; ++j) { const int blk = b * 512 + qt * 128 + chk * 16 + j;
              GAS bf16_t* hrow = (GAS bf16_t*)(H2 + ((size_t)g * 2048 + blk) * 256);
              hrow[p] = (bf16_t)f2bf(cr); hrow[64 + p] = (bf16_t)f2bf(ci);
              const float sr = SL[(chk * 16 + j) * 128 + p], si = SL[(chk * 16 + j) * 128 + 64 + p];
              const float nr = a1r * cr - a1i * ci + sr, ni = a1r * ci + a1i * cr + si; cr = nr; ci = ni; } }
    }
#undef S5_LOADQ
    asm volatile("s_waitcnt vmcnt(0)" ::: "memory");
    __syncthreads();
    S5_PST(1);
    S5Sched S{b, g};
    g8::EpiS5B E{(bf16_t*)(ws + WS_SCR + SC_Y)};
    g8::gemm_phase<g8::EpiS5B, S5Sched, 8, 512, 768, 128, 128, 6, 4>(lds, (const char*)ws, S, E, nullptr, tid);
    S5_PST(2);
#undef S5_PST
}

struct PrepSched {
    unsigned A, B; int pm, pn;
    __device__ __forceinline__ bool next(int i, g8::Unit& u) const { if (i) return false; u.A = A; u.A2 = A; u.B = B; u.pm = pm; u.pn = pn; u.slot = 0; u.aux = 0; return true; }
    __device__ __forceinline__ void a_ready(const g8::Unit&, int, int) const {}
};
__device__ __forceinline__ void prep_phase(const ArgsV& a, LAS unsigned char* lds, int layer, int c, int tid) {
    unsigned char* ws = a.ws; const int x = c & 7, r = c >> 3, b = x >> 1, h = (r >> 2) & 3, t = r & 3;
    const unsigned KV = (unsigned)WS_KV + (unsigned)layer * (unsigned)(4 * MiB) + (unsigned)b * (256u * 4096u) + (unsigned)h * 512u;
    const unsigned WX = (unsigned)WS_W_XA + (unsigned)layer * (unsigned)(8 * MiB);
    bf16_t* GX = (bf16_t*)(ws + (layer == 0 ? WS_SCR + SC_G0 : WS_G1) + (size_t)x * 4 * MiB);
    if (r < 16) { PrepSched S{KV, WX + (unsigned)t * (256u * 2048u) + (unsigned)h * 512u, h, t};
        g8::EpiStore E{GX, 1024};
        g8::gemm_phase<g8::EpiStore, PrepSched, 0, 4096, 2048, 128, 128, 4, 4>(lds, (const char*)ws, S, E, nullptr, tid); }
    else { PrepSched S{WX + (unsigned)(6 * MiB) + (unsigned)t * (256u * 2048u) + (unsigned)h * 512u, KV + 2048u, t, h};
        g8::EpiStore E{GX + 1048576, 1024};
        g8::gemm_phase<g8::EpiStore, PrepSched, 0, 2048, 4096, 128, 128, 4, 4>(lds, (const char*)ws, S, E, nullptr, tid); }
}

__device__ __forceinline__ void router_phase(const ArgsV& a, LAS unsigned char* lds, int layer, int G, int c, int tid, int wave, int lane) {
    unsigned char* ws = a.ws;
    const bf16_t* X = (const bf16_t*)(ws + WS_X); const bf16_t* RT = (const bf16_t*)(ws + WS_W_RT) + (size_t)layer * 49152;
    float* rinvB = (float*)(ws + WS_SMALL + SM_RINVB); float* wts = (float*)(ws + WS_SMALL + SM_WTS); unsigned char* xq = ws + WS_SCR + SC_XQ;
    unsigned* cnt = (unsigned*)(ws + WS_CTL) + CW_CNT + layer * 64; int* list = (int*)(ws + WS_LIST);
    if (blockIdx.x == 0 && tid < 64) ((GAS u32x4*)(xq + (size_t)T_TOK * 1024))[tid] = (u32x4){0u, 0u, 0u, 0u};
    LAS float* LG = (LAS float*)(lds + 98304);
    LAS int* HIST = (LAS int*)(lds + 118784);
    LAS int* ASG = (LAS int*)(lds + 119040);
    const int fr = lane & 15, fq = lane >> 4;
    const float* bgp = ARG(I_MOE_BG); const float* bep = ARG(I_MOE_BE);
    __syncthreads();
#pragma unroll
    for (int t = 0; t < 12; ++t) { const int i = wave * 12 + t; __builtin_amdgcn_global_load_lds((const unsigned*)((const char*)RT + i * 1024 + lane * 16), (LAS unsigned*)(lds + i * 1024), 16, 0, 0); }
    for (int it = (c & 7) * (G >> 3) + (c >> 3); it < T_TOK / 128; it += G) {
        const int tok0 = it * 128 + wave * 16;
        bf16x8 xa[32];
        const bf16_t* xrow = X + (size_t)(tok0 + fr) * 1024 + fq * 8;
#pragma unroll
        for (int ks = 0; ks < 32; ++ks) xa[ks] = *(const GAS bf16x8*)(xrow + ks * 32);
        asm volatile("s_waitcnt vmcnt(0)" ::: "memory");
        __syncthreads();
        if (tid < 64) HIST[tid] = 0;
        f32x4 acc[3];
#pragma unroll
        for (int j = 0; j < 3; ++j) acc[j] = (f32x4){0.f, 0.f, 0.f, 0.f};
        float ss = 0.f, am = 0.f;
#pragma unroll
        for (int ks = 0; ks < 32; ++ks) { const u32x4 w = __builtin_bit_cast(u32x4, xa[ks]);
            ss += bflo(w.x) * bflo(w.x) + bfhi(w.x) * bfhi(w.x) + bflo(w.y) * bflo(w.y) + bfhi(w.y) * bfhi(w.y) + bflo(w.z) * bflo(w.z) + bfhi(w.z) * bfhi(w.z) + bflo(w.w) * bflo(w.w) + bfhi(w.w) * bfhi(w.w);
            am = fmaxf(am, fmaxf(fmaxf(fmaxf(fabsf(bflo(w.x)), fabsf(bfhi(w.x))), fmaxf(fabsf(bflo(w.y)), fabsf(bfhi(w.y)))), fmaxf(fmaxf(fabsf(bflo(w.z)), fabsf(bfhi(w.z))), fmaxf(fabsf(bflo(w.w)), fabsf(bfhi(w.w)))))); }
        ss += __shfl_xor(ss, 16); ss += __shfl_xor(ss, 32);
        am = fmaxf(am, __shfl_xor(am, 16)); am = fmaxf(am, __shfl_xor(am, 32)); am = fmaxf(am, 1e-20f);
        const float rinv = 1.0f / sqrtf(ss * (1.0f / 1024.0f) + RMS_EPS), qs = 127.0f / am;
        if (fq == 0) rinvB[tok0 + fr] = rinv * am * (1.0f / 127.0f);
        GAS u32x2* qrow = (GAS u32x2*)(xq + (size_t)(tok0 + fr) * 1024 + fq * 8);
#pragma unroll
        for (int ks = 0; ks < 32; ++ks) {
#pragma unroll
            for (int j = 0; j < 3; ++j) { const bf16x8 wb = *(const LAS bf16x8*)(lds + ((ks * 3 + j) * 64 + lane) * 16);
                acc[j] = __builtin_amdgcn_mfma_f32_16x16x32_bf16(xa[ks], wb, acc[j], 0, 0, 0); }
            { u32x4 w = __builtin_bit_cast(u32x4, xa[ks]); asm volatile("" : "+v"(w));
              const int q0 = (int)rintf(bflo(w.x) * qs), q1 = (int)rintf(bfhi(w.x) * qs), q2 = (int)rintf(bflo(w.y) * qs), q3 = (int)rintf(bfhi(w.y) * qs);
              const int q4 = (int)rintf(bflo(w.z) * qs), q5 = (int)rintf(bfhi(w.z) * qs), q6 = (int)rintf(bflo(w.w) * qs), q7 = (int)rintf(bfhi(w.w) * qs);
              u32x2 o; o.x = (unsigned)(q0 & 255) | ((unsigned)(q1 & 255) << 8) | ((unsigned)(q2 & 255) << 16) | ((unsigned)(q3 & 255) << 24);
              o.y = (unsigned)(q4 & 255) | ((unsigned)(q5 & 255) << 8) | ((unsigned)(q6 & 255) << 16) | ((unsigned)(q7 & 255) << 24);
              qrow[ks * 4] = o; } }
#pragma unroll
        for (int reg = 0; reg < 4; ++reg) { const float rv = __shfl(rinv, fq * 4 + reg);
#pragma unroll
            for (int j = 0; j < 3; ++j) { const int n = j * 16 + fr; if (n < 40) LG[(wave * 16 + fq * 4 + reg) * 40 + n] = acc[j][reg] * rv; } }
        __syncthreads();
        if (tid < 128) { const int t = tid; const LAS float* lg = LG + t * 40;
            float gl[4]; int gsel = 0; float gm = -3.0e38f;
#pragma unroll
            for (int j = 0; j < 4; ++j) { gl[j] = lg[j] + bgp[layer * 4 + j]; if (gl[j] > gm) { gm = gl[j]; gsel = j; } }
            float gs = 0.f;
#pragma unroll
            for (int j = 0; j < 4; ++j) gs += expf(gl[j] - gm);
            const float wg = 1.0f / gs;
            float v0 = -3.0e38f, v1 = -3.0e38f; int i0 = 0, i1 = 0;
            for (int j = 0; j < 8; ++j) { const float v = lg[4 + gsel * 8 + j] + bep[layer * 32 + gsel * 8 + j];
                if (v > v0) { v1 = v0; i1 = i0; v0 = v; i0 = j; } else if (v > v1) { v1 = v; i1 = j; } }
            const float e1 = expf(v1 - v0), den = 1.0f / (1.0f + e1);
            const int tok = it * 128 + t; const int ea = gsel * 8 + i0, eb = gsel * 8 + i1;
            wts[(size_t)tok * 2] = wg * den; wts[(size_t)tok * 2 + 1] = wg * e1 * den;
            ASG[t * 4] = ea; ASG[t * 4 + 1] = __hip_atomic_fetch_add(HIST + ea, 1, __ATOMIC_RELAXED, __HIP_MEMORY_SCOPE_WORKGROUP); ASG[t * 4 + 2] = eb; ASG[t * 4 + 3] = __hip_atomic_fetch_add(HIST + eb, 1, __ATOMIC_RELAXED, __HIP_MEMORY_SCOPE_WORKGROUP); }
        __syncthreads();
        if (tid < 32) { const int n = HIST[tid]; HIST[32 + tid] = n ? (int)atomicAdd(&cnt[tid], (unsigned)n) : 0; }
        __syncthreads();
        if (tid < 128) { const int tok = it * 128 + tid; const int ea = ASG[tid * 4], eb = ASG[tid * 4 + 2];
            list[(size_t)ea * 32768 + HIST[32 + ea] + ASG[tid * 4 + 1]] = tok * 2; list[(size_t)eb * 32768 + HIST[32 + eb] + ASG[tid * 4 + 3]] = tok * 2 + 1; }
    }
    asm volatile("s_waitcnt vmcnt(0)" ::: "memory");
}

__device__ __forceinline__ bool moe_unit(int uidx, const LAS int* TP, unsigned A, unsigned arow, unsigned Bw, unsigned bstride, unsigned btile, int slot, g8::Unit& u) {
    if (uidx < 0 || uidx >= TP[32] * 4) return false;
    const int rtile = uidx >> 2, pn = uidx & 3; int e = 0;
    for (int j = 1; j < 32; ++j) e += (TP[j] <= rtile) ? 1 : 0;
    u.A = A + (unsigned)rtile * 256u * arow; u.A2 = u.A; u.B = Bw + (unsigned)e * bstride + (unsigned)pn * btile;
    u.pm = rtile * 256; u.pn = pn; u.slot = slot; u.aux = e | ((rtile - TP[e]) << 8); return true;
}
struct MoeUpSched {
    unsigned Bw; const LAS int* TP; int r;
    __device__ __forceinline__ bool next(int i, g8::Unit& u) const { return moe_unit(i * 256 + r, TP, (unsigned)(WS_SCR + SC_XQ), 0u, Bw, (unsigned)(2 * MiB), 512u * 1024u, i, u); }
    __device__ __forceinline__ void a_ready(const g8::Unit&, int, int) const {}
};
struct MoeDownSched {
    unsigned Bw; const LAS int* TP; int r; unsigned* done; unsigned* tmo;
    __device__ __forceinline__ int didx(int i) const {
        const int NU = TP[32] * 4, n5 = NU - 1024;
        if (n5 < 0 || n5 > 85) return i * 256 + r;
        if (r < n5) return i < 3 ? i * 256 + r : -1;
        if (i < 4) return i * 256 + r;
        if (i == 4) { if (r < 2 * n5) return 768 + (r - n5); if (r < 3 * n5) return 1024 + (r - 2 * n5); }
        return -1;
    }
    __device__ __forceinline__ bool next(int i, g8::Unit& u) const { return moe_unit(didx(i), TP, (unsigned)(WS_SCR + SC_HB), 1024u, Bw, (unsigned)(1 * MiB), 256u * 1024u, i, u); }
    __device__ __forceinline__ void a_ready(const g8::Unit& u, int wid, int lane) const {
        if (wid == 0) { unsigned* w = done + (u.pm >> 8) * 64; unsigned sp = 0;
            while ((unsigned)__builtin_amdgcn_readfirstlane(__hip_atomic_load(w, __ATOMIC_RELAXED, __HIP_MEMORY_SCOPE_AGENT)) < 32u) {
                __builtin_amdgcn_s_sleep(2);
                if (++sp > (1u << 20)) { if (lane == 0) __hip_atomic_fetch_add(tmo, 1u, __ATOMIC_RELAXED, __HIP_MEMORY_SCOPE_AGENT); break; } }
            __builtin_amdgcn_fence(__ATOMIC_ACQUIRE, "agent");
            asm volatile("s_waitcnt vmcnt(0)" ::: "memory"); }
        asm volatile("" ::: "memory"); __builtin_amdgcn_s_barrier(); asm volatile("" ::: "memory");
    }
};
__device__ __forceinline__ void moe_tables(const ArgsV& a, LAS unsigned char* lds, int layer, const MoeUpSched& SU, const MoeDownSched& SD, int tid) {
    unsigned char* ws = a.ws; const unsigned* cnt = (const unsigned*)(ws + WS_CTL) + CW_CNT + layer * 64; const int* list = (const int*)(ws + WS_LIST);
    const float* rinvB = (const float*)(ws + WS_SMALL + SM_RINVB); const float* wts = (const float*)(ws + WS_SMALL + SM_WTS);
    LAS int* TP = (LAS int*)(lds + LX_TAB); LAS int* TOK = TP + 64; LAS float* RS = (LAS float*)(TOK + 5 * 256); LAS float* WT = RS + 5 * 256; LAS int* TOKK = (LAS int*)(WT + 5 * 256);
    __syncthreads();
    if (tid == 0) { int s = 0; for (int e = 0; e < 32; ++e) { TP[e] = s; s += ((int)cnt[e] + 255) >> 8; } TP[32] = s; }
    __syncthreads();
    g8::Unit u;
    for (int i = 0; i < 5 && SU.next(i, u); ++i) {
        if (tid < 256) { const int e = u.aux & 255, rt = u.aux >> 8; const int pos = rt * 256 + tid; const int n = (int)cnt[e];
            int tok = T_TOK; float rs = 0.f, wt = 0.f;
            if (pos < n) { const int tk = list[(size_t)e * 32768 + pos]; tok = tk >> 1; rs = rinvB[tok]; wt = wts[tk]; }
            TOK[i * 256 + tid] = tok; RS[i * 256 + tid] = rs; WT[i * 256 + tid] = wt; } }
    for (int i = 0; i < 5 && SD.next(i, u); ++i) {
        if (tid < 256) { const int e = u.aux & 255, rt = u.aux >> 8; const int pos = rt * 256 + tid; const int n = (int)cnt[e];
            TOKK[i * 256 + tid] = (pos < n) ? list[(size_t)e * 32768 + pos] : -1; } }
    __syncthreads();
}
__device__ __forceinline__ void requant_gmin(const ArgsV& a, int gw, int NGW, int lane) {
    unsigned char* ws = a.ws; const bf16_t* W = (const bf16_t*)(ws + WS_W_GMIN); unsigned char* Q = ws + WS_W_GMQ; float* sw = (float*)(ws + WS_SMALL + SM_GMSW);
    for (int n = gw; n < 4096; n += NGW) {
        const GAS u32x4* wp = (const GAS u32x4*)(W + (size_t)n * 1024) + lane; u32x4 wv[2]; float am = 0.f;
#pragma unroll
        for (int j = 0; j < 2; ++j) { wv[j] = wp[64 * j]; const u32x4 w = wv[j];
            am = fmaxf(am, fmaxf(fmaxf(fmaxf(fabsf(bflo(w.x)), fabsf(bfhi(w.x))), fmaxf(fabsf(bflo(w.y)), fabsf(bfhi(w.y)))), fmaxf(fmaxf(fabsf(bflo(w.z)), fabsf(bfhi(w.z))), fmaxf(fabsf(bflo(w.w)), fabsf(bfhi(w.w)))))); }
#pragma unroll
        for (int o = 1; o < 64; o <<= 1) am = fmaxf(am, __shfl_xor(am, o));
        am = fmaxf(am, 1e-30f); const float qs = 127.0f / am;
        GAS u32x2* qp = (GAS u32x2*)(Q + (size_t)n * 1024) + lane;
#pragma unroll
        for (int j = 0; j < 2; ++j) { const u32x4 w = wv[j];
            const int q0 = (int)rintf(bflo(w.x) * qs), q1 = (int)rintf(bfhi(w.x) * qs), q2 = (int)rintf(bflo(w.y) * qs), q3 = (int)rintf(bfhi(w.y) * qs);
            const int q4 = (int)rintf(bflo(w.z) * qs), q5 = (int)rintf(bfhi(w.z) * qs), q6 = (int)rintf(bflo(w.w) * qs), q7 = (int)rintf(bfhi(w.w) * qs);
            u32x2 o; o.x = (unsigned)(q0 & 255) | ((unsigned)(q1 & 255) << 8) | ((unsigned)(q2 & 255) << 16) | ((unsigned)(q3 & 255) << 24);
            o.y = (unsigned)(q4 & 255) | ((unsigned)(q5 & 255) << 8) | ((unsigned)(q6 & 255) << 16) | ((unsigned)(q7 & 255) << 24);
            qp[64 * j] = o; }
        if (lane == 0) gstf(sw + n, am * (1.0f / 127.0f)); }
}
__device__ __forceinline__ void combine_phase(const ArgsV& a, int base, int lw, int stride, int nk, int lane, bool last) {
    unsigned char* ws = a.ws; bf16_t* X = (bf16_t*)(ws + WS_X); const bf16_t* YS = (const bf16_t*)(ws + WS_SCR + SC_YS); float* rinvA = (float*)(ws + WS_SMALL + SM_RINVA); unsigned char* xq = ws + WS_P1;
    for (int k = 0; k < nk; ++k) { const int m = base + lw + k * stride;
        GAS u32x4* xp = (GAS u32x4*)(X + (size_t)m * 1024) + lane; const GAS u32x4* y0 = (const GAS u32x4*)(YS + (size_t)m * 2048) + lane; const GAS u32x4* y1 = y0 + 128;
        float v[2][8]; float s = 0.f;
#pragma unroll
        for (int j = 0; j < 2; ++j) { const u32x4 xv = xp[64 * j], p = y0[64 * j], q = y1[64 * j];
            v[j][0] = bflo(xv.x) + bflo(p.x) + bflo(q.x); v[j][1] = bfhi(xv.x) + bfhi(p.x) + bfhi(q.x); v[j][2] = bflo(xv.y) + bflo(p.y) + bflo(q.y); v[j][3] = bfhi(xv.y) + bfhi(p.y) + bfhi(q.y);
            v[j][4] = bflo(xv.z) + bflo(p.z) + bflo(q.z); v[j][5] = bfhi(xv.z) + bfhi(p.z) + bfhi(q.z); v[j][6] = bflo(xv.w) + bflo(p.w) + bflo(q.w); v[j][7] = bfhi(xv.w) + bfhi(p.w) + bfhi(q.w); }
        if (!last) {
            u32x4 wv[2];
#pragma unroll
            for (int j = 0; j < 2; ++j) { u32x4 w; w.x = cvt_pk_bf16(v[j][0], v[j][1]); w.y = cvt_pk_bf16(v[j][2], v[j][3]); w.z = cvt_pk_bf16(v[j][4], v[j][5]); w.w = cvt_pk_bf16(v[j][6], v[j][7]); xp[64 * j] = w; wv[j] = w;
                s += bflo(w.x) * bflo(w.x) + bfhi(w.x) * bfhi(w.x) + bflo(w.y) * bflo(w.y) + bfhi(w.y) * bfhi(w.y) + bflo(w.z) * bflo(w.z) + bfhi(w.z) * bfhi(w.z) + bflo(w.w) * bflo(w.w) + bfhi(w.w) * bfhi(w.w); }
            const float r = 1.0f / sqrtf(wave_sum(s) * (1.0f / 1024.0f) + RMS_EPS);
            float am = 0.f;
#pragma unroll
            for (int j = 0; j < 2; ++j) { const u32x4 w = wv[j];
                am = fmaxf(am, fmaxf(fmaxf(fmaxf(fabsf(bflo(w.x)), fabsf(bfhi(w.x))), fmaxf(fabsf(bflo(w.y)), fabsf(bfhi(w.y)))), fmaxf(fmaxf(fabsf(bflo(w.z)), fabsf(bfhi(w.z))), fmaxf(fabsf(bflo(w.w)), fabsf(bfhi(w.w)))))); }
#pragma unroll
            for (int o = 1; o < 64; o <<= 1) am = fmaxf(am, __shfl_xor(am, o));
            am = fmaxf(am, 1e-20f); const float qs = 127.0f / am;
            GAS u32x2* qp = (GAS u32x2*)(xq + (size_t)m * 2048) + lane;
#pragma unroll
            for (int j = 0; j < 2; ++j) { const u32x4 w = wv[j];
                const int q0 = (int)rintf(bflo(w.x) * qs), q1 = (int)rintf(bfhi(w.x) * qs), q2 = (int)rintf(bflo(w.y) * qs), q3 = (int)rintf(bfhi(w.y) * qs);
                const int q4 = (int)rintf(bflo(w.z) * qs), q5 = (int)rintf(bfhi(w.z) * qs), q6 = (int)rintf(bflo(w.w) * qs), q7 = (int)rintf(bfhi(w.w) * qs);
                u32x2 o; o.x = (unsigned)(q0 & 255) | ((unsigned)(q1 & 255) << 8) | ((unsigned)(q2 & 255) << 16) | ((unsigned)(q3 & 255) << 24);
                o.y = (unsigned)(q4 & 255) | ((unsigned)(q5 & 255) << 8) | ((unsigned)(q6 & 255) << 16) | ((unsigned)(q7 & 255) << 24);
                qp[64 * j] = o; }
            if (lane == 0) gstf(rinvA + m, r * am * (1.0f / 127.0f));
        } else {
#pragma unroll
            for (int j = 0; j < 2; ++j)
#pragma unroll
                for (int k = 0; k < 8; ++k) s += v[j][k] * v[j][k];
            const float r = 1.0f / sqrtf(wave_sum(s) * (1.0f / 1024.0f) + RMS_EPS);
#pragma unroll
            for (int j = 0; j < 2; ++j) { const GAS f32x4* gp = (const GAS f32x4*)(ARG(I_FINAL_NORM) + (64 * j + lane) * 8); const f32x4 g0 = gp[0], g1 = gp[1];
                GAS f32x4* op = (GAS f32x4*)(((float*)ARG(33)) + (size_t)m * 1024 + (64 * j + lane) * 8);
                op[0] = (f32x4){v[j][0] * r * g0[0], v[j][1] * r * g0[1], v[j][2] * r * g0[2], v[j][3] * r * g0[3]};
                op[1] = (f32x4){v[j][4] * r * g1[0], v[j][5] * r * g1[1], v[j][6] * r * g1[2], v[j][7] * r * g1[3]}; }
        }
    }
}

__device__ __forceinline__ void spatial_phase(const ArgsV& a, LAS unsigned char* lds, int G, int c, int tid, int wave, int lane) {
    unsigned char* ws = a.ws; bf16_t* Z = (bf16_t*)(ws + WS_SCR + SC_Z); const float* part = (const float*)(ws + WS_PART);
    const char* WSB = (const char*)(ws + WS_SMALL + SM_WSB);
    LAS float* RV = (LAS float*)lds;
    LAS unsigned char* WLB = lds + 512;
    LAS bf16_t* ZL = (LAS bf16_t*)(lds + 512 + 65536);
    const int fr = lane & 15, fq = lane >> 4;
    const float* VN = ARG(I_GM_VNORM); const float* BS = ARG(I_GM_BS);
    for (int span = (c & 7) * (G >> 3) + (c >> 3); span < 256; span += G) {
        const size_t row0 = (size_t)span * 128;
        u32x4 zr[8]; u32x4 uv[8], un[8];
#define SP_LOADZ(gg_) do { _Pragma("unroll") for (int i = 0; i < 8; ++i) { const int idx = tid + i * NTHR; zr[i] = gld128(Z + ((size_t)span * 16 + 8 + (gg_)) * 32768 + (size_t)idx * 8); } } while (0)
#define SP_LOADU(dst, gg_) do { _Pragma("unroll") for (int mt = 0; mt < 8; ++mt) \
            dst[mt] = gld128(Z + ((size_t)span * 16 + (gg_)) * 32768 + (mt * 16 + fr) * 256 + wave * 32 + fq * 8); } while (0)
#define SP_DMAW(gg_) do { _Pragma("unroll") for (int t = 0; t < 4; ++t) { const int i = wave * 4 + t; \
            __builtin_amdgcn_global_load_lds((const unsigned*)(WSB + (size_t)(gg_) * 32768 + i * 1024 + lane * 16), (LAS unsigned*)(WLB + ((gg_) & 1) * 32768 + i * 1024), 16, 0, 0); } } while (0)
        __syncthreads();
        SP_LOADZ(0); SP_LOADU(un, 0); SP_DMAW(0);
        if (tid < 128) { float s = 0.f; const GAS f32x4* pp = (const GAS f32x4*)(part + (row0 + tid) * 32);
#pragma unroll
            for (int j = 0; j < 8; ++j) { const f32x4 t = pp[j]; s += (t[0] + t[1]) + (t[2] + t[3]); }
            RV[tid] = 1.0f / sqrtf(s * (1.0f / 2048.0f) + RMS_EPS); }
        __syncthreads();
#pragma unroll 1
        for (int gg = 0; gg < 8; ++gg) {
            asm volatile("s_waitcnt vmcnt(0)" ::: "memory");
#pragma unroll
            for (int i = 0; i < 8; ++i) { const int idx = tid + i * NTHR, j = idx >> 5, c8 = idx & 31; const float rv = RV[j];
                LAS unsigned* d = (LAS unsigned*)(ZL + j * 258 + c8 * 8);
                d[0] = cvt_pk_bf16(bflo(zr[i].x) * rv, bfhi(zr[i].x) * rv); d[1] = cvt_pk_bf16(bflo(zr[i].y) * rv, bfhi(zr[i].y) * rv);
                d[2] = cvt_pk_bf16(bflo(zr[i].z) * rv, bfhi(zr[i].z) * rv); d[3] = cvt_pk_bf16(bflo(zr[i].w) * rv, bfhi(zr[i].w) * rv); }
#pragma unroll
            for (int mt = 0; mt < 8; ++mt) uv[mt] = un[mt];
            __syncthreads();
            if (gg < 7) { SP_DMAW(gg + 1); SP_LOADZ(gg + 1); SP_LOADU(un, gg + 1); }
            LAS unsigned char* WL = WLB + (gg & 1) * 32768;
            const f32x4 vn0 = gldf4(VN + gg * 256 + wave * 32 + fq * 8), vn1 = gldf4(VN + gg * 256 + wave * 32 + fq * 8 + 4);
#pragma unroll
            for (int hf = 0; hf < 2; ++hf) {
                f32x4 acc[2][4];
#pragma unroll
                for (int t = 0; t < 2; ++t)
#pragma unroll
                    for (int mt = 0; mt < 4; ++mt) acc[t][mt] = (f32x4){0.f, 0.f, 0.f, 0.f};
#pragma unroll 1
                for (int ks = 0; ks < 4; ++ks) {
                    bf16x8 za[2];
#pragma unroll
                    for (int t = 0; t < 2; ++t) { const int cc = wave * 32 + 8 * (fr >> 2) + 4 * t + (fr & 3); const LAS bf16_t* zp = ZL + (ks * 32 + fq * 8) * 258 + cc;
#pragma unroll
                        for (int jj = 0; jj < 8; ++jj) za[t][jj] = (short)zp[jj * 258]; }
#pragma unroll
                    for (int mt = 0; mt < 4; ++mt) { const bf16x8 wb = *(const LAS bf16x8*)(WL + ((hf * 4 + mt) * 16 + fr) * 256 + (((ks * 4 + fq) ^ fr) << 4));
                        acc[0][mt] = __builtin_amdgcn_mfma_f32_16x16x32_bf16(za[0], wb, acc[0][mt], 0, 0, 0);
                        acc[1][mt] = __builtin_amdgcn_mfma_f32_16x16x32_bf16(za[1], wb, acc[1][mt], 0, 0, 0); } }
#pragma unroll
                for (int mt = 0; mt < 4; ++mt) { const int i = (hf * 4 + mt) * 16 + fr; const float bs = gldf(BS + gg * 128 + i);
                    const u32x4 uvv = uv[hf * 4 + mt]; const f32x4 m0 = acc[0][mt], m1 = acc[1][mt];
                    u32x4 o; o.x = cvt_pk_bf16(bflo(uvv.x) * (vn0[0] * m0[0] + bs), bfhi(uvv.x) * (vn0[1] * m0[1] + bs)); o.y = cvt_pk_bf16(bflo(uvv.y) * (vn0[2] * m0[2] + bs), bfhi(uvv.y) * (vn0[3] * m0[3] + bs));
                    o.z = cvt_pk_bf16(bflo(uvv.z) * (vn1[0] * m1[0] + bs), bfhi(uvv.z) * (vn1[1] * m1[1] + bs)); o.w = cvt_pk_bf16(bflo(uvv.w) * (vn1[2] * m1[2] + bs), bfhi(uvv.w) * (vn1[3] * m1[3] + bs));
                    gst128(Z + ((size_t)span * 16 + gg) * 32768 + i * 256 + wave * 32 + fq * 8, o); }
            }
            __syncthreads();
        }
#undef SP_LOADZ
#undef SP_LOADU
#undef SP_DMAW
    }
    asm volatile("s_waitcnt vmcnt(0)" ::: "memory");
}
struct KvSched {
    int G, c;
    __device__ __forceinline__ bool next(int i, g8::Unit& u) const {
        const int idx = i * G + c; if (idx >= 64) return false;
        const int l = idx >> 5, pm = (idx >> 3) & 3, pn = idx & 7;
        u.A = (unsigned)WS_MEMBF + (unsigned)pm * (256u * 2048u); u.A2 = u.A; u.B = (unsigned)WS_W_XA + (unsigned)l * (unsigned)(8 * MiB) + (unsigned)(2 * MiB) + (unsigned)pn * (256u * 2048u);
        u.pm = pm; u.pn = pn; u.slot = i; u.aux = l; return true; }
    __device__ __forceinline__ void a_ready(const g8::Unit&, int, int) const {}
};

#ifndef ONLY
#define ONLY -1
#endif
#define PH(n) (ONLY < 0 || ONLY == (n))
#ifndef P0_EARLY_LATE
#define P0_EARLY_LATE 8192
#endif
#define PHASE_CTX \
    ArgsV a; a.ws = (unsigned char*)ARG(34); unsigned char* ws = a.ws; const char* wsb = (const char*)ws; (void)wsb; \
    int tid_ = wave0 * 64 + lane_id(); asm volatile("" : "+v"(tid_)); const int tid = tid_, lane = tid & 63, wave = wave0; \
    const int G = gridDim.x; const volatile LAS unsigned* MS_ = (const volatile LAS unsigned*)(lds + LX_MISC); const int regular = __builtin_amdgcn_readfirstlane((int)MS_[10]) == 1; \
    const int c = regular ? __builtin_amdgcn_readfirstlane((int)(MS_[12] * 8u + MS_[13])) : (int)blockIdx.x;     \
    const int gw = c * NWAVES + wave, NGW = G * NWAVES; (void)gw; (void)NGW; (void)lane; \
    LAS float* RSL = (LAS float*)(lds + LX_TAB); bf16_t* X = (bf16_t*)(ws + WS_X); float* part = (float*)(ws + WS_PART); const float* rinvA = (const float*)(ws + WS_SMALL + SM_RINVA); \
    (void)RSL; (void)X; (void)part; (void)rinvA;
#ifndef PROBE_A
#define PROBE_A -1
#define PROBE_B -1
#endif
#ifndef PROBE_TICKS
#define PROBE_TICKS 1600
#endif
#define TSTAMP() do { if (PROBE_A >= 0 && blockIdx.x == 0 && wave0 == 0 && lane_id() == 0) { unsigned long long* ts_ = (unsigned long long*)((unsigned char*)ARG(34) + WS_CTL) + CW_DBG / 2; unsigned* n_ = (unsigned*)(ts_ + 200); ts_[*n_] = __builtin_amdgcn_s_memrealtime(); *n_ = *n_ + 1; } } while (0)
#define SUBSTAMP(k) do { if (PROBE_A >= 0 && blockIdx.x == 0 && wave0 == 0 && lane_id() == 0) { unsigned long long* ts_ = (unsigned long long*)((unsigned char*)ARG(34) + WS_CTL) + CW_DBG / 2; ts_[k] = __builtin_amdgcn_s_memrealtime(); } } while (0)
#define GRID_BAR() do { XcdBarrier bar_; bar_.bar = (unsigned*)((unsigned char*)ARG(34) + WS_CTL) + CW_BAR; bar_.x = xb_xcc_id(); bar_.st = (volatile LAS unsigned*)(lds + LX_MISC) + 8; xcd_barrier(bar_, wave0 == 0 && lane_id() == 0); TSTAMP(); } while (0)
#define LOCAL_BAR() do { const volatile LAS unsigned* ms_ = (const volatile LAS unsigned*)(lds + LX_MISC); if (__builtin_amdgcn_readfirstlane((int)ms_[10]) == 1) \
        xcc_local_barrier((unsigned*)((unsigned char*)ARG(34) + WS_CTL) + CW_BAR, (unsigned)__builtin_amdgcn_readfirstlane((int)ms_[13]), (unsigned)__builtin_amdgcn_readfirstlane((int)ms_[8]), wave0 == 0 && lane_id() == 0); \
    else GRID_BAR(); } while (0)
typedef g8::StdSched<128, 4, 256u * 2048u, 256u * 2048u> SchedN1024;

__global__ void __launch_bounds__(NTHR, 2) fwd_megakernel(Args a_unused) {
    extern __shared__ __attribute__((aligned(16))) unsigned char lds_raw[];
    LAS unsigned char* lds = (LAS unsigned char*)lds_raw;
    const int wave0 = __builtin_amdgcn_readfirstlane((int)threadIdx.x >> 6);
    { volatile LAS unsigned* MISC = (volatile LAS unsigned*)(lds + LX_MISC);
      if (wave0 == 0) MISC[lane_id()] = 0u;
      __syncthreads();
      if (wave0 == 0 && lane_id() == 0) { const unsigned x_ = xb_xcc_id(); MISC[13] = x_; MISC[12] = xcd_barrier_post((unsigned*)((unsigned char*)ARG(34) + WS_CTL) + CW_BAR, x_, true); }
      __syncthreads(); }
    TSTAMP();

    if (PH(0)) { PHASE_CTX
      const int NSH = 64 + 2 * (G - 64);
      int sh0, nsh;
      if (c < 64) { p0_s5_tables(a, lds, c, tid); __syncthreads(); sh0 = c; nsh = 1; } else { sh0 = 64 + 2 * (c - 64); nsh = 2; }
#pragma unroll 1
      for (int s = 0; s < nsh; ++s) { const int gwv = (sh0 + s) * NWAVES + wave, NGWv = NSH * NWAVES;
        p0_weights(a, lds, 0, 0, 1 << 30, gwv, NGWv, wave, lane);
        p0_rows(a, gwv, NGWv, lane);
        p0_weights(a, lds, 1, 0, P0_EARLY_LATE, gwv, NGWv, wave, lane); } }
    GRID_BAR();

    if (PH(1)) { PHASE_CTX
      if ((c >> 3) < (G >> 4)) {
        const int cg = c - ((c >> 3) >= (G >> 4) ? (G >> 1) : 0), Gg = G >> 1;
        { typedef g8::StdSched<128, 4, 256u * 2048u, 256u * 2048u> Sc; Sc S{(unsigned)WS_X, (unsigned)WS_W_S5IN, Gg, cg};
          fill_rs(S, RSL, rinvA, nullptr, 0, tid);
          g8::EpiU E{(bf16_t*)(ws + WS_SCR + SC_U), RSL};
          g8::gemm_phase<g8::EpiU, Sc, 0, 2048, 2048, 128, 128, 16, 16>(lds, wsb, S, E, nullptr, tid); }
        { KvSched S{Gg, cg};
          g8::EpiKV E{(bf16_t*)(ws + WS_KV), (const float*)(ws + WS_SMALL + SM_RINVMEM)};
          g8::gemm_phase<g8::EpiKV, KvSched, 0, 2048, 2048, 128, 128, 16, 16>(lds, wsb, S, E, nullptr, tid); }
      } else {
        const int cw = c - (G >> 1);
        p0_weights(a, lds, 1, P0_EARLY_LATE, 1 << 30, cw * NWAVES + wave, (G >> 1) * NWAVES, wave, lane);
        p0_moe_gu_jobs(a, lds, cw * NWAVES + wave, (G >> 1) * NWAVES, wave, lane);
      } }
    GRID_BAR();

    if (PH(3)) { PHASE_CTX
      { const int pr = c; if (pr < 256) { const int q = pr >> 3; s5_scan_pair(a, lds, q >> 3, (pr & 7) * 8 + (q & 7), tid, wave, lane, PROBE_A >= 0 ? (unsigned long long*)(ws + WS_CTL) + CW_DBG / 2 + 48 : nullptr); } }
      requant_gmin(a, gw, NGW, lane);
      prep_phase(a, lds, 0, c, tid); }
    GRID_BAR();

    if (PH(4)) { PHASE_CTX
      typedef g8::StdSched<128, 8, 256u * 32u, 256u * 2048u> Sc; Sc S{(unsigned)(WS_SCR + SC_Y), (unsigned)WS_W_S5OUT, G, c};
      g8::EpiGluRes E{X, part};
      g8::gemm_phase<g8::EpiGluRes, Sc, 16, 32, 2048, 4194304, 128, 16, 16>(lds, wsb, S, E, nullptr, tid); }
    LOCAL_BAR();

#pragma unroll 1
    for (int layer = 0; layer < 2; ++layer) {
        if (layer == 1) {
            if (PH(5)) { PHASE_CTX
              typedef g8::StdSched<128, 16, 256u * 2048u, 256u * 1024u> Sc; Sc S{(unsigned)WS_P1, (unsigned)WS_W_GMQ, G, c};
              fill_rs(S, RSL, rinvA, nullptr, 0, tid);
              g8::EpiGmIn E{(bf16_t*)(ws + WS_SCR + SC_Z), RSL, part, (const float*)(ws + WS_SMALL + SM_GMSW)};
              g8::gemm_phase<g8::EpiGmIn, Sc, 0, 2048, 1024, 128, 128, 8, 8>(lds, wsb, S, E, nullptr, tid); }
            LOCAL_BAR();
            if (PH(6)) { PHASE_CTX
              spatial_phase(a, lds, G, c, tid, wave, lane); }
            LOCAL_BAR();
            if (PH(7)) { PHASE_CTX
              typedef g8::StdSched<128, 4, 256u * 8192u, 256u * 4224u> Sc; Sc S{(unsigned)(WS_SCR + SC_Z), (unsigned)WS_W_GMOUT_P, G, c};
              g8::EpiRes<true> E{X, part};
              g8::gemm_phase<g8::EpiRes<true>, Sc, 4, 512, 4224, 128, 128, 32, 32>(lds, wsb, S, E, nullptr, tid, (PROBE_A >= 0) ? (unsigned long long*)(ws + WS_CTL) + CW_DBG / 2 + 40 : nullptr);
              prep_phase(a, lds, 1, c, tid); }
            LOCAL_BAR();
        }
        if (PH(8)) { PHASE_CTX
          const unsigned GXo = (layer == 0 ? (unsigned)(WS_SCR + SC_G0) : (unsigned)WS_G1) + (unsigned)(c & 7) * (unsigned)(4 * MiB);
          SchedN1024 S{(unsigned)WS_X, GXo, G, c};
          fill_rs(S, RSL, nullptr, part, layer == 0 ? 32 : 16, tid);
          g8::EpiSoftmax E{(bf16_t*)(ws + (layer == 0 ? WS_SCR + SC_P0 : WS_P1)), RSL, (LAS float*)(lds + LX_TAB + 8192)};
          g8::gemm_phase<g8::EpiSoftmax, SchedN1024, 0, 2048, 2048, 128, 128, 16, 16>(lds, wsb, S, E, nullptr, tid, (PROBE_A >= 0 && layer == 0) ? (unsigned long long*)(ws + WS_CTL) + CW_DBG / 2 + 32 : nullptr); }
        LOCAL_BAR();
        if (PH(10)) { PHASE_CTX
          const unsigned GXo = (layer == 0 ? (unsigned)(WS_SCR + SC_G0) : (unsigned)WS_G1) + (unsigned)(c & 7) * (unsigned)(4 * MiB) + (unsigned)(2 * MiB);
          SchedN1024 S{layer == 0 ? (unsigned)(WS_SCR + SC_P0) : (unsigned)WS_P1, GXo, G, c};
          g8::EpiRes<false> E{X, part};
          g8::gemm_phase<g8::EpiRes<false>, SchedN1024, 0, 2048, 2048, 128, 128, 16, 16>(lds, wsb, S, E, nullptr, tid); }
        GRID_BAR();
        if (PH(11)) { PHASE_CTX
          router_phase(a, lds, layer, G, c, tid, wave, lane); }
        GRID_BAR();
        if (PH(12)) { PHASE_CTX
          LAS int* TP = (LAS int*)(lds + LX_TAB); LAS int* TOK = TP + 64; LAS float* RS = (LAS float*)(TOK + 5 * 256); LAS float* WT = RS + 5 * 256; LAS int* TOKK = (LAS int*)(WT + 5 * 256);
          unsigned* done = (unsigned*)(ws + WS_CTL) + CW_DONE + layer * 32768;
          const int r = (c & 7) * (G >> 3) + (c >> 3);
          MoeUpSched SU{(unsigned)WS_W_MOE + (unsigned)layer * (unsigned)MOE_L_STRIDE, TP, r};
          MoeDownSched SD{(unsigned)WS_W_MOE + (unsigned)layer * (unsigned)MOE_L_STRIDE + (unsigned)MOE_D_OFF, TP, r, done, (unsigned*)(ws + WS_CTL) + CW_BAR + XB_TMO};
          moe_tables(a, lds, layer, SU, SD, tid);
          { g8::EpiMoeUp E{__builtin_amdgcn_make_buffer_rsrc((void*)(ws + WS_SCR + SC_HB), (short)0, (int)(73728u * 1024u), 0x00020000), RS, WT, done, (const float*)(ws + WS_SMALL + SM_MOESW) + layer * 32768};
            g8::gemm_phase<g8::EpiMoeUp, MoeUpSched, 1, 1024, 2048, 128, 128, 8, 8>(lds, wsb, SU, E, TOK, tid); }
          { g8::EpiMoeDown E{(bf16_t*)(ws + WS_SCR + SC_YS), TOKK};
            g8::gemm_phase<g8::EpiMoeDown, MoeDownSched, 0, 1024, 1024, 128, 128, 8, 8>(lds, wsb, SD, E, nullptr, tid); } }
        GRID_BAR();
        if (PH(14)) { PHASE_CTX
          if (regular) combine_phase(a, (c & 7) * 4096, (c >> 3) * NWAVES + wave, (G >> 3) * NWAVES, 16, lane, layer == 1);
          else combine_phase(a, 0, gw, NGW, T_TOK / NGW, lane, layer == 1); }
        if (layer == 0) LOCAL_BAR();
    }
    if (PROBE_A >= 0 && blockIdx.x == 0 && wave0 == 0 && lane_id() == 0) {
        asm volatile("s_waitcnt vmcnt(0)" ::: "memory");
        unsigned long long* ts_ = (unsigned long long*)((unsigned char*)ARG(34) + WS_CTL) + CW_DBG / 2; const unsigned long long te = __builtin_amdgcn_s_memrealtime(); ts_[21] = te;
        unsigned long long qa = (ts_[PROBE_A + 1] - ts_[PROBE_A] + PROBE_TICKS / 2) / PROBE_TICKS, qb = (ts_[PROBE_B + 1] - ts_[PROBE_B] + PROBE_TICKS / 2) / PROBE_TICKS; if (qa > 63) qa = 63; if (qb > 63) qb = 63;
        const unsigned long long D = (qa + 64 * qb) * 6400;
        while (__builtin_amdgcn_s_memrealtime() - te < D) __builtin_amdgcn_s_sleep(32);
    }
    { unsigned* ctl = (unsigned*)((unsigned char*)ARG(34) + WS_CTL);
      if (xb_ld(ctl + CW_BAR + XB_TMO) != 0u && blockIdx.x == 0 && wave0 == 0 && lane_id() == 0) ((float*)ARG(33))[0] = __builtin_nanf(""); }
}

extern "C" void kernel_launch(void* const* d_in, const int* in_sizes, int n_in, void* d_out, int out_size, void* d_ws, size_t ws_size, hipStream_t stream) {
    static int grid = 0;
    if (grid == 0) {
        if (n_in != 33 || in_sizes[0] != T_TOK * DM || out_size != T_TOK * DM || ws_size < WS_END) {
            fprintf(stderr, "kernel_launch: unexpected problem (n_in %d, in0 %d, out %d, ws %zu < %zu)\n", n_in, n_in > 0 ? in_sizes[0] : -1, out_size, ws_size, (size_t)WS_END); grid = -1; return; }
        int dev = 0, cus = 0, per_cu = 0;
        if (hipGetDevice(&dev) != hipSuccess || hipDeviceGetAttribute(&cus, hipDeviceAttributeMultiprocessorCount, dev) != hipSuccess) { grid = -1; return; }
        if (hipFuncSetAttribute((const void*)fwd_megakernel, hipFuncAttributeMaxDynamicSharedMemorySize, LDS_BYTES) != hipSuccess) { fprintf(stderr, "kernel_launch: hipFuncSetAttribute failed\n"); grid = -1; return; }
        if (hipOccupancyMaxActiveBlocksPerMultiprocessor(&per_cu, (const void*)fwd_megakernel, NTHR, LDS_BYTES) != hipSuccess || per_cu < 1) { fprintf(stderr, "kernel_launch: occupancy query says %d blocks per CU\n", per_cu); (void)hipGetLastError(); grid = -1; return; }
        grid = cus;
        if (grid != 256) { fprintf(stderr, "kernel_launch: built for 256 CUs, device has %d\n", cus); grid = -1; return; }
    }
    if (grid < 0) return;
    if (hipMemsetAsync((char*)d_ws + WS_CTL, 0, CTL_BYTES, stream) != hipSuccess) { fprintf(stderr, "kernel_launch: memset failed\n"); return; }
    Args a{};
    for (int i = 0; i < 33; ++i) a.in[i] = (const float*)d_in[i];
    a.out = (float*)d_out; a.ws = (unsigned char*)d_ws;
    void* args[] = {&a};
    const hipError_t e = hipLaunchCooperativeKernel((const void*)fwd_megakernel, dim3(grid), dim3(NTHR), args, LDS_BYTES, stream);
    if (e != hipSuccess) fprintf(stderr, "kernel_launch: cooperative launch failed: %s\n", hipGetErrorString(e));
}
```

```cpp
#include <hip/hip_runtime.h>
#include <cstdio>
#include <cstdint>

#define LAS __attribute__((address_space(3)))
typedef unsigned short bf16_t;
typedef short bf16x8 __attribute__((ext_vector_type(8)));
typedef float f32x4 __attribute__((ext_vector_type(4)));
typedef float f32x2 __attribute__((ext_vector_type(2)));
typedef unsigned u32x4 __attribute__((ext_vector_type(4)));
typedef unsigned u32x2 __attribute__((ext_vector_type(2)));
typedef int i32x4 __attribute__((ext_vector_type(4)));

constexpr int T_TOK = 32768, DM = 1024, NBATCH = 4, SEQ = 8192, MEMR = 1024;
constexpr float RMS_EPS = 1e-6f;
constexpr int NWAVES = 8, NTHR = 512;

constexpr size_t MiB = 1u << 20;
constexpr size_t WS_CTL = 0, CTL_BYTES = 1 * MiB;
constexpr size_t WS_W_S5IN = 1 * MiB, WS_W_S5OUT = 3 * MiB, WS_W_GMIN = 7 * MiB, WS_W_GMOUT = 15 * MiB, WS_W_XA = 19 * MiB  ;
constexpr size_t WS_W_RT = 35 * MiB;
constexpr size_t WS_W_MOE = 36 * MiB;
constexpr size_t MOE_L_STRIDE = 96 * MiB, MOE_D_OFF = 64 * MiB;
constexpr size_t WS_MEMBF = 228 * MiB, WS_KV = 230 * MiB;
constexpr size_t WS_SMALL = 238 * MiB;
constexpr size_t SM_RINVMEM = 0, SM_RINVA = 64 * 1024, SM_RINVB = 256 * 1024, SM_WTS = 512 * 1024, SM_AB16 = 1024 * 1024, SM_MOESW = 1536 * 1024  , SM_GMSW = 1024 * 1024 + 32768  , SM_WSB = 1024 * 1024 + 65536  ;
constexpr size_t WS_PART = 240 * MiB, WS_LIST = 244 * MiB, WS_X = 248 * MiB, WS_SCR = 313 * MiB, WS_W_GMOUT_P = 569 * MiB  , WS_W_GMQ = 574 * MiB  , WS_END = 578 * MiB;
constexpr size_t SC_U = 0, SC_H2 = 64 * MiB, SC_Y = 128 * MiB, SC_S5A = 192 * MiB, SC_S5M = 204 * MiB;
constexpr size_t SC_P0 = 0, SC_G0 = 208 * MiB;
constexpr size_t WS_G1 = 1 * MiB, WS_P1 = WS_W_MOE + 32 * MiB;
constexpr size_t SC_XQ = 0  , SC_HB = 32 * MiB, SC_YS = 104 * MiB;
constexpr size_t SC_Z = 0;
constexpr int CW_BAR = 4096, CW_CNT = 16384  , CW_DBG = 20480, CW_DONE = 65536  ;

constexpr int LDS_BYTES = 155648;
constexpr int LDS_EXTRA = 131072;
constexpr int LX_MISC = LDS_BYTES - 256;
constexpr int LX_TAB = LDS_EXTRA;

#define GAS __attribute__((address_space(1)))
__device__ __forceinline__ u32x4 gld128(const void* p) { return *(const GAS u32x4*)p; }
__device__ __forceinline__ void gst128(void* p, u32x4 v) { *(GAS u32x4*)p = v; }
__device__ __forceinline__ void gst128_nt(void* p, u32x4 v) { __builtin_nontemporal_store(v, (GAS u32x4*)p); }
__device__ __forceinline__ f32x4 gldf4(const void* p) { return *(const GAS f32x4*)p; }
__device__ __forceinline__ float gldf(const float* p) { return *(const GAS float*)p; }
__device__ __forceinline__ void gstf(float* p, float v) { *(GAS float*)p = v; }
__device__ __forceinline__ unsigned cvt_pk_bf16(float lo, float hi) { unsigned r; asm volatile("v_cvt_pk_bf16_f32 %0, %1, %2" : "=v"(r) : "v"(lo), "v"(hi)); return r; }
__device__ __forceinline__ unsigned f2bf(float f) { unsigned u = __builtin_bit_cast(unsigned, f); return (u + 0x7fffu + ((u >> 16) & 1u)) >> 16; }
__device__ __forceinline__ float bf2f(unsigned h) { return __builtin_bit_cast(float, h << 16); }
__device__ __forceinline__ float bflo(unsigned w) { return __builtin_bit_cast(float, w << 16); }
__device__ __forceinline__ float bfhi(unsigned w) { return __builtin_bit_cast(float, w & 0xffff0000u); }
__device__ __forceinline__ float wave_sum(float v) {
#pragma unroll
    for (int o = 1; o < 64; o <<= 1) v += __shfl_xor(v, o);
    return v;
}
__device__ __forceinline__ int lane_id() { int l; asm volatile("v_mbcnt_lo_u32_b32 %0, -1, 0\n\tv_mbcnt_hi_u32_b32 %0, -1, %0" : "=v"(l)); return l; }
__device__ __forceinline__ float fast_rcp(float x) { return __builtin_amdgcn_rcpf(x); }
__device__ __forceinline__ float fast_exp2(float x) { return __builtin_amdgcn_exp2f(x); }
__device__ __forceinline__ float sigmoid_f(float g) { return fast_rcp(1.0f + fast_exp2(-1.4426950408889634f * g)); }
__device__ __forceinline__ float gelu_tanh(float x) {
    const float t = x * (-2.302208198f - 0.102943240f * (x * x));
    return x * fast_rcp(1.0f + fast_exp2(t));
}

#define XB_TMO      128
#define XB_XCNT(j)  (256  + 64 * (j))
#define XB_XSUB(j)  (1280 + 64 * (j))
#define XB_XGEN(j)  (2304 + 64 * (j))
#define XB_TOP      3328
#define XB_TOPGEN   3392
#define XCD_BAR_WORDS 3456
#define XB_SPIN_CAP (1u << 18)
__device__ __forceinline__ unsigned xb_ld(unsigned* p)              { return __hip_atomic_load(p, __ATOMIC_RELAXED, __HIP_MEMORY_SCOPE_AGENT); }
__device__ __forceinline__ unsigned xb_add(unsigned* p, unsigned v) { return __hip_atomic_fetch_add(p, v, __ATOMIC_RELAXED, __HIP_MEMORY_SCOPE_AGENT); }
__device__ __forceinline__ unsigned xb_xcc_id() { return (unsigned)__builtin_amdgcn_s_getreg((3 << 11) | 20) & 0xFu; }
#define XB_SPIN(cond, bar) do { unsigned _sp = 0; while (cond) { __builtin_amdgcn_s_sleep(1); \
    if ((++_sp & 255u) == 0u) { if (xb_ld(&(bar)[XB_TMO])) break; if (_sp > XB_SPIN_CAP) { atomicAdd(&(bar)[XB_TMO], 1u); break; } } } } while (0)
struct XcdBarrier { unsigned* bar; unsigned x; volatile LAS unsigned* st; };
__device__ __forceinline__ unsigned xcd_barrier_post(unsigned* bar, unsigned x, bool leader) {
    unsigned rank = 0u;
    if (leader) rank = xb_add(&bar[XB_XCNT(x)], 1u);
    return rank;
}
__device__ __forceinline__ void xcd_barrier_complete(unsigned* bar, unsigned x, unsigned& nloc, unsigned& nx, unsigned& regular) {
    const unsigned G = gridDim.x * gridDim.y * gridDim.z;
    unsigned sum, cnt, mine, bad, sp = 0u;
    for (;;) {
        sum = 0u; cnt = 0u; mine = 0u; bad = 0u;
#pragma unroll
        for (unsigned j = 0; j < 16; ++j) { const unsigned c = xb_ld(&bar[XB_XCNT(j)]); sum += c; cnt += (c > 0u) ? 1u : 0u; mine = (j == x) ? c : mine; bad += (c != 0u && c * 8u != G) ? 1u : 0u; }
        if (sum == G) break;
        __builtin_amdgcn_s_sleep(1);
        if ((++sp & 255u) == 0u) { if (xb_ld(&bar[XB_TMO])) break; if (sp > XB_SPIN_CAP) { atomicAdd(&bar[XB_TMO], 1u); break; } }
    }
    nloc = mine > 0u ? mine : 1u; nx = cnt > 0u ? cnt : 1u; regular = (sum == G && cnt == 8u && bad == 0u) ? 1u : 2u;
}
__device__ __forceinline__ void xcd_barrier(const XcdBarrier& b, bool leader) {
    asm volatile("s_waitcnt vmcnt(0)" ::: "memory");
    __syncthreads();
    if (leader) {
        unsigned* bar = b.bar;
        __builtin_amdgcn_s_waitcnt(0);
        unsigned nloc = b.st[0], nx = b.st[1];
        if (nloc == 0u) { unsigned reg; xcd_barrier_complete(bar, b.x, nloc, nx, reg); b.st[0] = nloc; b.st[1] = nx; b.st[2] = reg; }
        const unsigned old = xb_add(&bar[XB_XSUB(b.x)], 1u);
        const unsigned gen = old / nloc;
        if (old + 1u == (gen + 1u) * nloc) {
            __builtin_amdgcn_fence(__ATOMIC_RELEASE, "agent");
            asm volatile("s_waitcnt vmcnt(0)" ::: "memory");
            const unsigned og = xb_add(&bar[XB_TOP], 1u);
            const unsigned tg = og / nx;
            if (og + 1u == (tg + 1u) * nx) xb_add(&bar[XB_TOPGEN], 1u);
            else XB_SPIN(xb_ld(&bar[XB_TOPGEN]) == tg, bar);
            __builtin_amdgcn_fence(__ATOMIC_ACQUIRE, "agent");
            asm volatile("s_waitcnt vmcnt(0)" ::: "memory");
        } else {
            XB_SPIN(xb_ld(&bar[XB_TOPGEN]) == gen, bar);
            __builtin_amdgcn_fence(__ATOMIC_ACQUIRE, "agent");
            asm volatile("s_waitcnt vmcnt(0)" ::: "memory");
        }
    }
    __syncthreads();
}

#define XL_SUB(j) (4096 + 64 * (j))
#define XL_GEN(j) (5120 + 64 * (j))
__device__ __forceinline__ void xcc_local_barrier(unsigned* bar, unsigned x, unsigned nloc, bool leader) {
    asm volatile("s_waitcnt vmcnt(0)" ::: "memory");
    __syncthreads();
    if (leader) {
        __builtin_amdgcn_s_waitcnt(0);
        const unsigned old = xb_add(&bar[XL_SUB(x)], 1u);
        const unsigned gen = old / nloc;
        if (old + 1u == (gen + 1u) * nloc) xb_add(&bar[XL_GEN(x)], 1u);
        else XB_SPIN(xb_ld(&bar[XL_GEN(x)]) == gen, bar);
        __builtin_amdgcn_fence(__ATOMIC_ACQUIRE, "agent");
        asm volatile("s_waitcnt vmcnt(0)" ::: "memory");
    }
    __syncthreads();
}

namespace g8 {
constexpr int BM = 256, BK = 64, HALF = 128, HTB = HALF * BK * 2, STAGE_BYTES = 8 * HTB, NXCD = 8, WGM = 8;
__host__ __device__ __forceinline__ int lds_byte(int r, int c) { const int st = (r >> 4) * 2 + (c >> 5), rr = r & 15, cc = c & 31, ob = rr * 64 + cc * 2; return st * 1024 + (ob ^ (((ob >> 9) & 1) << 5)); }
__host__ __device__ __forceinline__ void stage_rc(int b, int& R, int& C) { const int st = b / 1024, sb = b % 1024, swz = sb ^ (((sb >> 9) & 1) << 5); R = (st >> 1) * 16 + swz / 64; C = (st & 1) * 32 + (swz % 64) / 2; }
__host__ __device__ __forceinline__ int perm32(int rho) { const int n = rho >> 4, i = rho & 15; return 8 * (i >> 2) + 4 * n + (i & 3); }

struct Unit {
    unsigned A;
    unsigned A2;
    unsigned B;
    int pm, pn;
    int slot;
    int aux;
};
struct Cfg { int lda, ldb, kstepA, kstepB, nt, asplit; };

__device__ __forceinline__ bool static_order(int i, int G, int c, int nM, int nN, int& pm, int& pn) {
    const int nwg = nM * nN; const int L = i * G + c; if (L >= nwg) return false;
    int wgid = L; { const int q = nwg / NXCD, r = nwg % NXCD, xcd = wgid % NXCD, off = wgid / NXCD; wgid = (xcd < r ? xcd * (q + 1) : r * (q + 1) + (xcd - r) * q) + off; }
    const int nig = WGM * nN, gid = wgid / nig, fm = gid * WGM, gsz = (nM - fm) < WGM ? (nM - fm) : WGM;
    pm = fm + ((wgid % nig) % gsz); pn = (wgid % nig) / gsz; return true;
}
template <int NM, int NN, unsigned TSA, unsigned TSB>
struct StdSched {
    unsigned A, B; int G, c;
    __device__ __forceinline__ bool next(int i, Unit& u) const {
        int pm, pn; if (!static_order(i, G, c, NM, NN, pm, pn)) return false;
        u.A = A + (unsigned)pm * TSA; u.A2 = u.A; u.B = B + (unsigned)pn * TSB; u.pm = pm; u.pn = pn; u.slot = i; u.aux = 0; return true;
    }
    __device__ __forceinline__ void a_ready(const Unit&, int, int) const {}
};

template <class Epi, class Sched, int MODE, int LDA, int LDB, int KSA, int KSB, int NT, int ASPLIT>
__device__ __forceinline__ void gemm_phase(LAS unsigned char* lds, const char* wsb, const Sched& S, const Epi& E, const LAS int* tok_lds, int tid_in, unsigned long long* pts = nullptr) {
    constexpr Cfg cfg{LDA, LDB, KSA, KSB, NT, ASPLIT};
    int tid_ = tid_in; asm volatile("" : "+v"(tid_));
    const int tid = tid_, wid = __builtin_amdgcn_readfirstlane(tid >> 6), lane = tid & 63, wr = wid >> 2, wc = wid & 3, fr = lane & 15, fq = lane >> 4;
    constexpr int nt = NT;
    constexpr bool GATHER = (MODE & 1) != 0, TOKA = (MODE & 2) != 0, ZTILE = (MODE & 4) != 0, SPLIT = (MODE & 10) != 0, PLANE = (MODE & 16) != 0;
    int RA[2], CA[2]; unsigned voffA[2], voffB[2];
#pragma unroll
    for (int i = 0; i < 2; ++i) { int R, C; stage_rc(tid * 16 + i * 8192, R, C); const int Rb = Epi::PERM ? ((R & ~31) + perm32(R & 31)) : R;
        RA[i] = R; CA[i] = C;
        const unsigned acol = TOKA ? (unsigned)((C >> 4) * 2048 + (C & 15) * 2) : (PLANE ? (unsigned)((C >> 4) * 1048576 + (C & 15) * 2) : (unsigned)(C * 2));
        voffA[i] = (unsigned)R * (unsigned)cfg.lda + acol; voffB[i] = (unsigned)Rb * (unsigned)cfg.ldb + (unsigned)(C * 2); }
    constexpr unsigned kstepA = (unsigned)KSA, kstepB = (unsigned)KSB;
    constexpr unsigned hstepA = ZTILE ? 1048576u : (unsigned)HALF * (unsigned)LDA, hstepB = (unsigned)HALF * (unsigned)LDB;
    const unsigned ldsw = (unsigned)wid * 1024u;
    const int aoff = lds_byte(wr * 64 + fr, fq * 8), boff = lds_byte(wc * 32 + fr, fq * 8);
    unsigned gc00 = 0, gc01 = 0, gc10 = 0, gc11 = 0, gn00 = 0, gn01 = 0, gn10 = 0, gn11 = 0;
#define G8_SA(b, h) (((b) * 2 + (h)) * HTB)
#define G8_SB(b, h) ((4 + (b) * 2 + (h)) * HTB)
#define G8_GLDS(off32, ldsoff) __builtin_amdgcn_global_load_lds((const unsigned*)(wsb + (size_t)(unsigned)(off32)), (LAS unsigned*)(lds + (ldsoff)), 16, 0, 0)
#define G8_STAGE_B(bufoff, ub) do { G8_GLDS((ub) + voffB[0], (bufoff) + ldsw); G8_GLDS((ub) + voffB[1], (bufoff) + ldsw + 8192); } while (0)
#define G8_STAGE_A(bufoff, ua, h, o0, o1) do { if (GATHER) { G8_GLDS((ua) + (o0), (bufoff) + ldsw); G8_GLDS((ua) + (o1), (bufoff) + ldsw + 8192); } \
        else { G8_GLDS((ua) + (unsigned)(h) * hstepA + voffA[0], (bufoff) + ldsw); G8_GLDS((ua) + (unsigned)(h) * hstepA + voffA[1], (bufoff) + ldsw + 8192); } } while (0)
#define G8_LDA(dst, b, h) do { _Pragma("unroll") for (int m = 0; m < 4; ++m) _Pragma("unroll") for (int k = 0; k < 2; ++k) dst[m][k] = *(const LAS bf16x8*)(lds + G8_SA(b, h) + aoff + m * 2048 + k * 1024); } while (0)
#define G8_LDB(dst, b, h) do { _Pragma("unroll") for (int n = 0; n < 2; ++n) _Pragma("unroll") for (int k = 0; k < 2; ++k) dst[n][k] = *(const LAS bf16x8*)(lds + G8_SB(b, h) + boff + n * 2048 + k * 1024); } while (0)
#define G8_MMA(ai, bj, At, Bt) do { __builtin_amdgcn_s_setprio(1); _Pragma("unroll") for (int m = 0; m < 4; ++m) _Pragma("unroll") for (int n = 0; n < 2; ++n) _Pragma("unroll") for (int k = 0; k < 2; ++k) \
        { if constexpr (Epi::I8) acc[ai][bj][m][n] = __builtin_bit_cast(f32x4, __builtin_amdgcn_mfma_i32_16x16x64_i8(__builtin_bit_cast(i32x4, Bt[n][k]), __builtin_bit_cast(i32x4, At[m][k]), __builtin_bit_cast(i32x4, acc[ai][bj][m][n]), 0, 0, 0)); \
          else acc[ai][bj][m][n] = __builtin_amdgcn_mfma_f32_16x16x32_bf16(Bt[n][k], At[m][k], acc[ai][bj][m][n], 0, 0, 0); } __builtin_amdgcn_s_setprio(0); } while (0)
#define G8_WAIT_V(n) asm volatile("s_waitcnt vmcnt(" #n ")" ::: "memory")
#define G8_WAIT_L(n) asm volatile("s_waitcnt lgkmcnt(" #n ")" ::: "memory")
#define G8_BAR __builtin_amdgcn_s_barrier()
#define G8_SCHED __builtin_amdgcn_sched_barrier(0)
#define G8_APTR(u, kt) (ZTILE ? (u).A + (unsigned)((kt) >> 2) * 65536u + (unsigned)((kt) & 3) * 128u : ((SPLIT && (kt) >= cfg.asplit) ? (u).A2 + (unsigned)((kt) - cfg.asplit) * kstepA : (u).A + (unsigned)(kt) * kstepA))
#define G8_GOFF(u, d00, d01, d10, d11) do { if (GATHER) { const LAS int* _t = tok_lds + (u).slot * 256; \
        d00 = (unsigned)_t[RA[0]] * (unsigned)cfg.lda + (unsigned)(CA[0] * 2); d01 = (unsigned)_t[RA[1]] * (unsigned)cfg.lda + (unsigned)(CA[1] * 2); \
        d10 = (unsigned)_t[128 + RA[0]] * (unsigned)cfg.lda + (unsigned)(CA[0] * 2); d11 = (unsigned)_t[128 + RA[1]] * (unsigned)cfg.lda + (unsigned)(CA[1] * 2); } } while (0)
    Unit cur, nxt; int ui = 0;
    if (!S.next(0, cur)) return;
    f32x4 acc[2][2][4][2];
#pragma unroll
    for (int a = 0; a < 2; ++a)
#pragma unroll
        for (int b = 0; b < 2; ++b)
#pragma unroll
            for (int m = 0; m < 4; ++m)
#pragma unroll
                for (int n = 0; n < 2; ++n) acc[a][b][m][n] = (f32x4){0.f, 0.f, 0.f, 0.f};
    bf16x8 At[4][2], B0[2][2], B1[2][2];
    S.a_ready(cur, wid, lane);
    G8_GOFF(cur, gc00, gc01, gc10, gc11);
    {
        const unsigned cA0 = G8_APTR(cur, 0), cA1 = G8_APTR(cur, 1), cB = cur.B;
        G8_STAGE_B(G8_SB(0, 0), cB); G8_STAGE_B(G8_SB(0, 1), cB + hstepB); G8_STAGE_A(G8_SA(0, 0), cA0, 0, gc00, gc01); G8_STAGE_A(G8_SA(0, 1), cA0, 1, gc10, gc11);
        if (wr == 1) G8_BAR;
        G8_WAIT_V(2); G8_BAR;
        G8_STAGE_B(G8_SB(1, 0), cB + kstepB); G8_STAGE_A(G8_SA(1, 0), cA1, 0, gc00, gc01); G8_STAGE_B(G8_SB(1, 1), cB + hstepB + kstepB);
        G8_WAIT_V(6); G8_BAR;
    }
#define G8_PSTAMP(k) do { if (pts && blockIdx.x == 0 && wid == 0 && lane == 0 && ui == 0) pts[k] = __builtin_amdgcn_s_memrealtime(); } while (0)
    for (;;) {
        G8_PSTAMP(0);
        const bool has_next = S.next(ui + 1, nxt);
        if (!has_next) nxt = cur;
#pragma unroll 1
        for (int t = 0; t < nt; t += 2) {
            const bool last = (t == nt - 2);
            const unsigned a1 = G8_APTR(cur, t + 1);
            const unsigned a2 = last ? G8_APTR(nxt, 0) : G8_APTR(cur, t + 2), b2 = last ? nxt.B : cur.B + (unsigned)(t + 2) * kstepB;
            const unsigned a3 = last ? G8_APTR(nxt, 1) : G8_APTR(cur, t + 3), b3 = b2 + kstepB;
            if (last && has_next) S.a_ready(nxt, wid, lane);
            if (GATHER && last) { if (has_next) { G8_GOFF(nxt, gn00, gn01, gn10, gn11); } else { gn00 = gc00; gn01 = gc01; gn10 = gc10; gn11 = gc11; } }
            const unsigned s00 = last ? gn00 : gc00, s01 = last ? gn01 : gc01, s10 = last ? gn10 : gc10, s11 = last ? gn11 : gc11;
            G8_LDB(B0, 0, 0); G8_LDB(B1, 0, 1); G8_SCHED; G8_LDA(At, 0, 0); G8_STAGE_A(G8_SA(1, 1), a1, 1, gc10, gc11);
            G8_WAIT_V(8); G8_WAIT_L(0); G8_BAR; G8_MMA(0, 0, At, B0); G8_MMA(0, 1, At, B1); G8_BAR; G8_SCHED;
            G8_LDA(At, 0, 1); G8_STAGE_B(G8_SB(0, 0), b2); G8_STAGE_B(G8_SB(0, 1), b2 + hstepB); G8_STAGE_A(G8_SA(0, 0), a2, 0, s00, s01);
            G8_WAIT_V(8); G8_WAIT_L(0); G8_BAR; G8_MMA(1, 0, At, B0); G8_MMA(1, 1, At, B1); G8_BAR; G8_SCHED;
            G8_LDB(B0, 1, 0); G8_LDB(B1, 1, 1); G8_SCHED; G8_LDA(At, 1, 0); G8_STAGE_A(G8_SA(0, 1), a2, 1, s10, s11);
            G8_WAIT_V(8); G8_WAIT_L(0); G8_BAR; G8_MMA(0, 0, At, B0); G8_MMA(0, 1, At, B1); G8_BAR; G8_SCHED;
            G8_LDA(At, 1, 1); G8_STAGE_B(G8_SB(1, 0), b3); G8_STAGE_B(G8_SB(1, 1), b3 + hstepB); G8_STAGE_A(G8_SA(1, 0), a3, 0, s00, s01);
            G8_WAIT_V(8); G8_WAIT_L(0); G8_BAR; G8_MMA(1, 0, At, B0); G8_MMA(1, 1, At, B1); G8_BAR; G8_SCHED;
        }
        G8_PSTAMP(1);
        if (Epi::ALIGN && wr == 0) G8_BAR;
        G8_PSTAMP(2);
        if constexpr (!Epi::AFTER_DRAIN) { int efr = fr, efq = fq; asm volatile("" : "+v"(efr), "+v"(efq));
            E(acc, cur, wr, wc, efr, efq); }
        G8_PSTAMP(3);
        if (!has_next) break;
#pragma unroll
        for (int a = 0; a < 2; ++a)
#pragma unroll
            for (int b = 0; b < 2; ++b)
#pragma unroll
                for (int m = 0; m < 4; ++m)
#pragma unroll
                    for (int n = 0; n < 2; ++n) acc[a][b][m][n] = (f32x4){0.f, 0.f, 0.f, 0.f};
        cur = nxt; ++ui; gc00 = gn00; gc01 = gn01; gc10 = gn10; gc11 = gn11;
        if (Epi::ALIGN && wr == 1) G8_BAR;
    }
    G8_WAIT_V(0);
    if (!Epi::ALIGN && wr == 0) G8_BAR;
    G8_BAR;
    if constexpr (Epi::AFTER_DRAIN) { E.fused(acc, cur, wr, wc, fr, fq, lds, wid, lane); }
#undef G8_SA
#undef G8_SB
#undef G8_GLDS
#undef G8_STAGE_A
#undef G8_STAGE_B
#undef G8_LDA
#undef G8_LDB
#undef G8_MMA
#undef G8_WAIT_V
#undef G8_WAIT_L
#undef G8_BAR
#undef G8_SCHED
#undef G8_APTR
#undef G8_GOFF
#undef G8_PSTAMP
}
}
#ifndef EPI_ALIGN_DEFAULT
#define EPI_ALIGN_DEFAULT true
#endif
namespace g8 {
typedef const f32x4 (&AccRef)[2][2][4][2];

struct EpiRowScale {
    static constexpr bool PERM = true, AFTER_DRAIN = false, ALIGN = EPI_ALIGN_DEFAULT, I8 = false;
    bf16_t* O; int ldc; const LAS float* rs_lds;
    __device__ __forceinline__ void operator()(AccRef acc, const Unit& u, int wr, int wc, int fr, int fq) const {
        const int r0 = wr * 64 + fr; const int col0 = u.pn * BM + wc * 32 + 8 * fq;
#pragma unroll
        for (int ai = 0; ai < 2; ++ai)
#pragma unroll
            for (int m = 0; m < 4; ++m) { const int r = r0 + ai * HALF + m * 16; const float s = rs_lds[u.slot * 256 + r];
                bf16_t* rowp = O + (size_t)(u.pm * BM + r) * ldc + col0;
#pragma unroll
                for (int bj = 0; bj < 2; ++bj) { const f32x4 v0 = acc[ai][bj][m][0] * s, v1 = acc[ai][bj][m][1] * s;
                    u32x4 w; w.x = cvt_pk_bf16(v0[0], v0[1]); w.y = cvt_pk_bf16(v0[2], v0[3]); w.z = cvt_pk_bf16(v1[0], v1[1]); w.w = cvt_pk_bf16(v1[2], v1[3]);
                    gst128(rowp + bj * HALF, w); } }
    }
};
struct EpiU {
    static constexpr bool PERM = true, AFTER_DRAIN = false, ALIGN = EPI_ALIGN_DEFAULT, I8 = false;
    bf16_t* U2; const LAS float* rs_lds;
    __device__ __forceinline__ void operator()(AccRef acc, const Unit& u, int wr, int wc, int fr, int fq) const {
        const int r0 = wr * 64 + fr; const int col0 = u.pn * BM + wc * 32 + 8 * fq;
#pragma unroll
        for (int ai = 0; ai < 2; ++ai)
#pragma unroll
            for (int m = 0; m < 4; ++m) { const int r = r0 + ai * HALF + m * 16; const float s = rs_lds[u.slot * 256 + r]; const size_t row = (size_t)(u.pm * BM + r);
#pragma unroll
                for (int bj = 0; bj < 2; ++bj) { const int col = col0 + bj * HALF; const f32x4 v0 = acc[ai][bj][m][0] * s, v1 = acc[ai][bj][m][1] * s;
                    u32x4 w; w.x = cvt_pk_bf16(v0[0], v0[1]); w.y = cvt_pk_bf16(v0[2], v0[3]); w.z = cvt_pk_bf16(v1[0], v1[1]); w.w = cvt_pk_bf16(v1[2], v1[3]);
                    gst128(U2 + ((size_t)(col >> 4) * T_TOK + row) * 16 + (col & 15), w); } }
    }
};
struct EpiGmIn {
    static constexpr bool PERM = true, AFTER_DRAIN = false, ALIGN = EPI_ALIGN_DEFAULT, I8 = true;
    bf16_t* O; const LAS float* rs_lds; float* part; const float* sw;
    __device__ __forceinline__ void operator()(AccRef acc, const Unit& u, int wr, int wc, int fr, int fq) const {
        const int r0 = wr * 64 + fr; const int col0 = wc * 32 + 8 * fq;
        f32x4 cs[2][2];
#pragma unroll
        for (int bj = 0; bj < 2; ++bj)
#pragma unroll
            for (int n = 0; n < 2; ++n) cs[bj][n] = gldf4(sw + u.pn * BM + bj * HALF + col0 + 4 * n);
#pragma unroll
        for (int ai = 0; ai < 2; ++ai)
#pragma unroll
            for (int m = 0; m < 4; ++m) { const int rr = r0 + m * 16; const int r = rr + ai * HALF; const float s = rs_lds[u.slot * 256 + r];
                bf16_t* rowp = O + ((size_t)((u.pm * 2 + ai) * 16 + u.pn) * 128 + rr) * 256 + col0; float q = 0.f;
#pragma unroll
                for (int bj = 0; bj < 2; ++bj) { const i32x4 i0 = __builtin_bit_cast(i32x4, acc[ai][bj][m][0]), i1 = __builtin_bit_cast(i32x4, acc[ai][bj][m][1]);
                    f32x4 v0, v1;
#pragma unroll
                    for (int j = 0; j < 4; ++j) { v0[j] = gelu_tanh((float)i0[j] * s * cs[bj][0][j]); v1[j] = gelu_tanh((float)i1[j] * s * cs[bj][1][j]); }
                    u32x4 w; w.x = cvt_pk_bf16(v0[0], v0[1]); w.y = cvt_pk_bf16(v0[2], v0[3]); w.z = cvt_pk_bf16(v1[0], v1[1]); w.w = cvt_pk_bf16(v1[2], v1[3]);
                    gst128_nt(rowp + bj * HALF, w);
                    if (u.pn >= 8) q += bflo(w.x) * bflo(w.x) + bfhi(w.x) * bfhi(w.x) + bflo(w.y) * bflo(w.y) + bfhi(w.y) * bfhi(w.y) + bflo(w.z) * bflo(w.z) + bfhi(w.z) * bfhi(w.z) + bflo(w.w) * bflo(w.w) + bfhi(w.w) * bfhi(w.w); }
                if (u.pn >= 8) { q += __shfl_xor(q, 16); q += __shfl_xor(q, 32);
                    if (fq == 0) gstf(part + ((size_t)(u.pm * BM + r) * 32 + (u.pn - 8) * 4 + wc), q); } }
    }
};
struct EpiKV {
    static constexpr bool PERM = true, AFTER_DRAIN = false, ALIGN = EPI_ALIGN_DEFAULT, I8 = false;
    bf16_t* O0; const float* rinv_mem;
    __device__ __forceinline__ void operator()(AccRef acc, const Unit& u, int wr, int wc, int fr, int fq) const {
        const int r0 = wr * 64 + fr; const int col0 = u.pn * BM + wc * 32 + 8 * fq; bf16_t* Ob = O0 + (size_t)u.aux * 2097152;
#pragma unroll
        for (int ai = 0; ai < 2; ++ai)
#pragma unroll
            for (int m = 0; m < 4; ++m) { const int row = u.pm * BM + r0 + ai * HALF + m * 16; const float s = gldf(rinv_mem + row);
                bf16_t* rowp = Ob + (size_t)row * 2048 + col0;
#pragma unroll
                for (int bj = 0; bj < 2; ++bj) { const f32x4 v0 = acc[ai][bj][m][0] * s, v1 = acc[ai][bj][m][1] * s;
                    u32x4 w; w.x = cvt_pk_bf16(v0[0], v0[1]); w.y = cvt_pk_bf16(v0[2], v0[3]); w.z = cvt_pk_bf16(v1[0], v1[1]); w.w = cvt_pk_bf16(v1[2], v1[3]);
                    gst128(rowp + bj * HALF, w); } }
    }
};
struct EpiGluRes {
    static constexpr bool PERM = true, AFTER_DRAIN = false, ALIGN = EPI_ALIGN_DEFAULT, I8 = false;
    bf16_t* X; float* part;
    __device__ __forceinline__ void operator()(AccRef acc, const Unit& u, int wr, int wc, int fr, int fq) const {
        const int r0 = wr * 64 + fr; const int col0 = u.pn * HALF + wc * 32 + 8 * fq;
        u32x4 xo[2][4];
#pragma unroll
        for (int ai = 0; ai < 2; ++ai)
#pragma unroll
            for (int m = 0; m < 4; ++m) xo[ai][m] = gld128(X + (size_t)(u.pm * BM + r0 + ai * HALF + m * 16) * 1024 + col0);
#pragma unroll
        for (int ai = 0; ai < 2; ++ai)
#pragma unroll
            for (int m = 0; m < 4; ++m) { const int row = u.pm * BM + r0 + ai * HALF + m * 16;
                bf16_t* xp = X + (size_t)row * 1024 + col0; const u32x4 xv = xo[ai][m];
                f32x4 v0 = acc[ai][0][m][0], v1 = acc[ai][0][m][1]; const f32x4 g0 = acc[ai][1][m][0], g1 = acc[ai][1][m][1];
#pragma unroll
                for (int j = 0; j < 4; ++j) { v0[j] *= sigmoid_f(g0[j]); v1[j] *= sigmoid_f(g1[j]); }
                u32x4 w; w.x = cvt_pk_bf16(v0[0] + bflo(xv.x), v0[1] + bfhi(xv.x)); w.y = cvt_pk_bf16(v0[2] + bflo(xv.y), v0[3] + bfhi(xv.y));
                w.z = cvt_pk_bf16(v1[0] + bflo(xv.z), v1[1] + bfhi(xv.z)); w.w = cvt_pk_bf16(v1[2] + bflo(xv.w), v1[3] + bfhi(xv.w));
                gst128(xp, w);
                float q = bflo(w.x) * bflo(w.x) + bfhi(w.x) * bfhi(w.x) + bflo(w.y) * bflo(w.y) + bfhi(w.y) * bfhi(w.y) + bflo(w.z) * bflo(w.z) + bfhi(w.z) * bfhi(w.z) + bflo(w.w) * bflo(w.w) + bfhi(w.w) * bfhi(w.w);
                q += __shfl_xor(q, 16); q += __shfl_xor(q, 32);
                if (fq == 0) gstf(part + ((size_t)row * 32 + u.pn * 4 + wc), q); }
    }
};
template <bool PART> struct EpiRes {
    static constexpr bool PERM = true, AFTER_DRAIN = false, ALIGN = EPI_ALIGN_DEFAULT, I8 = false;
    bf16_t* X; float* part;
    __device__ __forceinline__ void operator()(AccRef acc, const Unit& u, int wr, int wc, int fr, int fq) const {
        const int r0 = wr * 64 + fr; const int col0 = u.pn * BM + wc * 32 + 8 * fq;
        u32x4 xo[2][4][2];
#pragma unroll
        for (int ai = 0; ai < 2; ++ai)
#pragma unroll
            for (int m = 0; m < 4; ++m)
#pragma unroll
                for (int bj = 0; bj < 2; ++bj) xo[ai][m][bj] = gld128(X + (size_t)(u.pm * BM + r0 + ai * HALF + m * 16) * 1024 + col0 + bj * HALF);
#pragma unroll
        for (int ai = 0; ai < 2; ++ai)
#pragma unroll
            for (int m = 0; m < 4; ++m) { const int row = u.pm * BM + r0 + ai * HALF + m * 16; float q = 0.f;
#pragma unroll
                for (int bj = 0; bj < 2; ++bj) { bf16_t* xp = X + (size_t)row * 1024 + col0 + bj * HALF; const u32x4 xv = xo[ai][m][bj];
                    const f32x4 v0 = acc[ai][bj][m][0], v1 = acc[ai][bj][m][1];
                    u32x4 w; w.x = cvt_pk_bf16(v0[0] + bflo(xv.x), v0[1] + bfhi(xv.x)); w.y = cvt_pk_bf16(v0[2] + bflo(xv.y), v0[3] + bfhi(xv.y));
                    w.z = cvt_pk_bf16(v1[0] + bflo(xv.z), v1[1] + bfhi(xv.z)); w.w = cvt_pk_bf16(v1[2] + bflo(xv.w), v1[3] + bfhi(xv.w));
                    gst128(xp, w);
                    if (PART) q += bflo(w.x) * bflo(w.x) + bfhi(w.x) * bfhi(w.x) + bflo(w.y) * bflo(w.y) + bfhi(w.y) * bfhi(w.y) + bflo(w.z) * bflo(w.z) + bfhi(w.z) * bfhi(w.z) + bflo(w.w) * bflo(w.w) + bfhi(w.w) * bfhi(w.w); }
                if (PART) { q += __shfl_xor(q, 16); q += __shfl_xor(q, 32); if (fq == 0) gstf(part + ((size_t)row * 32 + u.pn * 4 + wc), q); } }
    }
};
struct EpiS5B {
    static constexpr bool PERM = true, AFTER_DRAIN = false, ALIGN = EPI_ALIGN_DEFAULT, I8 = false;
    bf16_t* Y;
    __device__ __forceinline__ void operator()(AccRef acc, const Unit& u, int wr, int wc, int fr, int fq) const {
        const int r0 = wr * 64 + fr; const int g = u.aux;
#pragma unroll
        for (int ai = 0; ai < 2; ++ai)
#pragma unroll
            for (int m = 0; m < 4; ++m) { const int blk = u.pm * BM + r0 + ai * HALF + m * 16;
#pragma unroll
                for (int bj = 0; bj < 2; ++bj) { const int c = bj * HALF + wc * 32 + 8 * fq; const int tl = c >> 4, ch = c & 15;
                    f32x4 v0 = acc[ai][bj][m][0], v1 = acc[ai][bj][m][1];
#pragma unroll
                    for (int j = 0; j < 4; ++j) { v0[j] = gelu_tanh(v0[j]); v1[j] = gelu_tanh(v1[j]); }
                    u32x4 w; w.x = cvt_pk_bf16(v0[0], v0[1]); w.y = cvt_pk_bf16(v0[2], v0[3]); w.z = cvt_pk_bf16(v1[0], v1[1]); w.w = cvt_pk_bf16(v1[2], v1[3]);
                    gst128(Y + ((size_t)g * T_TOK + (size_t)blk * 16 + tl) * 16 + ch, w); } }
    }
};
struct EpiSoftmax {
    static constexpr bool PERM = true, AFTER_DRAIN = false, ALIGN = true, I8 = false;
    bf16_t* P; const LAS float* rs_lds; LAS float* tab;
    __device__ __forceinline__ void operator()(AccRef acc_in, const Unit& u, int wr, int wc, int fr, int fq) const {
        LAS float* RM = tab;
        LAS float* RS = tab + 1024;
        const int r0 = wr * 64 + fr;
        float mx[2][4], sc[2][4];
#pragma unroll
        for (int ai = 0; ai < 2; ++ai)
#pragma unroll
            for (int m = 0; m < 4; ++m) { float v = -3.0e38f; const float s = rs_lds[u.slot * 256 + r0 + ai * HALF + m * 16] * 1.4426950408889634f; sc[ai][m] = s;
#pragma unroll
                for (int bj = 0; bj < 2; ++bj)
#pragma unroll
                    for (int n = 0; n < 2; ++n) { const f32x4 x = acc_in[ai][bj][m][n]; v = fmaxf(v, fmaxf(fmaxf(x[0], x[1]), fmaxf(x[2], x[3]))); }
                v = fmaxf(v, __shfl_xor(v, 16)); v = fmaxf(v, __shfl_xor(v, 32));
                if (fq == 0) RM[(r0 + ai * HALF + m * 16) * 4 + wc] = v; }
        asm volatile("s_waitcnt lgkmcnt(0)" ::: "memory"); __builtin_amdgcn_s_barrier(); asm volatile("" ::: "memory");
#pragma unroll
        for (int ai = 0; ai < 2; ++ai)
#pragma unroll
            for (int m = 0; m < 4; ++m) { const f32x4 t = *(const LAS f32x4*)(RM + (r0 + ai * HALF + m * 16) * 4); mx[ai][m] = fmaxf(fmaxf(t[0], t[1]), fmaxf(t[2], t[3])) * sc[ai][m]; }
#pragma unroll
        for (int ai = 0; ai < 2; ++ai)
#pragma unroll
            for (int m = 0; m < 4; ++m) { float s = 0.f; const float mm = mx[ai][m], ss = sc[ai][m];
#pragma unroll
                for (int bj = 0; bj < 2; ++bj)
#pragma unroll
                    for (int n = 0; n < 2; ++n) { const f32x4 x = acc_in[ai][bj][m][n];
#pragma unroll
                        for (int j = 0; j < 4; ++j) s += fast_exp2(x[j] * ss - mm); }
                s += __shfl_xor(s, 16); s += __shfl_xor(s, 32);
                if (fq == 0) RS[(r0 + ai * HALF + m * 16) * 4 + wc] = s; }
        asm volatile("s_waitcnt lgkmcnt(0)" ::: "memory"); __builtin_amdgcn_s_barrier(); asm volatile("" ::: "memory");
#pragma unroll
        for (int ai = 0; ai < 2; ++ai)
#pragma unroll
            for (int m = 0; m < 4; ++m) { const int r = r0 + ai * HALF + m * 16; const f32x4 t = *(const LAS f32x4*)(RS + r * 4); const float inv = 1.0f / ((t[0] + t[1]) + (t[2] + t[3])); const float mm = mx[ai][m], ss = sc[ai][m];
                bf16_t* rowp = P + (size_t)(u.pm * BM + r) * 1024 + u.pn * BM + wc * 32 + 8 * fq;
#pragma unroll
                for (int bj = 0; bj < 2; ++bj) { f32x4 v0 = acc_in[ai][bj][m][0], v1 = acc_in[ai][bj][m][1];
#pragma unroll
                    for (int j = 0; j < 4; ++j) { v0[j] = fast_exp2(v0[j] * ss - mm) * inv; v1[j] = fast_exp2(v1[j] * ss - mm) * inv; }
                    u32x4 w; w.x = cvt_pk_bf16(v0[0], v0[1]); w.y = cvt_pk_bf16(v0[2], v0[3]); w.z = cvt_pk_bf16(v1[0], v1[1]); w.w = cvt_pk_bf16(v1[2], v1[3]);
                    gst128(rowp + bj * HALF, w); } }
        asm volatile("s_waitcnt lgkmcnt(0)" ::: "memory"); __builtin_amdgcn_s_barrier(); asm volatile("" ::: "memory");
    }
};
struct EpiStore {
    static constexpr bool PERM = true, AFTER_DRAIN = false, ALIGN = EPI_ALIGN_DEFAULT, I8 = false;
    bf16_t* O; int ldc;
    __device__ __forceinline__ void operator()(AccRef acc, const Unit& u, int wr, int wc, int fr, int fq) const {
        const int r0 = wr * 64 + fr; const int col0 = u.pn * BM + wc * 32 + 8 * fq;
#pragma unroll
        for (int ai = 0; ai < 2; ++ai)
#pragma unroll
            for (int m = 0; m < 4; ++m) { bf16_t* rowp = O + (size_t)(u.pm * BM + r0 + ai * HALF + m * 16) * ldc + col0;
#pragma unroll
                for (int bj = 0; bj < 2; ++bj) { const f32x4 v0 = acc[ai][bj][m][0], v1 = acc[ai][bj][m][1];
                    u32x4 w; w.x = cvt_pk_bf16(v0[0], v0[1]); w.y = cvt_pk_bf16(v0[2], v0[3]); w.z = cvt_pk_bf16(v1[0], v1[1]); w.w = cvt_pk_bf16(v1[2], v1[3]);
                    gst128(rowp + bj * HALF, w); } }
    }
};
struct EpiMoeUp {
    static constexpr bool PERM = true, AFTER_DRAIN = false, ALIGN = EPI_ALIGN_DEFAULT, I8 = true;
    __amdgpu_buffer_rsrc_t hrs; const LAS float* rs_lds; const LAS float* wt_lds; unsigned* done; const float* sw;
    __device__ __forceinline__ void operator()(AccRef acc, const Unit& u, int wr, int wc, int fr, int fq) const {
        const int r0 = wr * 64 + fr; const int col0 = u.pn * HALF + wc * 32 + 8 * fq;
        const float* swe = sw + (u.aux & 255) * 1024 + u.pn * BM + wc * 32 + 8 * fq;
        const f32x4 sg0 = gldf4(swe), sg1 = gldf4(swe + 4), su0 = gldf4(swe + HALF), su1 = gldf4(swe + HALF + 4);
#pragma unroll
        for (int ai = 0; ai < 2; ++ai)
#pragma unroll
            for (int m = 0; m < 4; ++m) { const int r = r0 + ai * HALF + m * 16; const float s = rs_lds[u.slot * 256 + r], wt = wt_lds[u.slot * 256 + r];
                const i32x4 ga = __builtin_bit_cast(i32x4, acc[ai][0][m][0]), gb = __builtin_bit_cast(i32x4, acc[ai][0][m][1]), ua = __builtin_bit_cast(i32x4, acc[ai][1][m][0]), ub = __builtin_bit_cast(i32x4, acc[ai][1][m][1]);
                f32x4 a0, a1;
#pragma unroll
                for (int j = 0; j < 4; ++j) { const float x0 = (float)ga[j] * s * sg0[j], x1 = (float)gb[j] * s * sg1[j], y0 = (float)ua[j] * s * su0[j], y1 = (float)ub[j] * s * su1[j];
                    a0[j] = wt * x0 * sigmoid_f(x0) * y0; a1[j] = wt * x1 * sigmoid_f(x1) * y1; }
                u32x4 w; w.x = cvt_pk_bf16(a0[0], a0[1]); w.y = cvt_pk_bf16(a0[2], a0[3]); w.z = cvt_pk_bf16(a1[0], a1[1]); w.w = cvt_pk_bf16(a1[2], a1[3]);
                __builtin_amdgcn_raw_buffer_store_b128(w, hrs, (unsigned)((u.pm + r) * 1024 + col0 * 2), 0,   16); }
        asm volatile("s_waitcnt vmcnt(0)" ::: "memory");
        if (fr == 0 && fq == 0) __hip_atomic_fetch_add(done + (u.pm >> 8) * 64, 1u, __ATOMIC_RELAXED, __HIP_MEMORY_SCOPE_AGENT);
    }
};
struct EpiMoeDown {
    static constexpr bool PERM = true, AFTER_DRAIN = false, ALIGN = EPI_ALIGN_DEFAULT, I8 = false;
    bf16_t* YS; const LAS int* tokk_lds;
    __device__ __forceinline__ void operator()(AccRef acc, const Unit& u, int wr, int wc, int fr, int fq) const {
        const int r0 = wr * 64 + fr; const int col0 = u.pn * BM + wc * 32 + 8 * fq;
#pragma unroll
        for (int ai = 0; ai < 2; ++ai)
#pragma unroll
            for (int m = 0; m < 4; ++m) { const int r = r0 + ai * HALF + m * 16; const int tk = tokk_lds[u.slot * 256 + r];
                if (tk >= 0) { bf16_t* rowp = YS + (size_t)tk * 1024 + col0;
#pragma unroll
                    for (int bj = 0; bj < 2; ++bj) { const f32x4 v0 = acc[ai][bj][m][0], v1 = acc[ai][bj][m][1];
                        u32x4 w; w.x = cvt_pk_bf16(v0[0], v0[1]); w.y = cvt_pk_bf16(v0[2], v0[3]); w.z = cvt_pk_bf16(v1[0], v1[1]); w.w = cvt_pk_bf16(v1[2], v1[3]);
                        gst128(rowp + bj * HALF, w); } } }
    }
};
}
struct Args { const float* in[33]; float* out; unsigned char* ws; };
__device__ __forceinline__ const float* ARG(int k) { const __attribute__((address_space(4))) volatile unsigned long long* p = (const __attribute__((address_space(4))) volatile unsigned long long*)__builtin_amdgcn_kernarg_segment_ptr(); return (const float*)p[k]; }
struct ArgsV { unsigned char* ws; };
enum { I_X = 0, I_MEM, I_S5_NORM, I_S5_WIN, I_S5_LRE, I_S5_LIM, I_S5_LOGDT, I_S5_BRE, I_S5_BIM, I_S5_CRE, I_S5_CIM, I_S5_D, I_S5_WOUT,
       I_GM_NORM, I_GM_WIN, I_GM_VNORM, I_GM_WS, I_GM_BS, I_GM_WOUT, I_MEM_NORM, I_XA_NORM, I_XA_WQ, I_XA_WKV, I_XA_WO,
       I_MOE_NORM, I_MOE_WG, I_MOE_BG, I_MOE_WE, I_MOE_BE, I_MOE_WGATE, I_MOE_WUP, I_MOE_WDOWN, I_FINAL_NORM };

struct TItem { const float* W; const float* ksc; bf16_t* WT; int ldw, k0, n0, ldt, drow0; float cs; };
__device__ __forceinline__ void titem_load(const TItem& d, f32x4 (&v)[16], float (&sc)[16], int lane) {
    const int lr = lane >> 4, lc = (lane & 15) * 4;
#pragma unroll
    for (int i = 0; i < 16; ++i) v[i] = __builtin_nontemporal_load((const GAS f32x4*)(d.W + (size_t)(d.k0 + 4 * i + lr) * d.ldw + d.n0 + lc));
#pragma unroll
    for (int i = 0; i < 16; ++i) sc[i] = d.ksc ? gldf(d.ksc + d.k0 + 4 * i + lr) * d.cs : d.cs;
}
__device__ __forceinline__ void titem_store(const TItem& d, const f32x4 (&v)[16], const float (&sc)[16], LAS float* scr, int lane) {
    const int lr = lane >> 4, lc = (lane & 15) * 4;
#pragma unroll
    for (int i = 0; i < 16; ++i) { LAS float* p = scr + (4 * i + lr) * 65 + lc; p[0] = v[i][0] * sc[i]; p[1] = v[i][1] * sc[i]; p[2] = v[i][2] * sc[i]; p[3] = v[i][3] * sc[i]; }
    asm volatile("s_waitcnt lgkmcnt(0)" ::: "memory");
    const int c = lane & 7;
#pragma unroll
    for (int j = 0; j < 8; ++j) { const int n = (lane >> 3) + 8 * j; const LAS float* s = scr + (8 * c) * 65 + n;
        u32x4 o; o.x = cvt_pk_bf16(s[0 * 65], s[1 * 65]); o.y = cvt_pk_bf16(s[2 * 65], s[3 * 65]); o.z = cvt_pk_bf16(s[4 * 65], s[5 * 65]); o.w = cvt_pk_bf16(s[6 * 65], s[7 * 65]);
        gst128_nt(d.WT + (size_t)(d.drow0 + n) * d.ldt + d.k0 + 8 * c, o); }
    asm volatile("s_waitcnt lgkmcnt(0)" ::: "memory");
}
__device__ __forceinline__ int glu_row(int j0, int part) { return (j0 >> 7) * 256 + part * 128 + (j0 & 127); }

__device__ __forceinline__ void p0_item(int r, int KB, int& kb, int& nb) { kb = r % KB; nb = r / KB; }
__device__ __forceinline__ bool p0_desc(unsigned char* ws, int L, TItem& d) {
    constexpr int N_DENSE = 4352;
    int kb, nb; d.ksc = nullptr; d.cs = 1.f;
    if (L < 256) { p0_item(L, 16, kb, nb);
        d.W = ARG(I_S5_WIN); d.ldw = 1024; d.ksc = ARG(I_S5_NORM); d.WT = (bf16_t*)(ws + WS_W_S5IN); d.ldt = 1024; d.drow0 = nb * 64;
    } else if (L < 768) { p0_item(L - 256, 16, kb, nb); const int n0 = nb * 64;
        d.W = ARG(I_S5_WOUT); d.ldw = 2048; d.WT = (bf16_t*)(ws + WS_W_S5OUT); d.ldt = 1024; d.drow0 = glu_row(n0 & 1023, n0 >> 10);
    } else if (L < 1792) { p0_item(L - 768, 16, kb, nb);
        d.W = ARG(I_GM_WIN); d.ldw = 4096; d.ksc = ARG(I_GM_NORM); d.WT = (bf16_t*)(ws + WS_W_GMIN); d.ldt = 1024; d.drow0 = nb * 64;
    } else if (L < 2304) { p0_item(L - 1792, 32, kb, nb);
        d.W = ARG(I_GM_WOUT); d.ldw = 1024; d.WT = (bf16_t*)(ws + WS_W_GMOUT_P); d.ldt = 2112; d.drow0 = nb * 64;
    } else if (L < 2816) { return false;
    } else if (L < 3840) { const int r = L - 2816, l = r / 512; p0_item(r % 512, 16, kb, nb); const int n0 = nb * 64;
        d.W = ARG(I_XA_WKV) + (size_t)l * 2097152; d.ldw = 2048; d.ksc = ARG(I_MEM_NORM); d.WT = (bf16_t*)(ws + WS_W_XA + l * 8 * MiB + (n0 < 1024 ? 2 : 4) * MiB); d.ldt = 1024; d.drow0 = n0 & 1023;
    } else if (L < N_DENSE) { const int r = L - 3840, l = r / 256; p0_item(r % 256, 16, kb, nb);
        d.W = ARG(I_XA_WO) + (size_t)l * 1048576; d.ldw = 1024; d.WT = (bf16_t*)(ws + WS_W_XA + l * 8 * MiB + 6 * MiB); d.ldt = 1024; d.drow0 = nb * 64;
    } else { const int r = L - N_DENSE; const int kind = r / 8192, q = r % 8192, mat = q / 128, it = q % 128, l = mat / 32, e = mat % 32;
        if (kind < 2) { p0_item(it, 16, kb, nb);
            d.W = ARG(kind == 0 ? I_MOE_WGATE : I_MOE_WUP) + (size_t)mat * 524288; d.ldw = 512; d.ksc = ARG(I_MOE_NORM) + l * 1024;
            d.WT = (bf16_t*)(ws + WS_W_MOE + l * MOE_L_STRIDE) + (size_t)e * 1048576; d.ldt = 1024; d.drow0 = glu_row(nb * 64, kind);
        } else { p0_item(it, 8, kb, nb);
            d.W = ARG(I_MOE_WDOWN) + (size_t)mat * 524288; d.ldw = 1024; d.WT = (bf16_t*)(ws + WS_W_MOE + l * MOE_L_STRIDE + MOE_D_OFF) + (size_t)e * 524288; d.ldt = 512; d.drow0 = nb * 64; } }
    d.k0 = kb * 64; d.n0 = nb * 64; return true;
}
__device__ __forceinline__ void p0_weights(const ArgsV& a, LAS unsigned char* lds, int part, int j0, int j1, int gw, int NGW, int wave, int lane) {
    LAS float* scr = (LAS float*)(lds + wave * 16640);
    unsigned char* ws = a.ws;
    constexpr int TOTAL = 4352 + 24576;
    const int NJ = part == 0 ? 1280 : 3072 + 8192; if (j1 > NJ) j1 = NJ; (void)TOTAL;
#define P0_L(j_) (part == 0 ? ((j_) < 256 ? (j_) : (j_) - 256 + 2816) : ((j_) < 2560 ? (j_) + 256 : ((j_) < 3072 ? (j_) - 2560 + 3840 : (j_) - 3072 + 20736)))
    TItem cur, nxt; f32x4 va[16], vb[16]; float sa[16], sb[16];
    int j = j0 + gw; bool have = false;
    while (j < j1 && !(have = p0_desc(ws, P0_L(j), cur))) j += NGW;
    if (have) titem_load(cur, va, sa, lane);
    while (have) {
        int jn = j + NGW; bool hn = false;
        while (jn < j1 && !(hn = p0_desc(ws, P0_L(jn), nxt))) jn += NGW;
        if (hn) titem_load(nxt, vb, sb, lane);
        titem_store(cur, va, sa, scr, lane);
        if (hn) {
#pragma unroll
            for (int i = 0; i < 16; ++i) { va[i] = vb[i]; sa[i] = sb[i]; }
            cur = nxt; }
        have = hn; j = jn;
    }
#undef P0_L
}
__device__ __forceinline__ void p0_moe_gu_jobs(const ArgsV& a, LAS unsigned char* lds, int cw, int NCW, int wave, int lane) {
    constexpr int RP = 2064;
    LAS unsigned char* tile = lds;
    LAS unsigned* RMAX = (LAS unsigned*)(lds + 64 * RP);
    LAS float* scr = (LAS float*)(lds + 64 * RP + 512 + wave * 2112);
    unsigned char* ws = a.ws; float* swm = (float*)(ws + WS_SMALL + SM_MOESW);
    const int lr = lane >> 4, lc = (lane & 15) * 4, tid = wave * 64 + lane;
    f32x4 va[16], vb[16];
#define GU_W(J_) (ARG(((J_) >> 9) == 0 ? I_MOE_WGATE : I_MOE_WUP) + (size_t)(((J_) >> 3) & 63) * 524288 + ((J_) & 7) * 64)
#define GU_LOAD(J_) do { const float* W_ = GU_W(J_); \
        _Pragma("unroll") for (int i = 0; i < 16; ++i) va[i] = __builtin_nontemporal_load((const GAS f32x4*)(W_ + (size_t)(wave * 64 + 4 * i + lr) * 512 + lc)); \
        _Pragma("unroll") for (int i = 0; i < 16; ++i) vb[i] = __builtin_nontemporal_load((const GAS f32x4*)(W_ + (size_t)((wave + 8) * 64 + 4 * i + lr) * 512 + lc)); } while (0)
#define GU_KBLOCK(V_, kb_) do { \
        _Pragma("unroll") for (int s = 0; s < 8; ++s) { \
            { LAS float* p0 = scr + lr * 65 + lc; LAS float* p1 = scr + (4 + lr) * 65 + lc; \
              p0[0] = V_[2 * s][0]; p0[1] = V_[2 * s][1]; p0[2] = V_[2 * s][2]; p0[3] = V_[2 * s][3]; p1[0] = V_[2 * s + 1][0]; p1[1] = V_[2 * s + 1][1]; p1[2] = V_[2 * s + 1][2]; p1[3] = V_[2 * s + 1][3]; } \
            asm volatile("s_waitcnt lgkmcnt(0)" ::: "memory"); \
            const f32x4 k0 = gldf4(ksc + (kb_) * 64 + 8 * s), k1 = gldf4(ksc + (kb_) * 64 + 8 * s + 4); const LAS float* q = scr + lane; \
            u32x4 o; o.x = cvt_pk_bf16(q[0 * 65] * k0[0], q[1 * 65] * k0[1]); o.y = cvt_pk_bf16(q[2 * 65] * k0[2], q[3 * 65] * k0[3]); o.z = cvt_pk_bf16(q[4 * 65] * k1[0], q[5 * 65] * k1[1]); o.w = cvt_pk_bf16(q[6 * 65] * k1[2], q[7 * 65] * k1[3]); \
            *(LAS u32x4*)(tile + lane * RP + ((kb_) * 64 + 8 * s) * 2) = o; \
            rmax = fmaxf(rmax, fmaxf(fmaxf(fmaxf(fabsf(bflo(o.x)), fabsf(bfhi(o.x))), fmaxf(fabsf(bflo(o.y)), fabsf(bfhi(o.y)))), fmaxf(fmaxf(fabsf(bflo(o.z)), fabsf(bfhi(o.z))), fmaxf(fabsf(bflo(o.w)), fabsf(bfhi(o.w)))))); \
            asm volatile("s_waitcnt lgkmcnt(0)" ::: "memory"); } } while (0)
    int J = cw; int par = 0;
    __syncthreads();
    if (tid < 128) RMAX[tid] = 0u;
    if (J < 1024) GU_LOAD(J);
    __syncthreads();
#pragma unroll 1
    for (; J < 1024; J += NCW, par ^= 1) {
        const int kind = J >> 9, mat = (J >> 3) & 63, nb = J & 7, l = mat >> 5, e = mat & 31;
        const float* ksc = ARG(I_MOE_NORM) + l * 1024;
        bf16_t* WT = (bf16_t*)(ws + WS_W_MOE + l * MOE_L_STRIDE) + (size_t)e * 1048576; const int drow0 = glu_row(nb * 64, kind);
        __syncthreads();
        if (tid < 64) RMAX[(par ^ 1) * 64 + tid] = 0u;
        float rmax = 0.f;
        GU_KBLOCK(va, wave);
        GU_KBLOCK(vb, wave + 8);
        __hip_atomic_fetch_max(RMAX + par * 64 + lane, __builtin_bit_cast(unsigned, rmax), __ATOMIC_RELAXED, __HIP_MEMORY_SCOPE_WORKGROUP);
        if (J + NCW < 1024) GU_LOAD(J + NCW);
        __syncthreads();
#pragma unroll
        for (int q = 0; q < 8; ++q) { const int n = wave * 8 + q; const float am = fmaxf(__builtin_bit_cast(float, RMAX[par * 64 + n]), 1e-30f), qs = 127.0f / am;
            const u32x4 a0 = *(const LAS u32x4*)(tile + n * RP + lane * 32), a1 = *(const LAS u32x4*)(tile + n * RP + lane * 32 + 16);
            u32x4 o;
            { const int q0 = (int)rintf(bflo(a0.x) * qs), q1 = (int)rintf(bfhi(a0.x) * qs), q2 = (int)rintf(bflo(a0.y) * qs), q3 = (int)rintf(bfhi(a0.y) * qs);
              const int q4 = (int)rintf(bflo(a0.z) * qs), q5 = (int)rintf(bfhi(a0.z) * qs), q6 = (int)rintf(bflo(a0.w) * qs), q7 = (int)rintf(bfhi(a0.w) * qs);
              o.x = (unsigned)(q0 & 255) | ((unsigned)(q1 & 255) << 8) | ((unsigned)(q2 & 255) << 16) | ((unsigned)(q3 & 255) << 24);
              o.y = (unsigned)(q4 & 255) | ((unsigned)(q5 & 255) << 8) | ((unsigned)(q6 & 255) << 16) | ((unsigned)(q7 & 255) << 24); }
            { const int q0 = (int)rintf(bflo(a1.x) * qs), q1 = (int)rintf(bfhi(a1.x) * qs), q2 = (int)rintf(bflo(a1.y) * qs), q3 = (int)rintf(bfhi(a1.y) * qs);
              const int q4 = (int)rintf(bflo(a1.z) * qs), q5 = (int)rintf(bfhi(a1.z) * qs), q6 = (int)rintf(bflo(a1.w) * qs), q7 = (int)rintf(bfhi(a1.w) * qs);
              o.z = (unsigned)(q0 & 255) | ((unsigned)(q1 & 255) << 8) | ((unsigned)(q2 & 255) << 16) | ((unsigned)(q3 & 255) << 24);
              o.w = (unsigned)(q4 & 255) | ((unsigned)(q5 & 255) << 8) | ((unsigned)(q6 & 255) << 16) | ((unsigned)(q7 & 255) << 24); }
            gst128_nt((unsigned char*)(WT + (size_t)(drow0 + n) * 1024) + lane * 16, o);
            if (lane == 0) gstf(swm + (size_t)mat * 1024 + drow0 + n, am * (1.0f / 127.0f)); }
    }
    __syncthreads();
#undef GU_W
#undef GU_LOAD
#undef GU_KBLOCK
}
template <int NR>
__device__ __forceinline__ void rows_to_bf16(const float* xsrc, bf16_t* dst, float* rinv, int m0, int stride, int mmax, int lane) {
    f32x4 v[NR][4];
#pragma unroll
    for (int i = 0; i < NR; ++i) { const int m = m0 + i * stride; if (m < mmax) { const GAS f32x4* xr = (const GAS f32x4*)(xsrc + (size_t)m * 1024) + lane;
#pragma unroll
        for (int j = 0; j < 4; ++j) v[i][j] = __builtin_nontemporal_load(xr + 64 * j); } }
#pragma unroll
    for (int i = 0; i < NR; ++i) { const int m = m0 + i * stride; if (m < mmax) { float s = 0.f; GAS u32x2* o8 = (GAS u32x2*)(dst + (size_t)m * 1024) + lane;
#pragma unroll
        for (int j = 0; j < 4; ++j) { u32x2 w; w.x = cvt_pk_bf16(v[i][j][0], v[i][j][1]); w.y = cvt_pk_bf16(v[i][j][2], v[i][j][3]); o8[64 * j] = w;
            s += bflo(w.x) * bflo(w.x) + bfhi(w.x) * bfhi(w.x) + bflo(w.y) * bflo(w.y) + bfhi(w.y) * bfhi(w.y); }
        const float r = 1.0f / sqrtf(wave_sum(s) * (1.0f / 1024.0f) + RMS_EPS); if (lane == 0) gstf(rinv + m, r); } }
}
__device__ __forceinline__ void p0_rows(const ArgsV& a, int gw, int NGW, int lane) {
    unsigned char* ws = a.ws; bf16_t* X = (bf16_t*)(ws + WS_X); float* rinvA = (float*)(ws + WS_SMALL + SM_RINVA);
    { const float* xs = ARG(I_X); for (int m = gw; m < T_TOK; m += 8 * NGW) rows_to_bf16<8>(xs, X, rinvA, m, NGW, T_TOK, lane); }
    if (gw == 0) { u32x4* z = (u32x4*)(X + (size_t)T_TOK * 1024); z[lane] = (u32x4){0u, 0u, 0u, 0u}; z[lane + 64] = (u32x4){0u, 0u, 0u, 0u}; }
    bf16_t* MB = (bf16_t*)(ws + WS_MEMBF); float* rinvM = (float*)(ws + WS_SMALL + SM_RINVMEM);
    { const float* ms = ARG(I_MEM); for (int m = gw; m < MEMR; m += NGW) rows_to_bf16<1>(ms, MB, rinvM, m, NGW, MEMR, lane); }
    { const float* wq = ARG(I_XA_WQ); const float* xn = ARG(I_XA_NORM); bf16_t* base = (bf16_t*)(ws + WS_W_XA);
      for (int m = gw; m < 2048; m += NGW) { const int l = m >> 10, kin = m & 1023; const float sc = xn[m] * 0.0625f;
          const GAS f32x4* xr = (const GAS f32x4*)(wq + (size_t)m * 1024) + lane; GAS u32x2* o8 = (GAS u32x2*)(base + (size_t)l * 4 * MiB + (size_t)kin * 1024) + lane;
#pragma unroll
          for (int j = 0; j < 4; ++j) { const f32x4 v = xr[64 * j]; u32x2 w; w.x = cvt_pk_bf16(v[0] * sc, v[1] * sc); w.y = cvt_pk_bf16(v[2] * sc, v[3] * sc); o8[64 * j] = w; } } }
    { const float* wsp = ARG(I_GM_WS); bf16_t* WSB = (bf16_t*)(ws + WS_SMALL + SM_WSB);
      for (int i = gw * 64 + lane; i < 8 * 128 * 128; i += NGW * 64) { const int g = i >> 14, r = (i >> 7) & 127, cp = i & 127, qp = cp >> 3, e = cp & 7; const int cs = ((qp ^ (r & 15)) << 3) + e;
          const float v = ((r < 64) && (cs >= 64)) ? 0.f : wsp[(size_t)g * 16384 + r * 128 + cs];
          WSB[i] = (bf16_t)f2bf(v); } }
    bf16_t* RT = (bf16_t*)(ws + WS_W_RT);
    { const float* wgp = ARG(I_MOE_WG); const float* wep = ARG(I_MOE_WE); const float* mn = ARG(I_MOE_NORM);
      for (int i = gw * 64 + lane; i < 2 * 49152; i += NGW * 64) { const int l = i / 49152, r = i % 49152, e = r & 7, ln = (r >> 3) & 63, j = (r >> 9) % 3, ks = r / 1536;
        const int n = j * 16 + (ln & 15), k = ks * 32 + (ln >> 4) * 8 + e;
        float v = 0.f;
        if (n < 4) v = wgp[(size_t)l * 4096 + k * 4 + n]; else if (n < 36) v = wep[(size_t)l * 32768 + k * 32 + (n - 4)];
        v *= mn[l * 1024 + k];
        RT[(size_t)l * 49152 + r] = (bf16_t)f2bf(v); } }
}
__device__ __forceinline__ void p0_s5_tables(const ArgsV& a, LAS unsigned char* lds, int g, int tid) {
    constexpr int CS = 65;
    LAS float* ABR = (LAS float*)lds;
    LAS float* ABI = ABR + 17 * 64;
    LAS float* CR = ABI + 17 * 64;
    LAS float* CI = CR + 16 * CS;
    LAS float* BR = CI + 16 * CS;
    LAS float* BI = BR + 1024;
    LAS float* KN = BI + 1024;
    __syncthreads();
    { const float dt = expf(ARG(I_S5_LOGDT)[g]);
      for (int i = tid; i < 17 * 64; i += NTHR) { const int lag = i >> 6, p = i & 63; const float lr = ARG(I_S5_LRE)[g * 64 + p], li = ARG(I_S5_LIM)[g * 64 + p];
          const float mag = expf(lr * dt * (float)lag); float sn, cs; sincosf(li * dt * (float)lag, &sn, &cs); ABR[i] = mag * cs; ABI[i] = mag * sn; }
      for (int i = tid; i < 1024; i += NTHR) { const int n = i >> 6, p = i & 63; CR[n * CS + p] = ARG(I_S5_CRE)[(size_t)g * 1024 + i]; CI[n * CS + p] = ARG(I_S5_CIM)[(size_t)g * 1024 + i]; }
      __syncthreads();
      for (int i = tid; i < 1024; i += NTHR) { const int p = i >> 4; const float lr = ARG(I_S5_LRE)[g * 64 + p], li = ARG(I_S5_LIM)[g * 64 + p];
          const float ar = ABR[64 + p], ai = ABI[64 + p], den = lr * lr + li * li;
          const float cre = ((ar - 1.0f) * lr + ai * li) / den, cim = (ai * lr - (ar - 1.0f) * li) / den;
          const float br = ARG(I_S5_BRE)[(size_t)g * 1024 + i], bi = ARG(I_S5_BIM)[(size_t)g * 1024 + i];
          BR[i] = cre * br - cim * bi; BI[i] = cre * bi + cim * br; } }
    __syncthreads();
    {
        const int n = (tid >> 4) & 15, np = tid & 15, l0 = tid >> 8;
        float k0 = 0.f, k1 = 0.f, k2 = 0.f, k3 = 0.f, k4 = 0.f, k5 = 0.f, k6 = 0.f, k7 = 0.f;
        for (int p = 0; p < 64; ++p) { const float cr = CR[n * CS + p], ci = CI[n * CS + p], br = BR[p * 16 + np], bi = BI[p * 16 + np];
            const float xr = cr * br - ci * bi, xi = cr * bi + ci * br; const LAS float* pr = ABR + l0 * 64 + p; const LAS float* pi = ABI + l0 * 64 + p;
            k0 += xr * pr[0 * 128] - xi * pi[0 * 128]; k1 += xr * pr[1 * 128] - xi * pi[1 * 128]; k2 += xr * pr[2 * 128] - xi * pi[2 * 128]; k3 += xr * pr[3 * 128] - xi * pi[3 * 128];
            k4 += xr * pr[4 * 128] - xi * pi[4 * 128]; k5 += xr * pr[5 * 128] - xi * pi[5 * 128]; k6 += xr * pr[6 * 128] - xi * pi[6 * 128]; k7 += xr * pr[7 * 128] - xi * pi[7 * 128]; }
        LAS float* ko = KN + (l0 * 16 + n) * 16 + np;
        ko[0 * 512] = k0; ko[1 * 512] = k1; ko[2 * 512] = k2; ko[3 * 512] = k3; ko[4 * 512] = k4; ko[5 * 512] = k5; ko[6 * 512] = k6; ko[7 * 512] = k7; }
    __syncthreads();
    bf16_t* AF = (bf16_t*)(a.ws + WS_SCR + SC_S5A) + (size_t)g * 256 * 384;
    const float* dsk = ARG(I_S5_D);
    for (int e = tid; e < 256 * 48; e += NTHR) { const int r = e / 48, k = (e % 48) * 8, tl = r >> 4, n = r & 15; float v[8];
        if (k < 256) { const int s = k >> 4, np0 = k & 15;
#pragma unroll
            for (int i = 0; i < 8; ++i) { float t = 0.f; if (s <= tl) { t = KN[((tl - s) * 16 + n) * 16 + np0 + i]; if (s == tl && np0 + i == n) t += dsk[g * 16 + n]; } v[i] = t; }
        } else { const int ci0 = k - 256, p0 = ci0 & 63;
#pragma unroll
            for (int i = 0; i < 8; ++i) { const int p = p0 + i; const float ar = ABR[(tl + 1) * 64 + p], ai = ABI[(tl + 1) * 64 + p], cr = CR[n * CS + p], cim = CI[n * CS + p];
                v[i] = (ci0 < 64) ? (cr * ar - cim * ai) : -(cr * ai + cim * ar); } }
        u32x4 o; o.x = cvt_pk_bf16(v[0], v[1]); o.y = cvt_pk_bf16(v[2], v[3]); o.z = cvt_pk_bf16(v[4], v[5]); o.w = cvt_pk_bf16(v[6], v[7]);
        gst128(AF + (size_t)r * 384 + k, o); }
    bf16_t* MS = (bf16_t*)(a.ws + WS_SCR + SC_S5M) + (size_t)g * 128 * 256;
    for (int e = tid; e < 128 * 32; e += NTHR) { const int pp = e >> 5, k = (e & 31) * 8, s = k >> 4, np0 = k & 15, p = pp & 63; float v[8];
        const float ar = ABR[(15 - s) * 64 + p], ai = ABI[(15 - s) * 64 + p];
#pragma unroll
        for (int i = 0; i < 8; ++i) { const float br = BR[p * 16 + np0 + i], bi = BI[p * 16 + np0 + i]; v[i] = (pp < 64) ? (ar * br - ai * bi) : (ar * bi + ai * br); }
        u32x4 o; o.x = cvt_pk_bf16(v[0], v[1]); o.y = cvt_pk_bf16(v[2], v[3]); o.z = cvt_pk_bf16(v[4], v[5]); o.w = cvt_pk_bf16(v[6], v[7]);
        gst128(MS + (size_t)pp * 256 + k, o); }
    if (tid < 64) { float* AB = (float*)(a.ws + WS_SMALL + SM_AB16) + (size_t)(g * 64 + tid) * 2; AB[0] = ABR[16 * 64 + tid]; AB[1] = ABI[16 * 64 + tid]; }
}

template <class Sched>
__device__ __forceinline__ void fill_rs(const Sched& S, LAS float* rs_lds, const float* direct, const float* part, int nslots, int tid) {
    g8::Unit u;
    for (int i = 0; i < 8 && S.next(i, u); ++i) {
        if (tid < 256) { const int row = u.pm * 256 + tid; float v;
            if (direct) v = direct[row];
            else { float s = 0.f; const f32x4* p = (const f32x4*)(part + (size_t)row * 32); for (int j = 0; j < nslots / 4; ++j) { const f32x4 t = p[j]; s += (t[0] + t[1]) + (t[2] + t[3]); } v = 1.0f / sqrtf(s * (1.0f / 1024.0f) + RMS_EPS); }
            rs_lds[i * 256 + tid] = v; }
    }
    __syncthreads();
}

struct S5Sched {
    int b, g;
    __device__ __forceinline__ bool next(int i, g8::Unit& u) const { if (i >= 2) return false;
        const int bt = b * 2 + i;
        const unsigned off = (unsigned)g * 1048576u + (unsigned)bt * (256u * 512u);
        u.A = (unsigned)(WS_SCR + SC_U) + off; u.A2 = (unsigned)(WS_SCR + SC_H2) + off; u.B = (unsigned)(WS_SCR + SC_S5A) + (unsigned)g * (256u * 768u); u.pm = bt; u.pn = 0; u.slot = i; u.aux = g; return true; }
    __device__ __forceinline__ void a_ready(const g8::Unit&, int, int) const {}
};
__device__ __forceinline__ void s5_scan_pair(const ArgsV& a, LAS unsigned char* lds, int b, int g, int tid, int wave, int lane, unsigned long long* pts = nullptr) {
#define S5_PST(k) do { if (pts && blockIdx.x == 0 && tid == 0) pts[k] = __builtin_amdgcn_s_memrealtime(); } while (0)
    S5_PST(0);
    unsigned char* ws = a.ws;
    const bf16_t* U = (const bf16_t*)(ws + WS_SCR + SC_U); bf16_t* H2 = (bf16_t*)(ws + WS_SCR + SC_H2);
    const bf16_t* MS = (const bf16_t*)(ws + WS_SCR + SC_S5M) + (size_t)g * 128 * 256;
    LAS unsigned char* UL = lds; LAS float* SL = (LAS float*)(lds + 67584); LAS float* LC = (LAS float*)(lds + 133120); LAS float* CC = LC + 1024;
    const int fr = lane & 15, fq = lane >> 4;
    bf16x8 mf[8];
#pragma unroll
    for (int ks = 0; ks < 8; ++ks) mf[ks] = *(const GAS bf16x8*)(MS + (size_t)(wave * 16 + fr) * 256 + ks * 32 + fq * 8);
    const int p = tid & 63, chk = tid >> 6;
    float a1r, a1i; { const float* AB = (const float*)(ws + WS_SMALL + SM_AB16) + (size_t)(g * 64 + p) * 2; a1r = AB[0]; a1i = AB[1]; }
    float a16r = a1r, a16i = a1i;
#pragma unroll
    for (int i = 0; i < 4; ++i) { const float r = a16r * a16r - a16i * a16i, im = 2.f * a16r * a16i; a16r = r; a16i = im; }
    float hr = 0.f, hi = 0.f;
    u32x4 pre[8];
#define S5_LOADQ(qt_) do { _Pragma("unroll") for (int i = 0; i < 8; ++i) { const int idx = tid + i * NTHR, t = idx >> 1, hf = idx & 1; \
        pre[i] = gld128(U + ((size_t)g * T_TOK + (size_t)(b * 512 + (qt_) * 128) * 16) * 16 + (size_t)idx * 8); (void)t; (void)hf; } } while (0)
    S5_LOADQ(0);
    for (int qt = 0; qt < 4; ++qt) {
        __syncthreads();
#pragma unroll
        for (int i = 0; i < 8; ++i) { const int idx = tid + i * NTHR, t = idx >> 1, hf = idx & 1; *(LAS u32x4*)(UL + (t >> 4) * 528 + (t & 15) * 32 + hf * 16) = pre[i]; }
        __syncthreads();
        if (qt < 3) S5_LOADQ(qt + 1);
#pragma unroll 1
        for (int bt = 0; bt < 8; ++bt) { f32x4 acc = (f32x4){0.f, 0.f, 0.f, 0.f};
#pragma unroll
            for (int ks = 0; ks < 8; ++ks) { const bf16x8 yb = *(const LAS bf16x8*)(UL + (bt * 16 + fr) * 528 + (2 * ks + (fq >> 1)) * 32 + (fq & 1) * 16);
                acc = __builtin_amdgcn_mfma_f32_16x16x32_bf16(mf[ks], yb, acc, 0, 0, 0); }
            *(LAS f32x4*)(SL + (bt * 16 + fr) * 128 + wave * 16 + fq * 4) = acc; }
        __syncthreads();
        { float lr = 0.f, li = 0.f;
#pragma unroll 4
          for (int j = 0; j < 16; ++j) { const float sr = SL[(chk * 16 + j) * 128 + p], si = SL[(chk * 16 + j) * 128 + 64 + p];
              const float nr = a1r * lr - a1i * li + sr, ni = a1r * li + a1i * lr + si; lr = nr; li = ni; }
          LC[(chk * 64 + p) * 2] = lr; LC[(chk * 64 + p) * 2 + 1] = li; }
        __syncthreads();
        if (tid < 64) {
#pragma unroll
            for (int cI = 0; cI < 8; ++cI) { CC[(cI * 64 + p) * 2] = hr; CC[(cI * 64 + p) * 2 + 1] = hi;
                const float lr = LC[(cI * 64 + p) * 2], li = LC[(cI * 64 + p) * 2 + 1];
                const float nr = a16r * hr - a16i * hi + lr, ni = a16r * hi + a16i * hr + li; hr = nr; hi = ni; } }
        __syncthreads();
        { float cr = CC[(chk * 64 + p) * 2], ci = CC[(chk * 64 + p) * 2 + 1];
#pragma unroll 4
          for (int j = 0; j < 16; ++j) { const int blk = b * 512 + qt * 128 + chk * 16 + j;
              GAS bf16_t* hrow = (GAS bf16_t*)(H2 + ((size_t)g * 2048 + blk) * 256);
              hrow[p] = (bf16_t)f2bf(cr); hrow[64 + p] = (bf16_t)f2bf(ci);
              const float sr = SL[(chk * 16 + j) * 128 + p], si = SL[(chk * 16 + j) * 128 + 64 + p];
              const float nr = a1r * cr - a1i * ci + sr, ni = a1r * ci + a1i * cr + si; cr = nr; ci = ni; } }
    }
#undef S5_LOADQ
    asm volatile("s_waitcnt vmcnt(0)" ::: "memory");
    __syncthreads();
    S5_PST(1);
    S5Sched S{b, g};
    g8::EpiS5B E{(bf16_t*)(ws + WS_SCR + SC_Y)};
    g8::gemm_phase<g8::EpiS5B, S5Sched, 8, 512, 768, 128, 128, 6, 4>(lds, (const char*)ws, S, E, nullptr, tid);
    S5_PST(2);
#undef S5_PST
}

struct PrepSched {
    unsigned A, B; int pm, pn;
    __device__ __forceinline__ bool next(int i, g8::Unit& u) const { if (i) return false; u.A = A; u.A2 = A; u.B = B; u.pm = pm; u.pn = pn; u.slot = 0; u.aux = 0; return true; }
    __device__ __forceinline__ void a_ready(const g8::Unit&, int, int) const {}
};
__device__ __forceinline__ void prep_tile(const ArgsV& a, LAS unsigned char* lds, int layer, int b, int r, size_t GXoff, int tid) {
    unsigned char* ws = a.ws; const int h = (r >> 2) & 3, t = r & 3;
    const unsigned KV = (unsigned)WS_KV + (unsigned)layer * (unsigned)(4 * MiB) + (unsigned)b * (256u * 4096u) + (unsigned)h * 512u;
    const unsigned WX = (unsigned)WS_W_XA + (unsigned)layer * (unsigned)(8 * MiB);
    bf16_t* GX = (bf16_t*)(ws + GXoff);
    if (r < 16) { PrepSched S{KV, WX + (unsigned)t * (256u * 2048u) + (unsigned)h * 512u, h, t};
        g8::EpiStore E{GX, 1024};
        g8::gemm_phase<g8::EpiStore, PrepSched, 0, 4096, 2048, 128, 128, 4, 4>(lds, (const char*)ws, S, E, nullptr, tid); }
    else { PrepSched S{WX + (unsigned)(6 * MiB) + (unsigned)t * (256u * 2048u) + (unsigned)h * 512u, KV + 2048u, t, h};
        g8::EpiStore E{GX + 1048576, 1024};
        g8::gemm_phase<g8::EpiStore, PrepSched, 0, 2048, 4096, 128, 128, 4, 4>(lds, (const char*)ws, S, E, nullptr, tid); }
}

__device__ __forceinline__ void router_phase(const ArgsV& a, LAS unsigned char* lds, int layer, int G, int c, int tid, int wave, int lane) {
    unsigned char* ws = a.ws;
    const bf16_t* X = (const bf16_t*)(ws + WS_X); const bf16_t* RT = (const bf16_t*)(ws + WS_W_RT) + (size_t)layer * 49152;
    float* rinvB = (float*)(ws + WS_SMALL + SM_RINVB); float* wts = (float*)(ws + WS_SMALL + SM_WTS); unsigned char* xq = ws + WS_SCR + SC_XQ;
    unsigned* cnt = (unsigned*)(ws + WS_CTL) + CW_CNT + layer * 64; int* list = (int*)(ws + WS_LIST);
    if (blockIdx.x == 0 && tid < 64) ((GAS u32x4*)(xq + (size_t)T_TOK * 1024))[tid] = (u32x4){0u, 0u, 0u, 0u};
    LAS float* LG = (LAS float*)(lds + 98304);
    LAS int* HIST = (LAS int*)(lds + 118784);
    LAS int* ASG = (LAS int*)(lds + 119040);
    const int fr = lane & 15, fq = lane >> 4;
    const float* bgp = ARG(I_MOE_BG); const float* bep = ARG(I_MOE_BE);
    __syncthreads();
#pragma unroll
    for (int t = 0; t < 12; ++t) { const int i = wave * 12 + t; __builtin_amdgcn_global_load_lds((const unsigned*)((const char*)RT + i * 1024 + lane * 16), (LAS unsigned*)(lds + i * 1024), 16, 0, 0); }
    for (int it = (c & 7) * (G >> 3) + (c >> 3); it < T_TOK / 128; it += G) {
        const int tok0 = it * 128 + wave * 16;
        bf16x8 xa[32];
        const bf16_t* xrow = X + (size_t)(tok0 + fr) * 1024 + fq * 8;
#pragma unroll
        for (int ks = 0; ks < 32; ++ks) xa[ks] = *(const GAS bf16x8*)(xrow + ks * 32);
        asm volatile("s_waitcnt vmcnt(0)" ::: "memory");
        __syncthreads();
        if (tid < 64) HIST[tid] = 0;
        f32x4 acc[3];
#pragma unroll
        for (int j = 0; j < 3; ++j) acc[j] = (f32x4){0.f, 0.f, 0.f, 0.f};
        float ss = 0.f, am = 0.f;
#pragma unroll
        for (int ks = 0; ks < 32; ++ks) { const u32x4 w = __builtin_bit_cast(u32x4, xa[ks]);
            ss += bflo(w.x) * bflo(w.x) + bfhi(w.x) * bfhi(w.x) + bflo(w.y) * bflo(w.y) + bfhi(w.y) * bfhi(w.y) + bflo(w.z) * bflo(w.z) + bfhi(w.z) * bfhi(w.z) + bflo(w.w) * bflo(w.w) + bfhi(w.w) * bfhi(w.w);
            am = fmaxf(am, fmaxf(fmaxf(fmaxf(fabsf(bflo(w.x)), fabsf(bfhi(w.x))), fmaxf(fabsf(bflo(w.y)), fabsf(bfhi(w.y)))), fmaxf(fmaxf(fabsf(bflo(w.z)), fabsf(bfhi(w.z))), fmaxf(fabsf(bflo(w.w)), fabsf(bfhi(w.w)))))); }
        ss += __shfl_xor(ss, 16); ss += __shfl_xor(ss, 32);
        am = fmaxf(am, __shfl_xor(am, 16)); am = fmaxf(am, __shfl_xor(am, 32)); am = fmaxf(am, 1e-20f);
        const float rinv = 1.0f / sqrtf(ss * (1.0f / 1024.0f) + RMS_EPS), qs = 127.0f / am;
        if (fq == 0) rinvB[tok0 + fr] = rinv * am * (1.0f / 127.0f);
        GAS u32x2* qrow = (GAS u32x2*)(xq + (size_t)(tok0 + fr) * 1024 + fq * 8);
#pragma unroll
        for (int ks = 0; ks < 32; ++ks) {
#pragma unroll
            for (int j = 0; j < 3; ++j) { const bf16x8 wb = *(const LAS bf16x8*)(lds + ((ks * 3 + j) * 64 + lane) * 16);
                acc[j] = __builtin_amdgcn_mfma_f32_16x16x32_bf16(xa[ks], wb, acc[j], 0, 0, 0); }
            { u32x4 w = __builtin_bit_cast(u32x4, xa[ks]); asm volatile("" : "+v"(w));
              const int q0 = (int)rintf(bflo(w.x) * qs), q1 = (int)rintf(bfhi(w.x) * qs), q2 = (int)rintf(bflo(w.y) * qs), q3 = (int)rintf(bfhi(w.y) * qs);
              const int q4 = (int)rintf(bflo(w.z) * qs), q5 = (int)rintf(bfhi(w.z) * qs), q6 = (int)rintf(bflo(w.w) * qs), q7 = (int)rintf(bfhi(w.w) * qs);
              u32x2 o; o.x = (unsigned)(q0 & 255) | ((unsigned)(q1 & 255) << 8) | ((unsigned)(q2 & 255) << 16) | ((unsigned)(q3 & 255) << 24);
              o.y = (unsigned)(q4 & 255) | ((unsigned)(q5 & 255) << 8) | ((unsigned)(q6 & 255) << 16) | ((unsigned)(q7 & 255) << 24);
              qrow[ks * 4] = o; } }
#pragma unroll
        for (int reg = 0; reg < 4; ++reg) { const float rv = __shfl(rinv, fq * 4 + reg);
#pragma unroll
            for (int j = 0; j < 3; ++j) { const int n = j * 16 + fr; if (n < 40) LG[(wave * 16 + fq * 4 + reg) * 40 + n] = acc[j][reg] * rv; } }
        __syncthreads();
        if (tid < 128) { const int t = tid; const LAS float* lg = LG + t * 40;
            float gl[4]; int gsel = 0; float gm = -3.0e38f;
#pragma unroll
            for (int j = 0; j < 4; ++j) { gl[j] = lg[j] + bgp[layer * 4 + j]; if (gl[j] > gm) { gm = gl[j]; gsel = j; } }
            float gs = 0.f;
#pragma unroll
            for (int j = 0; j < 4; ++j) gs += expf(gl[j] - gm);
            const float wg = 1.0f / gs;
            float v0 = -3.0e38f, v1 = -3.0e38f; int i0 = 0, i1 = 0;
            for (int j = 0; j < 8; ++j) { const float v = lg[4 + gsel * 8 + j] + bep[layer * 32 + gsel * 8 + j];
                if (v > v0) { v1 = v0; i1 = i0; v0 = v; i0 = j; } else if (v > v1) { v1 = v; i1 = j; } }
            const float e1 = expf(v1 - v0), den = 1.0f / (1.0f + e1);
            const int tok = it * 128 + t; const int ea = gsel * 8 + i0, eb = gsel * 8 + i1;
            wts[(size_t)tok * 2] = wg * den; wts[(size_t)tok * 2 + 1] = wg * e1 * den;
            ASG[t * 4] = ea; ASG[t * 4 + 1] = __hip_atomic_fetch_add(HIST + ea, 1, __ATOMIC_RELAXED, __HIP_MEMORY_SCOPE_WORKGROUP); ASG[t * 4 + 2] = eb; ASG[t * 4 + 3] = __hip_atomic_fetch_add(HIST + eb, 1, __ATOMIC_RELAXED, __HIP_MEMORY_SCOPE_WORKGROUP); }
        __syncthreads();
        if (tid < 32) { const int n = HIST[tid]; HIST[32 + tid] = n ? (int)atomicAdd(&cnt[tid], (unsigned)n) : 0; }
        __syncthreads();
        if (tid < 128) { const int tok = it * 128 + tid; const int ea = ASG[tid * 4], eb = ASG[tid * 4 + 2];
            list[(size_t)ea * 32768 + HIST[32 + ea] + ASG[tid * 4 + 1]] = tok * 2; list[(size_t)eb * 32768 + HIST[32 + eb] + ASG[tid * 4 + 3]] = tok * 2 + 1; }
    }
    asm volatile("s_waitcnt vmcnt(0)" ::: "memory");
}

__device__ __forceinline__ bool moe_unit(int uidx, const LAS int* TP, unsigned A, unsigned arow, unsigned Bw, unsigned bstride, unsigned btile, int slot, g8::Unit& u) {
    if (uidx < 0 || uidx >= TP[32] * 4) return false;
    const int rtile = uidx >> 2, pn = uidx & 3; int e = 0;
    for (int j = 1; j < 32; ++j) e += (TP[j] <= rtile) ? 1 : 0;
    u.A = A + (unsigned)rtile * 256u * arow; u.A2 = u.A; u.B = Bw + (unsigned)e * bstride + (unsigned)pn * btile;
    u.pm = rtile * 256; u.pn = pn; u.slot = slot; u.aux = e | ((rtile - TP[e]) << 8); return true;
}
struct MoeUpSched {
    unsigned Bw; const LAS int* TP; int r;
    __device__ __forceinline__ bool next(int i, g8::Unit& u) const { return moe_unit(i * 256 + r, TP, (unsigned)(WS_SCR + SC_XQ), 0u, Bw, (unsigned)(2 * MiB), 512u * 1024u, i, u); }
    __device__ __forceinline__ void a_ready(const g8::Unit&, int, int) const {}
};
struct MoeDownSched {
    unsigned Bw; const LAS int* TP; int r; unsigned* done; unsigned* tmo;
    __device__ __forceinline__ int didx(int i) const {
        const int NU = TP[32] * 4, n5 = NU - 1024;
        if (n5 < 0 || n5 > 85) return i * 256 + r;
        if (r < n5) return i < 3 ? i * 256 + r : -1;
        if (i < 4) return i * 256 + r;
        if (i == 4) { if (r < 2 * n5) return 768 + (r - n5); if (r < 3 * n5) return 1024 + (r - 2 * n5); }
        return -1;
    }
    __device__ __forceinline__ bool next(int i, g8::Unit& u) const { return moe_unit(didx(i), TP, (unsigned)(WS_SCR + SC_HB), 1024u, Bw, (unsigned)(1 * MiB), 256u * 1024u, i, u); }
    __device__ __forceinline__ void a_ready(const g8::Unit& u, int wid, int lane) const {
        if (wid == 0) { unsigned* w = done + (u.pm >> 8) * 64; unsigned sp = 0;
            while ((unsigned)__builtin_amdgcn_readfirstlane(__hip_atomic_load(w, __ATOMIC_RELAXED, __HIP_MEMORY_SCOPE_AGENT)) < 32u) {
                __builtin_amdgcn_s_sleep(2);
                if (++sp > (1u << 20)) { if (lane == 0) __hip_atomic_fetch_add(tmo, 1u, __ATOMIC_RELAXED, __HIP_MEMORY_SCOPE_AGENT); break; } }
            asm volatile("s_waitcnt vmcnt(0)" ::: "memory"); }
        asm volatile("" ::: "memory"); __builtin_amdgcn_s_barrier(); asm volatile("" ::: "memory");
    }
};
__device__ __forceinline__ void moe_tables(const ArgsV& a, LAS unsigned char* lds, int layer, const MoeUpSched& SU, const MoeDownSched& SD, int tid) {
    unsigned char* ws = a.ws; const unsigned* cnt = (const unsigned*)(ws + WS_CTL) + CW_CNT + layer * 64; const int* list = (const int*)(ws + WS_LIST);
    const float* rinvB = (const float*)(ws + WS_SMALL + SM_RINVB); const float* wts = (const float*)(ws + WS_SMALL + SM_WTS);
    LAS int* TP = (LAS int*)(lds + LX_TAB); LAS int* TOK = TP + 64; LAS float* RS = (LAS float*)(TOK + 5 * 256); LAS float* WT = RS + 5 * 256; LAS int* TOKK = (LAS int*)(WT + 5 * 256);
    __syncthreads();
    if (tid == 0) { int s = 0; for (int e = 0; e < 32; ++e) { TP[e] = s; s += ((int)cnt[e] + 255) >> 8; } TP[32] = s; }
    __syncthreads();
    g8::Unit u;
    for (int i = 0; i < 5 && SU.next(i, u); ++i) {
        if (tid < 256) { const int e = u.aux & 255, rt = u.aux >> 8; const int pos = rt * 256 + tid; const int n = (int)cnt[e];
            int tok = T_TOK; float rs = 0.f, wt = 0.f;
            if (pos < n) { const int tk = list[(size_t)e * 32768 + pos]; tok = tk >> 1; rs = rinvB[tok]; wt = wts[tk]; }
            TOK[i * 256 + tid] = tok; RS[i * 256 + tid] = rs; WT[i * 256 + tid] = wt; } }
    for (int i = 0; i < 5 && SD.next(i, u); ++i) {
        if (tid < 256) { const int e = u.aux & 255, rt = u.aux >> 8; const int pos = rt * 256 + tid; const int n = (int)cnt[e];
            TOKK[i * 256 + tid] = (pos < n) ? list[(size_t)e * 32768 + pos] : -1; } }
    __syncthreads();
}
__device__ __forceinline__ void requant_gmin(const ArgsV& a, int gw, int NGW, int lane) {
    unsigned char* ws = a.ws; const bf16_t* W = (const bf16_t*)(ws + WS_W_GMIN); unsigned char* Q = ws + WS_W_GMQ; float* sw = (float*)(ws + WS_SMALL + SM_GMSW);
    for (int n = gw; n < 4096; n += NGW) {
        const GAS u32x4* wp = (const GAS u32x4*)(W + (size_t)n * 1024) + lane; u32x4 wv[2]; float am = 0.f;
#pragma unroll
        for (int j = 0; j < 2; ++j) { wv[j] = wp[64 * j]; const u32x4 w = wv[j];
            am = fmaxf(am, fmaxf(fmaxf(fmaxf(fabsf(bflo(w.x)), fabsf(bfhi(w.x))), fmaxf(fabsf(bflo(w.y)), fabsf(bfhi(w.y)))), fmaxf(fmaxf(fabsf(bflo(w.z)), fabsf(bfhi(w.z))), fmaxf(fabsf(bflo(w.w)), fabsf(bfhi(w.w)))))); }
#pragma unroll
        for (int o = 1; o < 64; o <<= 1) am = fmaxf(am, __shfl_xor(am, o));
        am = fmaxf(am, 1e-30f); const float qs = 127.0f / am;
        GAS u32x2* qp = (GAS u32x2*)(Q + (size_t)n * 1024) + lane;
#pragma unroll
        for (int j = 0; j < 2; ++j) { const u32x4 w = wv[j];
            const int q0 = (int)rintf(bflo(w.x) * qs), q1 = (int)rintf(bfhi(w.x) * qs), q2 = (int)rintf(bflo(w.y) * qs), q3 = (int)rintf(bfhi(w.y) * qs);
            const int q4 = (int)rintf(bflo(w.z) * qs), q5 = (int)rintf(bfhi(w.z) * qs), q6 = (int)rintf(bflo(w.w) * qs), q7 = (int)rintf(bfhi(w.w) * qs);
            u32x2 o; o.x = (unsigned)(q0 & 255) | ((unsigned)(q1 & 255) << 8) | ((unsigned)(q2 & 255) << 16) | ((unsigned)(q3 & 255) << 24);
            o.y = (unsigned)(q4 & 255) | ((unsigned)(q5 & 255) << 8) | ((unsigned)(q6 & 255) << 16) | ((unsigned)(q7 & 255) << 24);
            qp[64 * j] = o; }
        if (lane == 0) gstf(sw + n, am * (1.0f / 127.0f)); }
}
__device__ __forceinline__ void combine_phase(const ArgsV& a, int base, int lw, int stride, int nk, int lane, bool last) {
    unsigned char* ws = a.ws; bf16_t* X = (bf16_t*)(ws + WS_X); const bf16_t* YS = (const bf16_t*)(ws + WS_SCR + SC_YS); float* rinvA = (float*)(ws + WS_SMALL + SM_RINVA); unsigned char* xq = ws + WS_P1;
    for (int k = 0; k < nk; ++k) { const int m = base + lw + k * stride;
        GAS u32x4* xp = (GAS u32x4*)(X + (size_t)m * 1024) + lane; const GAS u32x4* y0 = (const GAS u32x4*)(YS + (size_t)m * 2048) + lane; const GAS u32x4* y1 = y0 + 128;
        float v[2][8]; float s = 0.f;
#pragma unroll
        for (int j = 0; j < 2; ++j) { const u32x4 xv = xp[64 * j], p = y0[64 * j], q = y1[64 * j];
            v[j][0] = bflo(xv.x) + bflo(p.x) + bflo(q.x); v[j][1] = bfhi(xv.x) + bfhi(p.x) + bfhi(q.x); v[j][2] = bflo(xv.y) + bflo(p.y) + bflo(q.y); v[j][3] = bfhi(xv.y) + bfhi(p.y) + bfhi(q.y);
            v[j][4] = bflo(xv.z) + bflo(p.z) + bflo(q.z); v[j][5] = bfhi(xv.z) + bfhi(p.z) + bfhi(q.z); v[j][6] = bflo(xv.w) + bflo(p.w) + bflo(q.w); v[j][7] = bfhi(xv.w) + bfhi(p.w) + bfhi(q.w); }
        if (!last) {
            u32x4 wv[2];
#pragma unroll
            for (int j = 0; j < 2; ++j) { u32x4 w; w.x = cvt_pk_bf16(v[j][0], v[j][1]); w.y = cvt_pk_bf16(v[j][2], v[j][3]); w.z = cvt_pk_bf16(v[j][4], v[j][5]); w.w = cvt_pk_bf16(v[j][6], v[j][7]); xp[64 * j] = w; wv[j] = w;
                s += bflo(w.x) * bflo(w.x) + bfhi(w.x) * bfhi(w.x) + bflo(w.y) * bflo(w.y) + bfhi(w.y) * bfhi(w.y) + bflo(w.z) * bflo(w.z) + bfhi(w.z) * bfhi(w.z) + bflo(w.w) * bflo(w.w) + bfhi(w.w) * bfhi(w.w); }
            const float r = 1.0f / sqrtf(wave_sum(s) * (1.0f / 1024.0f) + RMS_EPS);
            float am = 0.f;
#pragma unroll
            for (int j = 0; j < 2; ++j) { const u32x4 w = wv[j];
                am = fmaxf(am, fmaxf(fmaxf(fmaxf(fabsf(bflo(w.x)), fabsf(bfhi(w.x))), fmaxf(fabsf(bflo(w.y)), fabsf(bfhi(w.y)))), fmaxf(fmaxf(fabsf(bflo(w.z)), fabsf(bfhi(w.z))), fmaxf(fabsf(bflo(w.w)), fabsf(bfhi(w.w)))))); }
#pragma unroll
            for (int o = 1; o < 64; o <<= 1) am = fmaxf(am, __shfl_xor(am, o));
            am = fmaxf(am, 1e-20f); const float qs = 127.0f / am;
            GAS u32x2* qp = (GAS u32x2*)(xq + (size_t)m * 2048) + lane;
#pragma unroll
            for (int j = 0; j < 2; ++j) { const u32x4 w = wv[j];
                const int q0 = (int)rintf(bflo(w.x) * qs), q1 = (int)rintf(bfhi(w.x) * qs), q2 = (int)rintf(bflo(w.y) * qs), q3 = (int)rintf(bfhi(w.y) * qs);
                const int q4 = (int)rintf(bflo(w.z) * qs), q5 = (int)rintf(bfhi(w.z) * qs), q6 = (int)rintf(bflo(w.w) * qs), q7 = (int)rintf(bfhi(w.w) * qs);
                u32x2 o; o.x = (unsigned)(q0 & 255) | ((unsigned)(q1 & 255) << 8) | ((unsigned)(q2 & 255) << 16) | ((unsigned)(q3 & 255) << 24);
                o.y = (unsigned)(q4 & 255) | ((unsigned)(q5 & 255) << 8) | ((unsigned)(q6 & 255) << 16) | ((unsigned)(q7 & 255) << 24);
                qp[64 * j] = o; }
            if (lane == 0) gstf(rinvA + m, r * am * (1.0f / 127.0f));
        } else {
#pragma unroll
            for (int j = 0; j < 2; ++j)
#pragma unroll
                for (int k = 0; k < 8; ++k) s += v[j][k] * v[j][k];
            const float r = 1.0f / sqrtf(wave_sum(s) * (1.0f / 1024.0f) + RMS_EPS);
#pragma unroll
            for (int j = 0; j < 2; ++j) { const GAS f32x4* gp = (const GAS f32x4*)(ARG(I_FINAL_NORM) + (64 * j + lane) * 8); const f32x4 g0 = gp[0], g1 = gp[1];
                GAS f32x4* op = (GAS f32x4*)(((float*)ARG(33)) + (size_t)m * 1024 + (64 * j + lane) * 8);
                op[0] = (f32x4){v[j][0] * r * g0[0], v[j][1] * r * g0[1], v[j][2] * r * g0[2], v[j][3] * r * g0[3]};
                op[1] = (f32x4){v[j][4] * r * g1[0], v[j][5] * r * g1[1], v[j][6] * r * g1[2], v[j][7] * r * g1[3]}; }
        }
    }
}

__device__ __forceinline__ void spatial_phase(const ArgsV& a, LAS unsigned char* lds, int G, int c, int tid, int wave, int lane) {
    unsigned char* ws = a.ws; bf16_t* Z = (bf16_t*)(ws + WS_SCR + SC_Z); const float* part = (const float*)(ws + WS_PART);
    const char* WSB = (const char*)(ws + WS_SMALL + SM_WSB);
    LAS float* RV = (LAS float*)lds;
    LAS unsigned char* WLB = lds + 512;
    LAS bf16_t* ZL = (LAS bf16_t*)(lds + 512 + 65536);
    const int fr = lane & 15, fq = lane >> 4;
    const float* VN = ARG(I_GM_VNORM); const float* BS = ARG(I_GM_BS);
    for (int span = (c & 7) * (G >> 3) + (c >> 3); span < 256; span += G) {
        const size_t row0 = (size_t)span * 128;
        u32x4 zr[8]; u32x4 uv[8], un[8];
#define SP_LOADZ(gg_) do { _Pragma("unroll") for (int i = 0; i < 8; ++i) { const int idx = tid + i * NTHR; zr[i] = gld128(Z + ((size_t)span * 16 + 8 + (gg_)) * 32768 + (size_t)idx * 8); } } while (0)
#define SP_LOADU(dst, gg_) do { _Pragma("unroll") for (int mt = 0; mt < 8; ++mt) \
            dst[mt] = gld128(Z + ((size_t)span * 16 + (gg_)) * 32768 + (mt * 16 + fr) * 256 + wave * 32 + fq * 8); } while (0)
#define SP_DMAW(gg_) do { _Pragma("unroll") for (int t = 0; t < 4; ++t) { const int i = wave * 4 + t; \
            __builtin_amdgcn_global_load_lds((const unsigned*)(WSB + (size_t)(gg_) * 32768 + i * 1024 + lane * 16), (LAS unsigned*)(WLB + ((gg_) & 1) * 32768 + i * 1024), 16, 0, 0); } } while (0)
        __syncthreads();
        SP_LOADZ(0); SP_LOADU(un, 0); SP_DMAW(0);
        if (tid < 128) { float s = 0.f; const GAS f32x4* pp = (const GAS f32x4*)(part + (row0 + tid) * 32);
#pragma unroll
            for (int j = 0; j < 8; ++j) { const f32x4 t = pp[j]; s += (t[0] + t[1]) + (t[2] + t[3]); }
            RV[tid] = 1.0f / sqrtf(s * (1.0f / 2048.0f) + RMS_EPS); }
        __syncthreads();
#pragma unroll 1
        for (int gg = 0; gg < 8; ++gg) {
            asm volatile("s_waitcnt vmcnt(0)" ::: "memory");
#pragma unroll
            for (int i = 0; i < 8; ++i) { const int idx = tid + i * NTHR, j = idx >> 5, c8 = idx & 31; const float rv = RV[j];
                LAS unsigned* d = (LAS unsigned*)(ZL + j * 258 + c8 * 8);
                d[0] = cvt_pk_bf16(bflo(zr[i].x) * rv, bfhi(zr[i].x) * rv); d[1] = cvt_pk_bf16(bflo(zr[i].y) * rv, bfhi(zr[i].y) * rv);
                d[2] = cvt_pk_bf16(bflo(zr[i].z) * rv, bfhi(zr[i].z) * rv); d[3] = cvt_pk_bf16(bflo(zr[i].w) * rv, bfhi(zr[i].w) * rv); }
#pragma unroll
            for (int mt = 0; mt < 8; ++mt) uv[mt] = un[mt];
            __syncthreads();
            if (gg < 7) { SP_DMAW(gg + 1); SP_LOADZ(gg + 1); SP_LOADU(un, gg + 1); }
            LAS unsigned char* WL = WLB + (gg & 1) * 32768;
            const f32x4 vn0 = gldf4(VN + gg * 256 + wave * 32 + fq * 8), vn1 = gldf4(VN + gg * 256 + wave * 32 + fq * 8 + 4);
#pragma unroll
            for (int hf = 0; hf < 2; ++hf) {
                f32x4 acc[2][4];
#pragma unroll
                for (int t = 0; t < 2; ++t)
#pragma unroll
                    for (int mt = 0; mt < 4; ++mt) acc[t][mt] = (f32x4){0.f, 0.f, 0.f, 0.f};
#pragma unroll 1
                for (int ks = 0; ks < 4; ++ks) {
                    bf16x8 za[2];
#pragma unroll
                    for (int t = 0; t < 2; ++t) { const int cc = wave * 32 + 8 * (fr >> 2) + 4 * t + (fr & 3); const LAS bf16_t* zp = ZL + (ks * 32 + fq * 8) * 258 + cc;
#pragma unroll
                        for (int jj = 0; jj < 8; ++jj) za[t][jj] = (short)zp[jj * 258]; }
#pragma unroll
                    for (int mt = 0; mt < 4; ++mt) { const bf16x8 wb = *(const LAS bf16x8*)(WL + ((hf * 4 + mt) * 16 + fr) * 256 + (((ks * 4 + fq) ^ fr) << 4));
                        acc[0][mt] = __builtin_amdgcn_mfma_f32_16x16x32_bf16(za[0], wb, acc[0][mt], 0, 0, 0);
                        acc[1][mt] = __builtin_amdgcn_mfma_f32_16x16x32_bf16(za[1], wb, acc[1][mt], 0, 0, 0); } }
#pragma unroll
                for (int mt = 0; mt < 4; ++mt) { const int i = (hf * 4 + mt) * 16 + fr; const float bs = gldf(BS + gg * 128 + i);
                    const u32x4 uvv = uv[hf * 4 + mt]; const f32x4 m0 = acc[0][mt], m1 = acc[1][mt];
                    u32x4 o; o.x = cvt_pk_bf16(bflo(uvv.x) * (vn0[0] * m0[0] + bs), bfhi(uvv.x) * (vn0[1] * m0[1] + bs)); o.y = cvt_pk_bf16(bflo(uvv.y) * (vn0[2] * m0[2] + bs), bfhi(uvv.y) * (vn0[3] * m0[3] + bs));
                    o.z = cvt_pk_bf16(bflo(uvv.z) * (vn1[0] * m1[0] + bs), bfhi(uvv.z) * (vn1[1] * m1[1] + bs)); o.w = cvt_pk_bf16(bflo(uvv.w) * (vn1[2] * m1[2] + bs), bfhi(uvv.w) * (vn1[3] * m1[3] + bs));
                    gst128(Z + ((size_t)span * 16 + gg) * 32768 + i * 256 + wave * 32 + fq * 8, o); }
            }
            __syncthreads();
        }
#undef SP_LOADZ
#undef SP_LOADU
#undef SP_DMAW
    }
    asm volatile("s_waitcnt vmcnt(0)" ::: "memory");
}
struct KvSched {
    int G, c;
    __device__ __forceinline__ bool next(int i, g8::Unit& u) const {
        const int idx = i * G + c; if (idx >= 64) return false;
        const int l = idx >> 5, pm = (idx >> 3) & 3, pn = idx & 7;
        u.A = (unsigned)WS_MEMBF + (unsigned)pm * (256u * 2048u); u.A2 = u.A; u.B = (unsigned)WS_W_XA + (unsigned)l * (unsigned)(8 * MiB) + (unsigned)(2 * MiB) + (unsigned)pn * (256u * 2048u);
        u.pm = pm; u.pn = pn; u.slot = i; u.aux = l; return true; }
    __device__ __forceinline__ void a_ready(const g8::Unit&, int, int) const {}
};

#ifndef ONLY
#define ONLY -1
#endif
#define PH(n) (ONLY < 0 || ONLY == (n))
#ifndef P0_EARLY_LATE
#define P0_EARLY_LATE 8192
#endif
#define PHASE_CTX \
    ArgsV a; a.ws = (unsigned char*)ARG(34); unsigned char* ws = a.ws; const char* wsb = (const char*)ws; (void)wsb; \
    int tid_ = wave0 * 64 + lane_id(); asm volatile("" : "+v"(tid_)); const int tid = tid_, lane = tid & 63, wave = wave0; \
    const int G = gridDim.x; const volatile LAS unsigned* MS_ = (const volatile LAS unsigned*)(lds + LX_MISC); const int regular = __builtin_amdgcn_readfirstlane((int)MS_[10]) == 1; \
    const int c = regular ? __builtin_amdgcn_readfirstlane((int)(MS_[12] * 8u + MS_[13])) : (int)blockIdx.x;     \
    const int gw = c * NWAVES + wave, NGW = G * NWAVES; (void)gw; (void)NGW; (void)lane; \
    LAS float* RSL = (LAS float*)(lds + LX_TAB); bf16_t* X = (bf16_t*)(ws + WS_X); float* part = (float*)(ws + WS_PART); const float* rinvA = (const float*)(ws + WS_SMALL + SM_RINVA); \
    (void)RSL; (void)X; (void)part; (void)rinvA;
#ifndef PROBE_A
#define PROBE_A -1
#define PROBE_B -1
#endif
#ifndef PROBE_TICKS
#define PROBE_TICKS 1600
#endif
#define TSTAMP() do { if (PROBE_A >= 0 && blockIdx.x == 0 && wave0 == 0 && lane_id() == 0) { unsigned long long* ts_ = (unsigned long long*)((unsigned char*)ARG(34) + WS_CTL) + CW_DBG / 2; unsigned* n_ = (unsigned*)(ts_ + 200); ts_[*n_] = __builtin_amdgcn_s_memrealtime(); *n_ = *n_ + 1; } } while (0)
#define SUBSTAMP(k) do { if (PROBE_A >= 0 && blockIdx.x == 0 && wave0 == 0 && lane_id() == 0) { unsigned long long* ts_ = (unsigned long long*)((unsigned char*)ARG(34) + WS_CTL) + CW_DBG / 2; ts_[k] = __builtin_amdgcn_s_memrealtime(); } } while (0)
#define GRID_BAR() do { XcdBarrier bar_; bar_.bar = (unsigned*)((unsigned char*)ARG(34) + WS_CTL) + CW_BAR; bar_.x = xb_xcc_id(); bar_.st = (volatile LAS unsigned*)(lds + LX_MISC) + 8; xcd_barrier(bar_, wave0 == 0 && lane_id() == 0); TSTAMP(); } while (0)
#define LOCAL_BAR() do { const volatile LAS unsigned* ms_ = (const volatile LAS unsigned*)(lds + LX_MISC); if (__builtin_amdgcn_readfirstlane((int)ms_[10]) == 1) \
        xcc_local_barrier((unsigned*)((unsigned char*)ARG(34) + WS_CTL) + CW_BAR, (unsigned)__builtin_amdgcn_readfirstlane((int)ms_[13]), (unsigned)__builtin_amdgcn_readfirstlane((int)ms_[8]), wave0 == 0 && lane_id() == 0); \
    else GRID_BAR(); } while (0)
typedef g8::StdSched<128, 4, 256u * 2048u, 256u * 2048u> SchedN1024;

__global__ void __launch_bounds__(NTHR, 2) fwd_megakernel(Args a_unused) {
    extern __shared__ __attribute__((aligned(16))) unsigned char lds_raw[];
    LAS unsigned char* lds = (LAS unsigned char*)lds_raw;
    const int wave0 = __builtin_amdgcn_readfirstlane((int)threadIdx.x >> 6);
    { volatile LAS unsigned* MISC = (volatile LAS unsigned*)(lds + LX_MISC);
      if (wave0 == 0) MISC[lane_id()] = 0u;
      __syncthreads();
      if (wave0 == 0 && lane_id() == 0) { const unsigned x_ = xb_xcc_id(); MISC[13] = x_; MISC[12] = xcd_barrier_post((unsigned*)((unsigned char*)ARG(34) + WS_CTL) + CW_BAR, x_, true); }
      __syncthreads(); }
    TSTAMP();

    if (PH(0)) { PHASE_CTX
      const int NSH = 64 + 2 * (G - 64);
      int sh0, nsh;
      if (c < 64) { p0_s5_tables(a, lds, c, tid); __syncthreads(); sh0 = c; nsh = 1; } else { sh0 = 64 + 2 * (c - 64); nsh = 2; }
#pragma unroll 1
      for (int s = 0; s < nsh; ++s) { const int gwv = (sh0 + s) * NWAVES + wave, NGWv = NSH * NWAVES;
        p0_weights(a, lds, 0, 0, 1 << 30, gwv, NGWv, wave, lane);
        p0_rows(a, gwv, NGWv, lane);
        p0_weights(a, lds, 1, 0, P0_EARLY_LATE, gwv, NGWv, wave, lane); } }
    GRID_BAR();

    if (PH(1)) { PHASE_CTX
      if ((c >> 3) < (G >> 4)) {
        const int cg = c - ((c >> 3) >= (G >> 4) ? (G >> 1) : 0), Gg = G >> 1;
        { typedef g8::StdSched<128, 4, 256u * 2048u, 256u * 2048u> Sc; Sc S{(unsigned)WS_X, (unsigned)WS_W_S5IN, Gg, cg};
          fill_rs(S, RSL, rinvA, nullptr, 0, tid);
          g8::EpiU E{(bf16_t*)(ws + WS_SCR + SC_U), RSL};
          g8::gemm_phase<g8::EpiU, Sc, 0, 2048, 2048, 128, 128, 16, 16>(lds, wsb, S, E, nullptr, tid); }
        { KvSched S{Gg, cg};
          g8::EpiKV E{(bf16_t*)(ws + WS_KV), (const float*)(ws + WS_SMALL + SM_RINVMEM)};
          g8::gemm_phase<g8::EpiKV, KvSched, 0, 2048, 2048, 128, 128, 16, 16>(lds, wsb, S, E, nullptr, tid); }
        if (cg >= 64) requant_gmin(a, (cg - 64) * NWAVES + wave, (Gg - 64) * NWAVES, lane);
      } else {
        const int cw = c - (G >> 1);
        p0_weights(a, lds, 1, P0_EARLY_LATE, 1 << 30, cw * NWAVES + wave, (G >> 1) * NWAVES, wave, lane);
        p0_moe_gu_jobs(a, lds, cw, G >> 1, wave, lane);
      } }
    GRID_BAR();

    if (PH(3)) { PHASE_CTX
      { const int pr = c; if (pr < 256) { const int q = pr >> 3; s5_scan_pair(a, lds, q >> 3, (pr & 7) * 8 + (q & 7), tid, wave, lane, PROBE_A >= 0 ? (unsigned long long*)(ws + WS_CTL) + CW_DBG / 2 + 48 : nullptr); } }
      prep_tile(a, lds, 0, (c & 7) >> 1, c >> 3, WS_SCR + SC_G0 + (size_t)(c & 7) * 4 * MiB, tid); }
    GRID_BAR();

    if (PH(4)) { PHASE_CTX
      typedef g8::StdSched<128, 8, 256u * 32u, 256u * 2048u> Sc; Sc S{(unsigned)(WS_SCR + SC_Y), (unsigned)WS_W_S5OUT, G, c};
      g8::EpiGluRes E{X, part};
      g8::gemm_phase<g8::EpiGluRes, Sc, 16, 32, 2048, 4194304, 128, 16, 16>(lds, wsb, S, E, nullptr, tid); }
    LOCAL_BAR();

#pragma unroll 1
    for (int layer = 0; layer < 2; ++layer) {
        if (layer == 1) {
            if (PH(5)) { PHASE_CTX
              typedef g8::StdSched<128, 16, 256u * 2048u, 256u * 1024u> Sc; Sc S{(unsigned)WS_P1, (unsigned)WS_W_GMQ, G, c};
              fill_rs(S, RSL, rinvA, nullptr, 0, tid);
              g8::EpiGmIn E{(bf16_t*)(ws + WS_SCR + SC_Z), RSL, part, (const float*)(ws + WS_SMALL + SM_GMSW)};
              g8::gemm_phase<g8::EpiGmIn, Sc, 0, 2048, 1024, 128, 128, 8, 8>(lds, wsb, S, E, nullptr, tid); }
            LOCAL_BAR();
            if (PH(6)) { PHASE_CTX
              spatial_phase(a, lds, G, c, tid, wave, lane); }
            LOCAL_BAR();
            if (PH(7)) { PHASE_CTX
              typedef g8::StdSched<128, 4, 256u * 8192u, 256u * 4224u> Sc; Sc S{(unsigned)(WS_SCR + SC_Z), (unsigned)WS_W_GMOUT_P, G, c};
              g8::EpiRes<true> E{X, part};
              g8::gemm_phase<g8::EpiRes<true>, Sc, 4, 512, 4224, 128, 128, 32, 32>(lds, wsb, S, E, nullptr, tid, (PROBE_A >= 0) ? (unsigned long long*)(ws + WS_CTL) + CW_DBG / 2 + 40 : nullptr);
            }
            LOCAL_BAR();
        }
        if (PH(8)) { PHASE_CTX
          const unsigned GXo = layer == 0 ? (unsigned)(WS_SCR + SC_G0) + (unsigned)(c & 7) * (unsigned)(4 * MiB) : (unsigned)WS_G1 + (unsigned)((c & 7) >> 1) * (unsigned)(4 * MiB);
          SchedN1024 S{(unsigned)WS_X, GXo, G, c};
          fill_rs(S, RSL, nullptr, part, layer == 0 ? 32 : 16, tid);
          g8::EpiSoftmax E{(bf16_t*)(ws + (layer == 0 ? WS_SCR + SC_P0 : WS_P1)), RSL, (LAS float*)(lds + LX_TAB + 8192)};
          g8::gemm_phase<g8::EpiSoftmax, SchedN1024, 0, 2048, 2048, 128, 128, 16, 16>(lds, wsb, S, E, nullptr, tid, (PROBE_A >= 0 && layer == 0) ? (unsigned long long*)(ws + WS_CTL) + CW_DBG / 2 + 32 : nullptr); }
        LOCAL_BAR();
        if (PH(10)) { PHASE_CTX
          const unsigned GXo = (layer == 0 ? (unsigned)(WS_SCR + SC_G0) + (unsigned)(c & 7) * (unsigned)(4 * MiB) : (unsigned)WS_G1 + (unsigned)((c & 7) >> 1) * (unsigned)(4 * MiB)) + (unsigned)(2 * MiB);
          SchedN1024 S{layer == 0 ? (unsigned)(WS_SCR + SC_P0) : (unsigned)WS_P1, GXo, G, c};
          g8::EpiRes<false> E{X, part};
          g8::gemm_phase<g8::EpiRes<false>, SchedN1024, 0, 2048, 2048, 128, 128, 16, 16>(lds, wsb, S, E, nullptr, tid); }
        GRID_BAR();
        if (PH(11)) { PHASE_CTX
          router_phase(a, lds, layer, G, c, tid, wave, lane); }
        GRID_BAR();
        if (PH(12)) { PHASE_CTX
          LAS int* TP = (LAS int*)(lds + LX_TAB); LAS int* TOK = TP + 64; LAS float* RS = (LAS float*)(TOK + 5 * 256); LAS float* WT = RS + 5 * 256; LAS int* TOKK = (LAS int*)(WT + 5 * 256);
          unsigned* done = (unsigned*)(ws + WS_CTL) + CW_DONE + layer * 32768;
          const int r = (c & 7) * (G >> 3) + (c >> 3);
          MoeUpSched SU{(unsigned)WS_W_MOE + (unsigned)layer * (unsigned)MOE_L_STRIDE, TP, r};
          MoeDownSched SD{(unsigned)WS_W_MOE + (unsigned)layer * (unsigned)MOE_L_STRIDE + (unsigned)MOE_D_OFF, TP, r, done, (unsigned*)(ws + WS_CTL) + CW_BAR + XB_TMO};
          moe_tables(a, lds, layer, SU, SD, tid);
          { g8::EpiMoeUp E{__builtin_amdgcn_make_buffer_rsrc((void*)(ws + WS_SCR + SC_HB), (short)0, (int)(73728u * 1024u), 0x00020000), RS, WT, done, (const float*)(ws + WS_SMALL + SM_MOESW) + layer * 32768};
            g8::gemm_phase<g8::EpiMoeUp, MoeUpSched, 1, 1024, 2048, 128, 128, 8, 8>(lds, wsb, SU, E, TOK, tid); }
          { g8::EpiMoeDown E{(bf16_t*)(ws + WS_SCR + SC_YS), TOKK};
            g8::gemm_phase<g8::EpiMoeDown, MoeDownSched, 0, 1024, 1024, 128, 128, 8, 8>(lds, wsb, SD, E, nullptr, tid); }
          if (layer == 0 && (r < 64 || r >= 192)) { const int q = r < 64 ? r : r - 128; prep_tile(a, lds, 1, q >> 5, q & 31, WS_G1 + (size_t)(q >> 5) * 4 * MiB, tid); } }
        GRID_BAR();
        if (PH(14)) { PHASE_CTX
          if (regular) combine_phase(a, (c & 7) * 4096, (c >> 3) * NWAVES + wave, (G >> 3) * NWAVES, 16, lane, layer == 1);
          else combine_phase(a, 0, gw, NGW, T_TOK / NGW, lane, layer == 1); }
        if (layer == 0) GRID_BAR();
    }
    if (PROBE_A >= 0 && blockIdx.x == 0 && wave0 == 0 && lane_id() == 0) {
        asm volatile("s_waitcnt vmcnt(0)" ::: "memory");
        unsigned long long* ts_ = (unsigned long long*)((unsigned char*)ARG(34) + WS_CTL) + CW_DBG / 2; const unsigned long long te = __builtin_amdgcn_s_memrealtime(); ts_[21] = te;
        unsigned long long qa = (ts_[PROBE_A + 1] - ts_[PROBE_A] + PROBE_TICKS / 2) / PROBE_TICKS, qb = (ts_[PROBE_B + 1] - ts_[PROBE_B] + PROBE_TICKS / 2) / PROBE_TICKS; if (qa > 63) qa = 63; if (qb > 63) qb = 63;
        const unsigned long long D = (qa + 64 * qb) * 6400;
        while (__builtin_amdgcn_s_memrealtime() - te < D) __builtin_amdgcn_s_sleep(32);
    }
    { unsigned* ctl = (unsigned*)((unsigned char*)ARG(34) + WS_CTL);
      if (xb_ld(ctl + CW_BAR + XB_TMO) != 0u && blockIdx.x == 0 && wave0 == 0 && lane_id() == 0) ((float*)ARG(33))[0] = __builtin_nanf(""); }
}

extern "C" void kernel_launch(void* const* d_in, const int* in_sizes, int n_in, void* d_out, int out_size, void* d_ws, size_t ws_size, hipStream_t stream) {
    static int grid = 0;
    if (grid == 0) {
        if (n_in != 33 || in_sizes[0] != T_TOK * DM || out_size != T_TOK * DM || ws_size < WS_END) {
            fprintf(stderr, "kernel_launch: unexpected problem (n_in %d, in0 %d, out %d, ws %zu < %zu)\n", n_in, n_in > 0 ? in_sizes[0] : -1, out_size, ws_size, (size_t)WS_END); grid = -1; return; }
        int dev = 0, cus = 0, per_cu = 0;
        if (hipGetDevice(&dev) != hipSuccess || hipDeviceGetAttribute(&cus, hipDeviceAttributeMultiprocessorCount, dev) != hipSuccess) { grid = -1; return; }
        if (hipFuncSetAttribute((const void*)fwd_megakernel, hipFuncAttributeMaxDynamicSharedMemorySize, LDS_BYTES) != hipSuccess) { fprintf(stderr, "kernel_launch: hipFuncSetAttribute failed\n"); grid = -1; return; }
        if (hipOccupancyMaxActiveBlocksPerMultiprocessor(&per_cu, (const void*)fwd_megakernel, NTHR, LDS_BYTES) != hipSuccess || per_cu < 1) { fprintf(stderr, "kernel_launch: occupancy query says %d blocks per CU\n", per_cu); (void)hipGetLastError(); grid = -1; return; }
        grid = cus;
        if (grid != 256) { fprintf(stderr, "kernel_launch: built for 256 CUs, device has %d\n", cus); grid = -1; return; }
    }
    if (grid < 0) return;
    if (hipMemsetAsync((char*)d_ws + WS_CTL, 0, CTL_BYTES, stream) != hipSuccess) { fprintf(stderr, "kernel_launch: memset failed\n"); return; }
    Args a{};
    for (int i = 0; i < 33; ++i) a.in[i] = (const float*)d_in[i];
    a.out = (float*)d_out; a.ws = (unsigned char*)d_ws;
    void* args[] = {&a};
    const hipError_t e = hipLaunchCooperativeKernel((const void*)fwd_megakernel, dim3(grid), dim3(NTHR), args, LDS_BYTES, stream);
    if (e != hipSuccess) fprintf(stderr, "kernel_launch: cooperative launch failed: %s\n", hipGetErrorString(e));
}
```
